# Optimizing an MI355X kernel written in HIP

```python
import jax, jax.numpy as jnp
from jax import lax
import numpy as np

D_MODEL = 1024
BATCH = 4
SEQ = 8192
DEPTH = 1

HEAD_DIM = 64
SWA_Q_HEADS = 8
SWA_KV_HEADS = 2
SWA_WINDOW = 128
FOX_HEADS = 8
BLOCK = 128
ROPE_THETA = 10000.0
N_EXPERTS = 32
TOP_K = 4
D_FF_EXPERT = D_MODEL
SWIGLU_LIMIT = 7.0
SWIGLU_ALPHA = 1.702
EPS = 1e-6
NEG = -1e30
ATTN_SCALE = HEAD_DIM ** -0.5

SWA_Q_W = SWA_Q_HEADS * HEAD_DIM
SWA_KV_W = SWA_KV_HEADS * HEAD_DIM
FOX_W = FOX_HEADS * HEAD_DIM
IN_SPLITS = (SWA_Q_W, SWA_KV_W, SWA_KV_W, FOX_W, FOX_W, FOX_W, FOX_HEADS, 2 * D_MODEL)
IN_W = SWA_Q_W + 2 * SWA_KV_W + 3 * FOX_W + FOX_HEADS + 2 * D_MODEL

kernel_name = "hybrid_swa_sink_fox_moe_block"


def rms_norm(x, g):
    xf = x.astype(jnp.float32)
    y = xf * lax.rsqrt(jnp.mean(xf * xf, axis=-1, keepdims=True) + EPS)
    return (y * g.astype(jnp.float32)).astype(x.dtype)


def rope(x, positions):
    half = HEAD_DIM // 2
    inv = ROPE_THETA ** (-jnp.arange(half, dtype=jnp.float32) / half)
    ang = positions.astype(jnp.float32)[..., None] * inv
    cos = jnp.cos(ang)[:, :, None, :]
    sin = jnp.sin(ang)[:, :, None, :]
    xf = x.astype(jnp.float32)
    x1, x2 = xf[..., :half], xf[..., half:]
    return jnp.concatenate([x1 * cos - x2 * sin, x2 * cos + x1 * sin], axis=-1).astype(x.dtype)


def split_cols(p):
    idx, acc = [], 0
    for w in IN_SPLITS[:-1]:
        acc += w
        idx.append(acc)
    return jnp.split(p, idx, axis=-1)


def swa_sink_attention(q, k, v, sinks):
    B, S = q.shape[0], q.shape[1]
    nb = S // BLOCK
    G = SWA_Q_HEADS // SWA_KV_HEADS
    qb = q.reshape(B, nb, BLOCK, SWA_KV_HEADS, G, HEAD_DIM)
    kb = k.reshape(B, nb, BLOCK, SWA_KV_HEADS, HEAD_DIM)
    vb = v.reshape(B, nb, BLOCK, SWA_KV_HEADS, HEAD_DIM)

    def with_prev(t):
        prev = jnp.pad(t[:, :-1], ((0, 0), (1, 0), (0, 0), (0, 0), (0, 0)))
        return jnp.concatenate([prev, t], axis=2)

    kk, vv = with_prev(kb), with_prev(vb)
    s = jnp.einsum('bnqhgd,bnkhd->bnhgqk', qb, kk).astype(jnp.float32) * ATTN_SCALE
    qi = jnp.arange(BLOCK)[:, None]
    kj = jnp.arange(2 * BLOCK)[None, :]
    delta = qi + BLOCK - kj
    blk = jnp.arange(nb)[:, None, None]
    valid = (delta >= 0) & (delta < SWA_WINDOW) & (blk * BLOCK + kj - BLOCK >= 0)
    s = jnp.where(valid[None, :, None, None], s, NEG)
    sink = sinks.astype(jnp.float32).reshape(1, 1, SWA_KV_HEADS, G, 1, 1)
    m = jnp.maximum(jnp.max(s, axis=-1, keepdims=True), sink)
    p = jnp.exp(s - m)
    p = p / (jnp.sum(p, axis=-1, keepdims=True) + jnp.exp(sink - m))
    o = jnp.einsum('bnhgqk,bnkhd->bnqhgd', p.astype(v.dtype), vv)
    return o.reshape(B, S, SWA_Q_W)


def forgetting_attention(q, k, v, log_f):
    B, S = q.shape[0], q.shape[1]
    nb = S // BLOCK
    c = jnp.cumsum(log_f, axis=1).transpose(0, 2, 1)
    qb = q.reshape(B, nb, BLOCK, FOX_HEADS, HEAD_DIM).transpose(1, 0, 2, 3, 4)
    cq = c.reshape(B, FOX_HEADS, nb, BLOCK).transpose(2, 0, 1, 3)
    k_pos = jnp.arange(S)

    def block(args):
        q_blk, c_blk, n = args
        s = jnp.einsum('bqhd,bkhd->bhqk', q_blk, k).astype(jnp.float32) * ATTN_SCALE
        s = s + c_blk[..., None] - c[:, :, None, :]
        q_pos = n * BLOCK + jnp.arange(BLOCK)
        s = jnp.where((k_pos[None, :] <= q_pos[:, None])[None, None], s, NEG)
        p = jax.nn.softmax(s, axis=-1).astype(v.dtype)
        return jnp.einsum('bhqk,bkhd->bqhd', p, v)

    o = lax.map(block, (qb, cq, jnp.arange(nb)))
    return o.transpose(1, 0, 2, 3, 4).reshape(B, S, FOX_W)


def moe_ffn(h, w_router, b_router, w_gate_up, b_gate_up, w_down, b_down):
    B, S, D = h.shape
    N = B * S
    t = h.reshape(N, D)
    logits = (t @ w_router).astype(jnp.float32) + b_router.astype(jnp.float32)
    top_val, top_idx = lax.top_k(logits, TOP_K)
    gate = jax.nn.softmax(top_val, axis=-1)
    e_flat = top_idx.reshape(-1).astype(jnp.int32)
    tok_flat = jnp.repeat(jnp.arange(N, dtype=jnp.int32), TOP_K)
    w_flat = gate.reshape(-1)
    order = jnp.argsort(e_flat)
    e_sorted = e_flat[order]
    counts = jnp.zeros((N_EXPERTS,), jnp.int32).at[e_flat].add(1)
    padded = (counts + BLOCK - 1) // BLOCK * BLOCK
    pad_end = jnp.cumsum(padded)
    pad_start = pad_end - padded
    grp_start = jnp.cumsum(counts) - counts
    rank = jnp.arange(N * TOP_K, dtype=jnp.int32) - grp_start[e_sorted]
    dest = pad_start[e_sorted] + rank
    cap = N * TOP_K + N_EXPERTS * BLOCK
    n_blk = cap // BLOCK
    row_tok = jnp.full((cap,), N, jnp.int32).at[dest].set(tok_flat[order])
    row_w = jnp.zeros((cap,), jnp.float32).at[dest].set(w_flat[order])
    blk_expert = jnp.minimum(jnp.searchsorted(pad_end, jnp.arange(n_blk, dtype=jnp.int32) * BLOCK, side='right'),
                             N_EXPERTS - 1).astype(jnp.int32)
    t_pad = jnp.concatenate([t, jnp.zeros((1, D), t.dtype)], axis=0)
    xin = t_pad[row_tok].reshape(n_blk, BLOCK, D)

    def expert_block(args):
        xb, e = args
        gu = xb @ w_gate_up[e] + b_gate_up[e]
        g, u = gu[:, :D_FF_EXPERT], gu[:, D_FF_EXPERT:]
        g = jnp.minimum(g, SWIGLU_LIMIT)
        u = jnp.clip(u, -SWIGLU_LIMIT, SWIGLU_LIMIT)
        a = (u + 1.0) * (g * jax.nn.sigmoid(SWIGLU_ALPHA * g))
        return a @ w_down[e] + b_down[e]

    yb = lax.map(expert_block, (xin, blk_expert)).reshape(cap, D)
    y = jax.ops.segment_sum(yb * row_w[:, None].astype(yb.dtype), row_tok, num_segments=N + 1)[:N]
    return y.reshape(B, S, D)


def hybrid_layer(x, positions, norm1_g, w_in, b_forget, b_gate, q_norm_swa, k_norm_swa, sinks,
                 q_norm_fox, k_norm_fox, w_o_swa, w_o_fox, w_out, norm2_g, w_router, b_router,
                 w_gate_up, b_gate_up, w_down, b_down):
    B, S, D = x.shape
    h = rms_norm(x, norm1_g)
    proj = h @ w_in
    qa, ka, va, qf, kf, vf, fl, gl = split_cols(proj)
    qa = rope(rms_norm(qa.reshape(B, S, SWA_Q_HEADS, HEAD_DIM), q_norm_swa), positions)
    ka = rope(rms_norm(ka.reshape(B, S, SWA_KV_HEADS, HEAD_DIM), k_norm_swa), positions)
    va = va.reshape(B, S, SWA_KV_HEADS, HEAD_DIM)
    out_a = swa_sink_attention(qa, ka, va, sinks)
    qf = rms_norm(qf.reshape(B, S, FOX_HEADS, HEAD_DIM), q_norm_fox)
    kf = rms_norm(kf.reshape(B, S, FOX_HEADS, HEAD_DIM), k_norm_fox)
    vf = vf.reshape(B, S, FOX_HEADS, HEAD_DIM)
    log_f = jax.nn.log_sigmoid((fl + b_forget).astype(jnp.float32))
    out_b = forgetting_attention(qf, kf, vf, log_f)
    gates = jax.nn.sigmoid(gl + b_gate)
    g_a, g_b = gates[..., :D_MODEL], gates[..., D_MODEL:]
    merged = g_a * (out_a @ w_o_swa) + g_b * (out_b @ w_o_fox)
    x = x + merged @ w_out
    h2 = rms_norm(x, norm2_g)
    return x + moe_ffn(h2, w_router, b_router, w_gate_up, b_gate_up, w_down, b_down)


def setup_inputs(seed: int = 0) -> dict:
    key = jax.random.key(seed)
    ks = jax.random.split(key, 24)
    f32 = jnp.float32

    def nrm(k, shape, scale):
        return jax.random.normal(k, shape, f32) * scale

    L = DEPTH
    return {
        "x": nrm(ks[0], (BATCH, SEQ, D_MODEL), 1.0),
        "positions": (jnp.arange(SEQ, dtype=jnp.int32)[None, :]
                      + jax.random.randint(ks[1], (BATCH, 1), 0, 4096, dtype=jnp.int32)),
        "norm1_g": 1.0 + nrm(ks[2], (L, D_MODEL), 0.02),
        "w_in": nrm(ks[3], (L, D_MODEL, IN_W), D_MODEL ** -0.5),
        "b_forget": 3.0 + nrm(ks[4], (L, FOX_HEADS), 0.5),
        "b_gate": nrm(ks[5], (L, 2 * D_MODEL), 0.02),
        "q_norm_swa": 1.0 + nrm(ks[6], (L, HEAD_DIM), 0.02),
        "k_norm_swa": 1.0 + nrm(ks[7], (L, HEAD_DIM), 0.02),
        "sinks": nrm(ks[8], (L, SWA_Q_HEADS), 0.5),
        "q_norm_fox": 1.0 + nrm(ks[9], (L, HEAD_DIM), 0.02),
        "k_norm_fox": 1.0 + nrm(ks[10], (L, HEAD_DIM), 0.02),
        "w_o_swa": nrm(ks[11], (L, SWA_Q_W, D_MODEL), SWA_Q_W ** -0.5),
        "w_o_fox": nrm(ks[12], (L, FOX_W, D_MODEL), FOX_W ** -0.5),
        "w_out": nrm(ks[13], (L, D_MODEL, D_MODEL), D_MODEL ** -0.5),
        "norm2_g": 1.0 + nrm(ks[14], (L, D_MODEL), 0.02),
        "w_router": nrm(ks[15], (L, D_MODEL, N_EXPERTS), D_MODEL ** -0.5),
        "b_router": nrm(ks[16], (L, N_EXPERTS), 0.01),
        "w_gate_up": nrm(ks[17], (L, N_EXPERTS, D_MODEL, 2 * D_FF_EXPERT), D_MODEL ** -0.5),
        "b_gate_up": nrm(ks[18], (L, N_EXPERTS, 2 * D_FF_EXPERT), 0.01),
        "w_down": nrm(ks[19], (L, N_EXPERTS, D_FF_EXPERT, D_MODEL), D_FF_EXPERT ** -0.5),
        "b_down": nrm(ks[20], (L, N_EXPERTS, D_MODEL), 0.01),
    }


def reference(x, positions, norm1_g, w_in, b_forget, b_gate, q_norm_swa, k_norm_swa, sinks,
              q_norm_fox, k_norm_fox, w_o_swa, w_o_fox, w_out, norm2_g, w_router, b_router,
              w_gate_up, b_gate_up, w_down, b_down):
    for l in range(DEPTH):
        x = hybrid_layer(x, positions, norm1_g[l], w_in[l], b_forget[l], b_gate[l],
                         q_norm_swa[l], k_norm_swa[l], sinks[l], q_norm_fox[l], k_norm_fox[l],
                         w_o_swa[l], w_o_fox[l], w_out[l], norm2_g[l], w_router[l], b_router[l],
                         w_gate_up[l], b_gate_up[l], w_down[l], b_down[l])
    return x
```

```cpp
#include <hip/hip_runtime.h>
#include <hip/hip_cooperative_groups.h>
#include <hip/hip_bf16.h>
#include <cstdio>
#include <cstdint>
namespace cg = cooperative_groups;

#ifndef XREC
#define XREC 1
#endif
#ifndef P3A_FP8
#define P3A_FP8 1
#endif
#ifndef P3B_FP8
#define P3B_FP8 1
#endif
#ifndef P1_FP8
#define P1_FP8 1
#endif
#ifndef MK_N_LAUNCHES
#define MK_N_LAUNCHES 1
#endif

#define LAS __attribute__((address_space(3)))
typedef unsigned short bf16_t;
typedef short bf16x8 __attribute__((ext_vector_type(8)));
typedef short s16x4 __attribute__((ext_vector_type(4)));
typedef float f32x2 __attribute__((ext_vector_type(2)));
typedef float f32x4 __attribute__((ext_vector_type(4)));
typedef float f32x16 __attribute__((ext_vector_type(16)));
typedef unsigned u32x2 __attribute__((ext_vector_type(2)));
typedef unsigned u32x4 __attribute__((ext_vector_type(4)));
typedef int i32x4_t __attribute__((ext_vector_type(4)));

constexpr int D_MODEL = 1024, BATCH = 4, SEQ = 8192, NTOK = BATCH * SEQ;
constexpr int HD = 64, SWA_QH = 8, SWA_KVH = 2, FOX_H = 8, N_EXP = 32, TOPK = 4, D_FF = 1024;
constexpr int IN_W = 4360, COL_FL = 2304, COL_GL = 2312;
constexpr int IN_TILES = 17;
constexpr float EPS = 1e-6f;
constexpr float LOG2E = 1.4426950408889634f;
constexpr float C2 = 0.125f * LOG2E;
constexpr int CAP_TILES = (NTOK * TOPK) / 256 + N_EXP;

__device__ __forceinline__ unsigned cvt_pk_bf16(float lo, float hi) { typedef __bf16 b2 __attribute__((ext_vector_type(2))); f32x2 v = {lo, hi}; b2 b = __builtin_convertvector(v, b2); return __builtin_bit_cast(unsigned, b); }
__device__ __forceinline__ float bf_lo(unsigned u) { return __uint_as_float(u << 16); }
__device__ __forceinline__ float bf_hi(unsigned u) { return __uint_as_float(u & 0xffff0000u); }
__device__ __forceinline__ float bf2f(short s) { return __uint_as_float(((unsigned)(unsigned short)s) << 16); }
__device__ __forceinline__ float clamp448(float x) { return __builtin_fminf(__builtin_fmaxf(x, -448.0f), 448.0f); }
__device__ __forceinline__ unsigned pk4_fp8(float a, float b, float c, float d) {
    int r = __builtin_amdgcn_cvt_pk_fp8_f32(clamp448(a), clamp448(b), 0, false); r = __builtin_amdgcn_cvt_pk_fp8_f32(clamp448(c), clamp448(d), r, true); return (unsigned)r; }
__device__ __forceinline__ unsigned pk4_fp8_nc(float a, float b, float c, float d) { int r = __builtin_amdgcn_cvt_pk_fp8_f32(a, b, 0, false); r = __builtin_amdgcn_cvt_pk_fp8_f32(c, d, r, true); return (unsigned)r; }
typedef int i32x8 __attribute__((ext_vector_type(8)));
constexpr float W8_SCALE = 32.0f;
__device__ __forceinline__ int opaque_tid() { int t = threadIdx.x; asm volatile("" : "+v"(t)); return t; }
__host__ __device__ __forceinline__ int perm32s(int p) { return 16 * ((p >> 2) & 1) + 4 * (p >> 3) + (p & 3); }

namespace pg8 {
constexpr int BM = 256, BK = 64, HALF = 128, HTB = HALF * BK * 2  , STAGE_BYTES = 8 * HTB, NXCD = 8, WGM = 4;
__host__ __device__ __forceinline__ int lds_byte(int r, int c) { const int st = (r >> 4) * 2 + (c >> 5), rr = r & 15, cc = c & 31, ob = rr * 64 + cc * 2; return st * 1024 + (ob ^ (((ob >> 9) & 1) << 5)); }
__host__ __device__ __forceinline__ void stage_rc(int b, int& R, int& C) { const int st = b / 1024, sb = b % 1024, swz = sb ^ (((sb >> 9) & 1) << 5); R = (st >> 1) * 16 + swz / 64; C = (st & 1) * 32 + (swz % 64) / 2; }

struct Unit { int pm, pn, e; const char* a; const char* b; const LAS int* gtab; int gcnt; };

__device__ __forceinline__ void tile_map(int L, int nM, int nN, int& pm, int& pn) {
    const int nwg = nM * nN; int wgid = L; { const int q = nwg / NXCD, r = nwg % NXCD, xcd = wgid % NXCD, off = wgid / NXCD; wgid = (xcd < r ? xcd * (q + 1) : r * (q + 1) + (xcd - r) * q) + off; }
    const int nig = WGM * nN, gid = wgid / nig, fm = gid * WGM, gsz = (nM - fm) < WGM ? (nM - fm) : WGM;
    pm = fm + ((wgid % nig) % gsz); pn = (wgid % nig) / gsz;
}
struct DenseOrder {
    int nM, nN, G, c; const char* A; const char* B; size_t tstep;
    __device__ __forceinline__ bool next(int i, Unit& u) const {
        const long L = (long)i * G + c; if (L >= (long)nM * nN) return false;
        tile_map((int)L, nM, nN, u.pm, u.pn); u.e = 0; u.a = A + (size_t)u.pm * tstep; u.b = B + (size_t)u.pn * tstep; u.gtab = nullptr; u.gcnt = 0; return true; }
};
struct SplitOrder {
    int nM, nN, G, c, pn0; const char* A; const char* B; size_t tstep;
    __device__ __forceinline__ bool next(int i, Unit& u) const {
        long L;
        if (G == 256 && nM * nN == 1280) { if (c < 128) { if (i >= 4) return false; L = (long)i * 128 + c; } else { if (i >= 6) return false; L = 512 + (long)i * 128 + (c - 128); } }
        else { L = (long)i * G + c; if (L >= (long)nM * nN) return false; }
        tile_map((int)L, nM, nN, u.pm, u.pn); u.e = 0; u.a = A + (size_t)u.pm * tstep; u.b = B + (size_t)u.pn * tstep; u.pn += pn0; u.gtab = nullptr; u.gcnt = 0; return true; }
};
struct PairOrder {
    int nM, nN, G, c; const char* A0; const char* A1; const char* B0; const char* B1; size_t tstep;
    __device__ __forceinline__ bool next(int i, Unit& u) const {
        const long L = (long)(i >> 1) * G + c; if (L >= (long)nM * nN) return false;
        tile_map((int)L, nM, nN, u.pm, u.pn); u.e = i & 1; u.a = ((i & 1) ? A1 : A0) + (size_t)u.pm * tstep; u.b = ((i & 1) ? B1 : B0) + (size_t)u.pn * tstep; u.gtab = nullptr; u.gcnt = 0; return true; }
};
struct GroupOrder {
    int MT, nN, G, c; const LAS int* tile_e; const LAS int* pt; const LAS int* cnt; const char* A; const char* B; size_t tstep; int brows; const LAS int* tokl; bool gather;
    __device__ __forceinline__ bool next(int i, Unit& u) const {
        const long L = (long)i * G + c; if (L >= (long)MT * nN) return false;
        tile_map((int)L, MT, nN, u.pm, u.pn); const int e = tile_e[u.pm]; u.e = e;
        u.b = B + ((size_t)e * brows + (size_t)u.pn * BM) / BM * tstep;
        if (gather) { u.a = A; u.gtab = tokl + i * BM; u.gcnt = BM; }
        else { u.a = A + (size_t)u.pm * tstep; u.gtab = nullptr; u.gcnt = 0; }
        return true; }
};

template <class Epi, class Sched, bool GATHER, bool FP8 = false, unsigned ASC = 0x7f7f7f7fu>
__device__ __forceinline__ void gemm_phase(LAS unsigned char* lds, const int K, const Sched& S, const Epi& E) {
    const int tid = opaque_tid(), wid = __builtin_amdgcn_readfirstlane(tid >> 6), lane = tid & 63, wr = wid >> 2, wc = wid & 3, fr = lane & 15, fq = lane >> 4;
    const int nt = K / BK;
    unsigned voffA[2], voffB[2]; int RA[2]; unsigned CA2[2];
#pragma unroll
    for (int i = 0; i < 2; ++i) { int R, C; stage_rc(tid * 16 + i * 8192, R, C); voffA[i] = (unsigned)(R * K + C) * 2u; voffB[i] = voffA[i]; RA[i] = R; CA2[i] = (unsigned)C * 2u; }
    const size_t kstep = (size_t)(BK * 2);
    const size_t hstep = (size_t)HALF * K * 2;
    const unsigned ldsw = (unsigned)wid * 1024u;
    const int aoff = lds_byte(wr * 64 + fr, fq * 8), boff = lds_byte(wc * 32 + fr, fq * 8);
#define PG8_SA(b, h) (((b) * 2 + (h)) * HTB)
#define PG8_SB(b, h) ((4 + (b) * 2 + (h)) * HTB)
#define PG8_STAGE(bufoff, gbase, voff) do { _Pragma("unroll") for (int _i = 0; _i < 2; ++_i) \
        __builtin_amdgcn_global_load_lds((const unsigned*)((const char*)(gbase) + (voff)[_i]), (LAS unsigned*)(lds + (bufoff) + ldsw + _i * 8192), 16, 0, 0); } while (0)
#define PG8_STAGE_A(bufoff, gbase, h, NXT) do { if constexpr (GATHER) { unsigned _v[2]; _v[0] = (NXT) ? nv[h][0] : cv[h][0]; _v[1] = (NXT) ? nv[h][1] : cv[h][1]; PG8_STAGE(bufoff, gbase, _v); } \
        else { PG8_STAGE(bufoff, (const char*)(gbase) + (h) * hstep, voffA); } } while (0)
#define PG8_LOADG(u, v) do { _Pragma("unroll") for (int _h = 0; _h < 2; ++_h) _Pragma("unroll") for (int _i = 0; _i < 2; ++_i) { const int _r = _h * HALF + RA[_i]; \
        const int _tok = (u).gtab[_r]; v[_h][_i] = (unsigned)_tok * (unsigned)(K * 2) + CA2[_i]; } } while (0)
#define PG8_LDA(dst, b, h) do { _Pragma("unroll") for (int m = 0; m < 4; ++m) _Pragma("unroll") for (int k = 0; k < 2; ++k) dst[m][k] = *(const LAS bf16x8*)(lds + PG8_SA(b, h) + aoff + m * 2048 + k * 1024); } while (0)
#define PG8_LDB(dst, b, h) do { _Pragma("unroll") for (int n = 0; n < 2; ++n) _Pragma("unroll") for (int k = 0; k < 2; ++k) dst[n][k] = *(const LAS bf16x8*)(lds + PG8_SB(b, h) + boff + n * 2048 + k * 1024); } while (0)
#define PG8_CAT(x) __builtin_shufflevector(__builtin_bit_cast(i32x4_t, x[0]), __builtin_bit_cast(i32x4_t, x[1]), 0, 1, 2, 3, 4, 5, 6, 7)
#define PG8_MMA(ai, bj, At, Bt) do { __builtin_amdgcn_s_setprio(1); if constexpr (FP8) { _Pragma("unroll") for (int m = 0; m < 4; ++m) _Pragma("unroll") for (int n = 0; n < 2; ++n) \
        asm volatile("v_mfma_scale_f32_16x16x128_f8f6f4 %0, %1, %2, %0, %3, %4 op_sel_hi:[0,0,0]" : "+v"(acc[ai][bj][m][n]) : "v"(PG8_CAT(Bt[n])), "v"(PG8_CAT(At[m])), "v"(0x7a7a7a7a), "v"(ASC)); } \
        else { _Pragma("unroll") for (int m = 0; m < 4; ++m) _Pragma("unroll") for (int n = 0; n < 2; ++n) _Pragma("unroll") for (int k = 0; k < 2; ++k) \
        acc[ai][bj][m][n] = __builtin_amdgcn_mfma_f32_16x16x32_bf16(Bt[n][k], At[m][k], acc[ai][bj][m][n], 0, 0, 0); } __builtin_amdgcn_s_setprio(0); } while (0)
#define PG8_WAIT_V(n) asm volatile("s_waitcnt vmcnt(" #n ")" ::: "memory")
#define PG8_WAIT_L(n) asm volatile("s_waitcnt lgkmcnt(" #n ")" ::: "memory")
#define PG8_BAR __builtin_amdgcn_s_barrier()
#define PG8_SCHED __builtin_amdgcn_sched_barrier(0)
    Unit cur, nxt; int ui = 0;
    if (!S.next(0, cur)) return;
    f32x4 acc[2][2][4][2];
#pragma unroll
    for (int a = 0; a < 2; ++a)
#pragma unroll
        for (int b = 0; b < 2; ++b)
#pragma unroll
            for (int m = 0; m < 4; ++m)
#pragma unroll
                for (int n = 0; n < 2; ++n) acc[a][b][m][n] = (f32x4){0.f, 0.f, 0.f, 0.f};
    bf16x8 At[4][2], B0[2][2], B1[2][2];
    unsigned cv[2][2] = {{0u, 0u}, {0u, 0u}}, nv[2][2] = {{0u, 0u}, {0u, 0u}};
    const char* cA = cur.a; const char* cB = cur.b;
    if constexpr (GATHER) { PG8_LOADG(cur, cv); }
    PG8_STAGE(PG8_SB(0, 0), cB, voffB); PG8_STAGE(PG8_SB(0, 1), cB + hstep, voffB); PG8_STAGE_A(PG8_SA(0, 0), cA, 0, false); PG8_STAGE_A(PG8_SA(0, 1), cA, 1, false);
    if (wr == 1) PG8_BAR;
    PG8_WAIT_V(2); PG8_BAR;
    PG8_STAGE(PG8_SB(1, 0), cB + kstep, voffB); PG8_STAGE_A(PG8_SA(1, 0), cA + kstep, 0, false); PG8_STAGE(PG8_SB(1, 1), cB + hstep + kstep, voffB);
    PG8_WAIT_V(6); PG8_BAR;
    for (;;) {
        const bool has_next = S.next(ui + 1, nxt);
        const char* nA = has_next ? nxt.a : cA; const char* nB = has_next ? nxt.b : cB;
        if constexpr (GATHER) {
            if (has_next) { PG8_LOADG(nxt, nv); }
            else {
#pragma unroll
                for (int h = 0; h < 2; ++h)
#pragma unroll
                    for (int i = 0; i < 2; ++i) nv[h][i] = cv[h][i]; }
        }
#pragma clang loop unroll(disable)
        for (int t = 0; t < nt; t += 2) {
            const bool last = (t == nt - 2);
            const char* a1 = cA + (size_t)(t + 1) * kstep;
            const char* a2 = last ? nA : cA + (size_t)(t + 2) * kstep; const char* b2 = last ? nB : cB + (size_t)(t + 2) * kstep;
            const char* a3 = a2 + kstep; const char* b3 = b2 + kstep;
            PG8_LDB(B0, 0, 0); PG8_LDB(B1, 0, 1); PG8_SCHED; PG8_LDA(At, 0, 0); PG8_STAGE_A(PG8_SA(1, 1), a1, 1, false);
            PG8_WAIT_V(8); PG8_WAIT_L(0); PG8_BAR; PG8_MMA(0, 0, At, B0); PG8_MMA(0, 1, At, B1); PG8_BAR; PG8_SCHED;
            PG8_LDA(At, 0, 1); PG8_STAGE(PG8_SB(0, 0), b2, voffB); PG8_STAGE(PG8_SB(0, 1), b2 + hstep, voffB); PG8_STAGE_A(PG8_SA(0, 0), a2, 0, last);
            PG8_WAIT_V(8); PG8_WAIT_L(0); PG8_BAR; PG8_MMA(1, 0, At, B0); PG8_MMA(1, 1, At, B1); PG8_BAR; PG8_SCHED;
            PG8_LDB(B0, 1, 0); PG8_LDB(B1, 1, 1); PG8_SCHED; PG8_LDA(At, 1, 0); PG8_STAGE_A(PG8_SA(0, 1), a2, 1, last);
            PG8_WAIT_V(8); PG8_WAIT_L(0); PG8_BAR; PG8_MMA(0, 0, At, B0); PG8_MMA(0, 1, At, B1); PG8_BAR; PG8_SCHED;
            PG8_LDA(At, 1, 1); PG8_STAGE(PG8_SB(1, 0), b3, voffB); PG8_STAGE(PG8_SB(1, 1), b3 + hstep, voffB); PG8_STAGE_A(PG8_SA(1, 0), a3, 0, last);
            PG8_WAIT_V(8); PG8_WAIT_L(0); PG8_BAR; PG8_MMA(1, 0, At, B0); PG8_MMA(1, 1, At, B1); PG8_BAR; PG8_SCHED;
        }
        if constexpr (FP8) asm volatile("s_nop 15\n\ts_nop 7" ::: "memory");
        if (wr == 0) PG8_BAR;
        bool keep = false;
        if constexpr (Epi::PAIR_KEEP) keep = (cur.e == 0);
        if constexpr (Epi::PAIR_KEEP) { if (keep) E.rescale(acc, cur, wr, wc, fr, fq); else E(acc, cur, wr, wc, fr, fq); } else E(acc, cur, wr, wc, fr, fq);
        if (!has_next) break;
        if (!keep) {
#pragma unroll
        for (int a = 0; a < 2; ++a)
#pragma unroll
            for (int b = 0; b < 2; ++b)
#pragma unroll
                for (int m = 0; m < 4; ++m)
#pragma unroll
                    for (int n = 0; n < 2; ++n) acc[a][b][m][n] = (f32x4){0.f, 0.f, 0.f, 0.f};
        }
        cur = nxt; cA = nA; cB = nB; ++ui;
        if constexpr (GATHER) {
#pragma unroll
            for (int h = 0; h < 2; ++h)
#pragma unroll
                for (int i = 0; i < 2; ++i) cv[h][i] = nv[h][i]; }
        if (wr == 1) PG8_BAR;
    }
    PG8_WAIT_V(0);
    PG8_BAR;
#undef PG8_SA
#undef PG8_SB
#undef PG8_STAGE
#undef PG8_STAGE_A
#undef PG8_LOADG
#undef PG8_LDA
#undef PG8_LDB
#undef PG8_MMA
#undef PG8_CAT
#undef PG8_WAIT_V
#undef PG8_WAIT_L
#undef PG8_BAR
#undef PG8_SCHED
}
}

namespace epi {
using pg8::Unit;
__device__ __forceinline__ u32x4 pack8(const f32x4& a, const f32x4& b) { u32x4 w; w.x = cvt_pk_bf16(a[0], a[1]); w.y = cvt_pk_bf16(a[2], a[3]); w.z = cvt_pk_bf16(b[0], b[1]); w.w = cvt_pk_bf16(b[2], b[3]); return w; }
__device__ __forceinline__ void unpack8(const u32x4& w, float (&f)[8]) { f[0] = bf_lo(w.x); f[1] = bf_hi(w.x); f[2] = bf_lo(w.y); f[3] = bf_hi(w.y); f[4] = bf_lo(w.z); f[5] = bf_hi(w.z); f[6] = bf_lo(w.w); f[7] = bf_hi(w.w); }
__device__ __forceinline__ float sigmoidf_(float z) { return __builtin_amdgcn_rcpf(1.0f + __expf(-z)); }

struct EpiIn {
    static constexpr bool PAIR_KEEP = false;
    bf16_t *QA, *KA, *VA, *QF, *KF, *VF; unsigned char* GT; const int* pos; const float *qn_s, *kn_s, *qn_f, *kn_f, *b_gate;
    __device__ __forceinline__ void operator()(const f32x4 (&acc)[2][2][4][2], const Unit& u, int wr, int wc, int fr, int fq) const {
        const int pn = u.pn; const int row0 = u.pm * 256 + wr * 64 + fr;
        if (pn >= 9) {
            const int col0 = (pn - 9) * 256 + wc * 64 + 16 * fq;
            f32x4 bv[2][2];
#pragma unroll
            for (int bj = 0; bj < 2; ++bj)
#pragma unroll
                for (int n = 0; n < 2; ++n) bv[bj][n] = *(const f32x4*)(b_gate + col0 + bj * 8 + 4 * n) * (-LOG2E);
#pragma unroll
            for (int ai = 0; ai < 2; ++ai)
#pragma unroll
                for (int m = 0; m < 4; ++m) { u32x4 w;
#pragma unroll
                    for (int bj = 0; bj < 2; ++bj)
#pragma unroll
                        for (int n = 0; n < 2; ++n) { const f32x4 v = acc[ai][bj][m][n]; unsigned r = 0;
#pragma unroll
                            for (int i = 0; i < 4; ++i) { const float sg = __builtin_amdgcn_rcpf(1.0f + __builtin_amdgcn_exp2f(__builtin_fmaf(v[i], -LOG2E, bv[bj][n][i])));
                                r = __builtin_amdgcn_cvt_pk_u8_f32(__builtin_fmaf(sg, 255.0f, 0.5f), i, r); }
                            w[2 * bj + n] = r; }
                    *(u32x4*)(GT + (size_t)(row0 + ai * 128 + m * 16) * 2048 + col0) = w; }
            return;
        }
        bf16_t* dst; int pitch, hcol; const float* nw; bool rope; float scale;
        if (pn < 2)       { dst = QA; pitch = 512; hcol = (4 * pn + wc) * 64; nw = qn_s; rope = true; scale = C2; }
        else if (pn == 2) { if (wc < 2) { dst = KA; pitch = 128; hcol = wc * 64; nw = kn_s; rope = true; scale = 1.f; } else { dst = VA; pitch = 128; hcol = (wc - 2) * 64; nw = nullptr; rope = false; scale = 1.f; } }
        else if (pn < 5)  { dst = QF; pitch = 512; hcol = (4 * (pn - 3) + wc) * 64; nw = qn_f; rope = false; scale = C2; }
        else if (pn < 7)  { dst = KF; pitch = 512; hcol = (4 * (pn - 5) + wc) * 64; nw = kn_f; rope = false; scale = 1.f; }
        else              { dst = VF; pitch = 512; hcol = (4 * (pn - 7) + wc) * 64; nw = nullptr; rope = false; scale = 1.f; }
        f32x4 wv[2][2]; float inv[2][4];
#pragma unroll
        for (int bj = 0; bj < 2; ++bj)
#pragma unroll
            for (int n = 0; n < 2; ++n) { wv[bj][n] = nw ? *(const f32x4*)(nw + 32 * bj + 8 * fq + 4 * n) : (f32x4){1.f, 1.f, 1.f, 1.f}; wv[bj][n] = wv[bj][n] * scale; }
#pragma unroll
        for (int n = 0; n < 2; ++n)
#pragma unroll
            for (int i = 0; i < 4; ++i) inv[n][i] = exp2f(-(float)(8 * fq + 4 * n + i) * (13.287712379549449f / 32.0f)) * 0.15915494309189535f;
        float posf[8];
#pragma unroll
        for (int g = 0; g < 8; ++g) posf[g] = rope ? (float)pos[row0 + (g >> 2) * 128 + (g & 3) * 16] : 0.f;
#pragma unroll
        for (int ai = 0; ai < 2; ++ai)
#pragma unroll
            for (int m = 0; m < 4; ++m) {
                const int row = row0 + ai * 128 + m * 16;
                f32x4 v[2][2];
#pragma unroll
                for (int bj = 0; bj < 2; ++bj)
#pragma unroll
                    for (int n = 0; n < 2; ++n) v[bj][n] = acc[ai][bj][m][n];
                if (nw) {
                    float ss = 0.f;
#pragma unroll
                    for (int bj = 0; bj < 2; ++bj)
#pragma unroll
                        for (int n = 0; n < 2; ++n) ss += (v[bj][n][0] * v[bj][n][0] + v[bj][n][1] * v[bj][n][1]) + (v[bj][n][2] * v[bj][n][2] + v[bj][n][3] * v[bj][n][3]);
                    ss += __shfl_xor(ss, 16); ss += __shfl_xor(ss, 32);
                    const float rstd = rsqrtf(ss * (1.0f / 64.0f) + EPS);
#pragma unroll
                    for (int bj = 0; bj < 2; ++bj)
#pragma unroll
                        for (int n = 0; n < 2; ++n) v[bj][n] = v[bj][n] * rstd * wv[bj][n];
                }
                if (rope) {
                    const float p = posf[ai * 4 + m];
#pragma unroll
                    for (int n = 0; n < 2; ++n)
#pragma unroll
                        for (int i = 0; i < 4; ++i) { float rev = p * inv[n][i]; rev = rev - floorf(rev); const float sn = __builtin_amdgcn_sinf(rev), cs = __builtin_amdgcn_cosf(rev);
                            const float x1 = v[0][n][i], x2 = v[1][n][i]; v[0][n][i] = x1 * cs - x2 * sn; v[1][n][i] = x2 * cs + x1 * sn; }
                }
                bf16_t* rowp = dst + (size_t)row * pitch + hcol + 8 * fq;
                *(u32x4*)(rowp) = pack8(v[0][0], v[0][1]);
                *(u32x4*)(rowp + 32) = pack8(v[1][0], v[1][1]);
            }
    }
};

struct EpiMerge {
    static constexpr bool PAIR_KEEP = (P3B_FP8 != 0);
    const unsigned char* GT; bf16_t* MG; unsigned char* MG8;
    __device__ __forceinline__ void rescale(f32x4 (&acc)[2][2][4][2], const Unit& u, int wr, int wc, int fr, int fq) const {
        const int row0 = u.pm * 256 + wr * 64 + fr, col0 = u.pn * 256 + wc * 32 + 8 * fq;
#pragma unroll
        for (int hf = 0; hf < 2; ++hf) {
            u32x2 ga8[4][2], gb8[4][2];
#pragma unroll
            for (int m = 0; m < 4; ++m)
#pragma unroll
                for (int bj = 0; bj < 2; ++bj) { const unsigned char* p = GT + (size_t)(row0 + hf * 128 + m * 16) * 2048 + col0 + bj * 128; ga8[m][bj] = *(const u32x2*)p; gb8[m][bj] = *(const u32x2*)(p + 1024); }
#pragma unroll
            for (int m = 0; m < 4; ++m)
#pragma unroll
                for (int bj = 0; bj < 2; ++bj)
#pragma unroll
                    for (int n = 0; n < 2; ++n) { const unsigned ga = n ? ga8[m][bj].y : ga8[m][bj].x, gb = n ? gb8[m][bj].y : gb8[m][bj].x;
#pragma unroll
                        for (int i = 0; i < 4; ++i) acc[hf][bj][m][n][i] *= (float)((ga >> (8 * i)) & 255u) * __builtin_amdgcn_rcpf(fmaxf((float)((gb >> (8 * i)) & 255u), 0.5f)); }
            __builtin_amdgcn_sched_barrier(0);
        }
    }
    __device__ __forceinline__ void operator()(const f32x4 (&acc)[2][2][4][2], const Unit& u, int wr, int wc, int fr, int fq) const {
        const int row0 = u.pm * 256 + wr * 64 + fr, col0 = u.pn * 256 + wc * 32 + 8 * fq, part = u.e;
        if constexpr (PAIR_KEEP) {
            u32x2 gb8[8][2];
#pragma unroll
            for (int g = 0; g < 8; ++g)
#pragma unroll
                for (int bj = 0; bj < 2; ++bj) gb8[g][bj] = *(const u32x2*)(GT + (size_t)(row0 + (g >> 2) * 128 + (g & 3) * 16) * 2048 + 1024 + col0 + bj * 128);
            asm volatile("" ::: "memory");
#pragma unroll
            for (int g = 0; g < 8; ++g)
#pragma unroll
                for (int bj = 0; bj < 2; ++bj) { float f[8];
#pragma unroll
                    for (int n = 0; n < 2; ++n) { const unsigned gb = n ? gb8[g][bj].y : gb8[g][bj].x; const f32x4 v = acc[g >> 2][bj][g & 3][n];
#pragma unroll
                        for (int i = 0; i < 4; ++i) f[4 * n + i] = v[i] * (fmaxf((float)((gb >> (8 * i)) & 255u), 0.5f) * (32.0f / 255.0f)); }
                    u32x2 w8; w8.x = pk4_fp8(f[0], f[1], f[2], f[3]); w8.y = pk4_fp8(f[4], f[5], f[6], f[7]);
                    *(u32x2*)(MG8 + (size_t)(row0 + (g >> 2) * 128 + (g & 3) * 16) * 1024 + col0 + bj * 128) = w8; }
            return;
        }
        u32x2 g8[8][2]; u32x4 mg[8][2];
#define EM_ROW(g) (row0 + ((g) >> 2) * 128 + ((g) & 3) * 16)
#define EM_LDMG(g) do { _Pragma("unroll") for (int bj = 0; bj < 2; ++bj) mg[g][bj] = part ? *(const u32x4*)(MG + (size_t)EM_ROW(g) * 1024 + col0 + bj * 128) : (u32x4){0u, 0u, 0u, 0u}; } while (0)
#pragma unroll
        for (int g = 0; g < 8; ++g)
#pragma unroll
            for (int bj = 0; bj < 2; ++bj) g8[g][bj] = *(const u32x2*)(GT + (size_t)EM_ROW(g) * 2048 + part * 1024 + col0 + bj * 128);
        EM_LDMG(0); EM_LDMG(1);
        asm volatile("" ::: "memory");
#pragma unroll
        for (int g = 0; g < 8; ++g) {
            u32x4 ov[2];
#pragma unroll
            for (int bj = 0; bj < 2; ++bj) { const unsigned ga = g8[g][bj].x, gb = g8[g][bj].y; float o[8]; unpack8(mg[g][bj], o);
                f32x4 v0 = acc[g >> 2][bj][g & 3][0], v1 = acc[g >> 2][bj][g & 3][1];
#pragma unroll
                for (int i = 0; i < 4; ++i) { v0[i] = v0[i] * ((float)((ga >> (8 * i)) & 255u) * (1.0f / 255.0f)) + o[i]; v1[i] = v1[i] * ((float)((gb >> (8 * i)) & 255u) * (1.0f / 255.0f)) + o[4 + i]; }
                ov[bj] = pack8(v0, v1); }
            if (g + 2 < 8) { EM_LDMG(g + 2); }
            asm volatile("" ::: "memory");
#pragma unroll
            for (int bj = 0; bj < 2; ++bj) {
                if (P3B_FP8 && part) { float f[8]; unpack8(ov[bj], f); u32x2 w8; w8.x = pk4_fp8(f[0] * 32.0f, f[1] * 32.0f, f[2] * 32.0f, f[3] * 32.0f); w8.y = pk4_fp8(f[4] * 32.0f, f[5] * 32.0f, f[6] * 32.0f, f[7] * 32.0f);
                    *(u32x2*)(MG8 + (size_t)EM_ROW(g) * 1024 + col0 + bj * 128) = w8; }
                else *(u32x4*)(MG + (size_t)EM_ROW(g) * 1024 + col0 + bj * 128) = ov[bj]; }
            asm volatile("" ::: "memory");
        }
#undef EM_ROW
#undef EM_LDMG
    }
};

struct EpiResid {
    static constexpr bool PAIR_KEEP = false;
    const float* X; bf16_t* O; const bf16_t* XN; const float* RMS; const float* G1; bool rec;
    __device__ __forceinline__ void operator()(const f32x4 (&acc)[2][2][4][2], const Unit& u, int wr, int wc, int fr, int fq) const {
        const int row0 = u.pm * 256 + wr * 64 + fr, col0 = u.pn * 256 + wc * 32 + 8 * fq;
#define ER_OFF(g) ((size_t)(row0 + ((g) >> 2) * 128 + ((g) & 3) * 16) * 1024 + col0)
        if (XREC != 0 && rec) {
            u32x4 xn[8][2]; float rm[8]; f32x4 ig[2][2];
#define XR_LD(g) do { rm[g] = RMS[row0 + ((g) >> 2) * 128 + ((g) & 3) * 16]; _Pragma("unroll") for (int bj = 0; bj < 2; ++bj) xn[g][bj] = *(const u32x4*)(XN + ER_OFF(g) + bj * 128); } while (0)
#pragma unroll
            for (int bj = 0; bj < 2; ++bj)
#pragma unroll
                for (int n = 0; n < 2; ++n) { const f32x4 gg = *(const f32x4*)(G1 + col0 + bj * 128 + 4 * n);
#pragma unroll
                    for (int i = 0; i < 4; ++i) ig[bj][n][i] = __builtin_amdgcn_rcpf(gg[i]); }
            XR_LD(0); XR_LD(1); XR_LD(2);
            asm volatile("" ::: "memory");
#pragma unroll
            for (int g = 0; g < 8; ++g) {
                u32x4 ov[2];
#pragma unroll
                for (int bj = 0; bj < 2; ++bj) { float f[8]; unpack8(xn[g][bj], f); f32x4 v0, v1;
#pragma unroll
                    for (int i = 0; i < 4; ++i) { v0[i] = __builtin_fmaf(f[i] * rm[g], ig[bj][0][i], acc[g >> 2][bj][g & 3][0][i]); v1[i] = __builtin_fmaf(f[4 + i] * rm[g], ig[bj][1][i], acc[g >> 2][bj][g & 3][1][i]); }
                    ov[bj] = pack8(v0, v1); }
                if (g + 3 < 8) { XR_LD(g + 3); }
                asm volatile("" ::: "memory");
#pragma unroll
                for (int bj = 0; bj < 2; ++bj) *(u32x4*)(O + ER_OFF(g) + bj * 128) = ov[bj];
                asm volatile("" ::: "memory");
            }
#undef XR_LD
        } else {
        f32x4 xr[8][2][2];
#define ER_LD(g) do { _Pragma("unroll") for (int bj = 0; bj < 2; ++bj) _Pragma("unroll") for (int n = 0; n < 2; ++n) xr[g][bj][n] = *(const f32x4*)(X + ER_OFF(g) + bj * 128 + n * 4); } while (0)
        ER_LD(0); ER_LD(1); ER_LD(2);
        asm volatile("" ::: "memory");
#pragma unroll
        for (int g = 0; g < 8; ++g) {
            u32x4 ov[2];
#pragma unroll
            for (int bj = 0; bj < 2; ++bj) ov[bj] = pack8(xr[g][bj][0] + acc[g >> 2][bj][g & 3][0], xr[g][bj][1] + acc[g >> 2][bj][g & 3][1]);
            if (g + 3 < 8) { ER_LD(g + 3); }
            asm volatile("" ::: "memory");
#pragma unroll
            for (int bj = 0; bj < 2; ++bj) *(u32x4*)(O + ER_OFF(g) + bj * 128) = ov[bj];
            asm volatile("" ::: "memory");
        }
#undef ER_LD
        }
#undef ER_OFF
    }
};

struct EpiSwiglu {
    static constexpr bool PAIR_KEEP = false;
    const float* bgu; unsigned char* ACT;
    __device__ __forceinline__ void operator()(const f32x4 (&acc)[2][2][4][2], const Unit& u, int wr, int wc, int fr, int fq) const {
        const int row0 = u.pm * 256 + wr * 64 + fr, f0 = u.pn * 128 + wc * 32 + 8 * fq; const float* be = bgu + (size_t)u.e * 2048;
        f32x4 bg[2], bu[2];
#pragma unroll
        for (int n = 0; n < 2; ++n) { bg[n] = *(const f32x4*)(be + f0 + 4 * n); bu[n] = *(const f32x4*)(be + 1024 + f0 + 4 * n) + 1.0f; }
#pragma unroll
        for (int ai = 0; ai < 2; ++ai)
#pragma unroll
            for (int m = 0; m < 4; ++m) { f32x4 o[2];
#pragma unroll
                for (int n = 0; n < 2; ++n) { const f32x4 g = acc[ai][0][m][n] + bg[n], uu = acc[ai][1][m][n] + bu[n];
#pragma unroll
                    for (int i = 0; i < 4; ++i) { const float gc = fminf(g[i], 7.0f), up = __builtin_amdgcn_fmed3f(uu[i], -6.0f, 8.0f);
                        o[n][i] = up * (gc * __builtin_amdgcn_rcpf(1.0f + __builtin_amdgcn_exp2f(gc * (-1.702f * LOG2E)))); } }
                u32x2 w; w.x = pk4_fp8_nc(o[0][0], o[0][1], o[0][2], o[0][3]); w.y = pk4_fp8_nc(o[1][0], o[1][1], o[1][2], o[1][3]); *(u32x2*)(ACT + (size_t)(row0 + ai * 128 + m * 16) * 1024 + f0) = w; }
    }
};

struct EpiDown {
    static constexpr bool PAIR_KEEP = false;
    const float* bd; unsigned char* YB;
    __device__ __forceinline__ void operator()(const f32x4 (&acc)[2][2][4][2], const Unit& u, int wr, int wc, int fr, int fq) const {
        const int row0 = u.pm * 256 + wr * 64 + fr, col0 = u.pn * 256 + wc * 64 + 16 * fq; const float* be = bd + (size_t)u.e * 1024;
        f32x4 bv[2][2];
#pragma unroll
        for (int bj = 0; bj < 2; ++bj)
#pragma unroll
            for (int n = 0; n < 2; ++n) bv[bj][n] = *(const f32x4*)(be + col0 + bj * 8 + 4 * n);
#pragma unroll
        for (int ai = 0; ai < 2; ++ai)
#pragma unroll
            for (int m = 0; m < 4; ++m) { u32x4 w;
                { const f32x4 v0 = acc[ai][0][m][0] + bv[0][0], v1 = acc[ai][0][m][1] + bv[0][1]; w.x = pk4_fp8(v0[0], v0[1], v0[2], v0[3]); w.y = pk4_fp8(v1[0], v1[1], v1[2], v1[3]); }
                { const f32x4 v0 = acc[ai][1][m][0] + bv[1][0], v1 = acc[ai][1][m][1] + bv[1][1]; w.z = pk4_fp8(v0[0], v0[1], v0[2], v0[3]); w.w = pk4_fp8(v1[0], v1[1], v1[2], v1[3]); }
                *(u32x4*)(YB + (size_t)(row0 + ai * 128 + m * 16) * 1024 + col0) = w; }
    }
};
}

namespace attn_body {
using bf16 = __hip_bfloat16;
constexpr int QP = 512;
constexpr int NW = 8, QBLK = 32, QB = QBLK * NW, KVBLK = 64;
constexpr float NEGV = -1.0e30f;
__device__ __forceinline__ int crow(int r, int hi) { return (r & 3) + 8 * (r >> 2) + 4 * hi; }
#define SBAR() __builtin_amdgcn_sched_barrier(0)
__device__ __forceinline__ void cmask(f32x16& p0, f32x16& p1, int jb, int qrel, int hi) {
    int d = qrel - (64 * jb + 4 * hi); asm volatile("" : "+v"(d));
#pragma unroll
    for (int r = 0; r < 16; ++r) { const int c = (r & 3) + 8 * (r >> 2); if (d < c) p0[r] = NEGV; if (d < c + 32) p1[r] = NEGV; }
}
__device__ __forceinline__ void wmask(f32x16& p0, f32x16& p1, int jb, int qrel, int hi) {
    int d = qrel - (64 * jb + 4 * hi); asm volatile("" : "+v"(d));
#pragma unroll
    for (int r = 0; r < 16; ++r) { const int c = (r & 3) + 8 * (r >> 2); if ((unsigned)(d - c) > 127u) p0[r] = NEGV; if ((unsigned)(d - c - 32) > 127u) p1[r] = NEGV; }
}
constexpr int NSLOT = 3, SLOTB = 8192;
constexpr int LDS_K = 0, LDS_V = NSLOT * SLOTB, LDS_WS = 2 * NSLOT * SLOTB, LDS_OST = LDS_WS + NW * 64 * 4, LDS_NCS = LDS_OST + NW * 4096, LDS_BYTES = LDS_NCS + SEQ * 4;
__device__ __forceinline__ void glds16(const void* gsrc, unsigned lds_dst) { unsigned keep;
    asm volatile("s_mov_b32 %0, m0\n\ts_mov_b32 m0, %2\n\ts_nop 0\n\tglobal_load_lds_dwordx4 %1, off\n\ts_mov_b32 m0, %0" : "=&s"(keep) : "v"(gsrc), "s"(lds_dst) : "memory"); }
#define WAIT_BAR(N) asm volatile("s_waitcnt vmcnt(" #N ") lgkmcnt(0)\n\ts_barrier" ::: "memory")
typedef LAS const char* lds_cptr;
typedef short v4i16_t __attribute__((ext_vector_type(4)));
__device__ __forceinline__ void kload8(bf16x8* kf, lds_cptr kp) {
    kf[0] = *(const LAS bf16x8*)(kp);        kf[1] = *(const LAS bf16x8*)(kp + 512);
    kf[2] = *(const LAS bf16x8*)(kp + 2048); kf[3] = *(const LAS bf16x8*)(kp + 2560);
    kf[4] = *(const LAS bf16x8*)(kp + 4096); kf[5] = *(const LAS bf16x8*)(kp + 4608);
    kf[6] = *(const LAS bf16x8*)(kp + 6144); kf[7] = *(const LAS bf16x8*)(kp + 6656);
}
__device__ __forceinline__ void kload2(bf16x8* kf, lds_cptr kp, int j) { kf[2 * j] = *(const LAS bf16x8*)(kp + j * 2048); kf[2 * j + 1] = *(const LAS bf16x8*)(kp + j * 2048 + 512); }
__device__ __forceinline__ s16x4 vtr(lds_cptr p) { return __builtin_bit_cast(s16x4, __builtin_amdgcn_ds_read_tr16_b64_v4i16((LAS v4i16_t*)p)); }
#define MX3(a, b, c) __builtin_fmaxf(__builtin_fmaxf((a), (b)), (c))
__device__ __forceinline__ float rowmax(const f32x16& p0, const f32x16& p1) {
    float a = MX3(p0[0], p0[1], p1[0]), b = MX3(p0[2], p0[3], p1[1]); a = MX3(a, p1[2], p1[3]);
#pragma unroll
    for (int r = 4; r < 16; r += 4) { a = MX3(a, p0[r], p0[r + 1]); b = MX3(b, p0[r + 2], p0[r + 3]); a = MX3(a, p1[r], p1[r + 1]); b = MX3(b, p1[r + 2], p1[r + 3]); }
    const float m = __builtin_fmaxf(a, b); auto rr = __builtin_amdgcn_permlane32_swap(__float_as_uint(m), __float_as_uint(m), false, false);
    return __builtin_fmaxf(__uint_as_float(rr[0]), __uint_as_float(rr[1]));
}
__device__ __forceinline__ void cinit_half(f32x16& c, float rowt, const LAS float* nc) {
#pragma unroll
    for (int g = 0; g < 4; ++g) { const f32x4 a = *(const LAS f32x4*)(nc + 8 * g);
#pragma unroll
        for (int j = 0; j < 4; ++j) c[4 * g + j] = rowt + a[j]; }
}
__device__ __forceinline__ void pv(f32x16* o, int vb, bf16x8 pa0, bf16x8 pa1, bf16x8 pa2, bf16x8 pa3) {
#pragma unroll
    for (int d0 = 0; d0 < 2; ++d0) { s16x4 lo[4], hi[4];
#pragma unroll
        for (int ks = 0; ks < 4; ++ks) {
            asm volatile("ds_read_b64_tr_b16 %0,%1 offset:%c2" : "=&v"(lo[ks]) : "v"(vb), "i"(d0 * 4096 + ks * 1024) : "memory");
            asm volatile("ds_read_b64_tr_b16 %0,%1 offset:%c2" : "=&v"(hi[ks]) : "v"(vb), "i"(d0 * 4096 + ks * 1024 + 512) : "memory"); }
        asm volatile("s_waitcnt lgkmcnt(0)" ::: "memory"); SBAR();
#define PK(k) (bf16x8){lo[k][0], lo[k][1], lo[k][2], lo[k][3], hi[k][0], hi[k][1], hi[k][2], hi[k][3]}
        o[d0] = __builtin_amdgcn_mfma_f32_32x32x16_bf16(pa0, PK(0), o[d0], 0, 0, 0);
        o[d0] = __builtin_amdgcn_mfma_f32_32x32x16_bf16(pa1, PK(1), o[d0], 0, 0, 0);
        o[d0] = __builtin_amdgcn_mfma_f32_32x32x16_bf16(pa2, PK(2), o[d0], 0, 0, 0);
        o[d0] = __builtin_amdgcn_mfma_f32_32x32x16_bf16(pa3, PK(3), o[d0], 0, 0, 0);
#undef PK
    }
}

struct NextU { const bf16* Kh; const bf16* Vh; const float* ncsg; int KP, t0, qb; };
__device__ __forceinline__ void prime_unit(const bf16* Kh, const bf16* Vh, const int KP, const int t0, const float* ncsg, const int qb, const unsigned lds0, const int lane, const int wid) {
    const bf16* ksrc = Kh + (long)(t0 * KVBLK + lane) * KP + wid * 8;
    const bf16* vsrc = Vh + (long)(t0 * KVBLK + 16 * (wid & 3) + (lane >> 2)) * KP + (wid >> 2) * 32 + (lane & 3) * 8;
    const unsigned kdst = lds0 + LDS_K + wid * 1024, vdst = lds0 + LDS_V + wid * 1024;
    glds16(ksrc, (unsigned)__builtin_amdgcn_readfirstlane(kdst)); glds16(vsrc, (unsigned)__builtin_amdgcn_readfirstlane(vdst)); glds16(ksrc + (long)KVBLK * KP, (unsigned)__builtin_amdgcn_readfirstlane(kdst + SLOTB));
    if (ncsg != nullptr) for (int i = (t0 >> 2) + wid; i <= qb; i += NW) glds16((const char*)ncsg + i * 1024 + lane * 16, (unsigned)__builtin_amdgcn_readfirstlane(lds0 + LDS_NCS + i * 1024));
}
struct P2Dec {
    const bf16 *KF, *VF, *KA, *VA; const float* NCS; const LAS int* ordl;
    static constexpr int QPOS = 2048 + 1536;
    __device__ __forceinline__ static int unit_of(int p) { if (p < 2048) return (p & 1) ? -1 : (p >> 1); const int q = p - 2048, pq = q / 3, pr = q - 3 * pq; return pr == 2 ? -1 : 1024 + 2 * pq + pr; }
    __device__ __forceinline__ static int chunk_of(int p) { return p < 2048 ? (p >> 1) : 1024 + (p - 2048) / 3; }
    __device__ __forceinline__ NextU next(int p) const {
        NextU nx; nx.Kh = nullptr; nx.Vh = nullptr; nx.ncsg = nullptr; nx.KP = 0; nx.t0 = 0; nx.qb = 0;
        if (p >= QPOS) return nx;
        const int idx = unit_of(p);
        if (idx < 0) return nx;
        if (idx < 1024) { const int od = __builtin_amdgcn_readfirstlane(ordl[idx]), u = od & 0xffff, bh = u >> 5, b = bh >> 3, h = bh & 7;
            nx.Kh = KF + (size_t)b * SEQ * 512 + h * 64; nx.Vh = VF + (size_t)b * SEQ * 512 + h * 64; nx.ncsg = NCS + (size_t)bh * SEQ; nx.KP = 512; nx.t0 = od >> 16; nx.qb = u & 31; }
        else { const int u = idx - 1024, bk = u >> 7, qb = 127 - (u & 127), b = bk >> 1, kvh = bk & 1;
            nx.Kh = KA + (size_t)b * SEQ * 128 + kvh * 64; nx.Vh = VA + (size_t)b * SEQ * 128 + kvh * 64; nx.KP = 128; nx.t0 = qb < 2 ? 0 : qb - 2; nx.qb = qb; }
        return nx; }
};
template <int MODE, int THRL, bool TRK> __device__ __forceinline__ void attn_unit(int qb, int t0f, const bf16* Qh, const bf16* __restrict__ Kh, const bf16* __restrict__ Vh, bf16* Oh, const int KP, const float sinkl2, char* shm, const float* ncsg, const bool primed, const NextU nx1, const int pos1, const P2Dec& dec, volatile LAS int* qslot, const int qval, int& pos2, int& primed_pos) {
    const int tid = opaque_tid(), lane = tid & 63, r32 = lane & 31, hi = lane >> 5; const int wid = __builtin_amdgcn_readfirstlane(tid >> 6);
    const int q0 = MODE == 1 ? qb * 64 : qb * QB;
    const int t0 = (MODE == 1) ? (qb < 2 ? 0 : qb - 2) : t0f;
    const int NT = MODE == 1 ? 3 : (q0 + QB) / KVBLK - t0;
    const int wrow = MODE == 1 ? (wid & 1) * QBLK : wid * QBLK, wcol = MODE == 1 ? (wid >> 1) * 64 : 0;
    const int jdiag = MODE == 1 ? qb - t0 : NT - 4;
    const bf16* Qw = Qh + (long)(q0 + wrow) * QP + wcol;
    const unsigned lds0 = (unsigned)(uintptr_t)shm;
    float* wsf = (float*)(shm + LDS_WS) + wid * 64;
    const bf16* ksrc = Kh + (long)(t0 * KVBLK + lane) * KP + wid * 8;
    const bf16* vsrc = Vh + (long)(t0 * KVBLK + 16 * (wid & 3) + (lane >> 2)) * KP + (wid >> 2) * 32 + (lane & 3) * 8;
    const unsigned kdst = lds0 + LDS_K + wid * 1024, vdst = lds0 + LDS_V + wid * 1024;
    const long tstride = (long)KVBLK * KP;
#define DMA_K(t, slot) glds16(ksrc + (long)(t) * tstride, (unsigned)__builtin_amdgcn_readfirstlane(kdst + (slot)))
#define DMA_V(t, slot) glds16(vsrc + (long)(t) * tstride, (unsigned)__builtin_amdgcn_readfirstlane(vdst + (slot)))
    const int vb0 = (int)(lds0 + LDS_V) + ((lane >> 4) & 1) * 32 + (lane & 3) * 8 + (4 * hi + ((lane & 15) >> 2)) * 64;
    const char* Kbase = shm + LDS_K; bf16x8 kf[8];
    const lds_cptr shm3 = (lds_cptr)shm; const lds_cptr kp0 = shm3 + LDS_K + hi * 1024 + r32 * 16; const lds_cptr vp0 = shm3 + LDS_V + ((lane >> 4) & 1) * 32 + (lane & 3) * 8 + (4 * hi + ((lane & 15) >> 2)) * 64;
    const LAS float* ncs = (const LAS float*)(shm3 + LDS_NCS) + t0 * 64 + 4 * hi;
    if (!primed) prime_unit(Kh, Vh, KP, t0, MODE == 0 ? ncsg : nullptr, qb, lds0, lane, wid);
    bf16x8 qr[4]; float mhat;
    { bf16x8 kd[4];
#pragma unroll
      for (int d0 = 0; d0 < 4; ++d0) { qr[d0] = *reinterpret_cast<const bf16x8*>(&Qw[(long)r32 * QP + d0 * 16 + hi * 8]); kd[d0] = *reinterpret_cast<const bf16x8*>(&Kh[(long)(q0 + wrow + r32) * KP + d0 * 16 + hi * 8]); }
      float dg = 0.f;
#pragma unroll
      for (int d0 = 0; d0 < 4; ++d0)
#pragma unroll
          for (int j = 0; j < 8; ++j) dg += bf2f(qr[d0][j]) * bf2f(kd[d0][j]);
      auto rr = __builtin_amdgcn_permlane32_swap(__float_as_uint(dg), __float_as_uint(dg), false, false);
      mhat = __uint_as_float(rr[0]) + __uint_as_float(rr[1]); }
    float rowt = -mhat;
#define CI0(C, t) do { if constexpr (MODE == 0) { cinit_half(C, rowt, ncs + (t) * 64); } else { _Pragma("unroll") for (int r = 0; r < 16; ++r) C[r] = rowt; } } while (0)
#define CI1(C, t) do { if constexpr (MODE == 0) { cinit_half(C, rowt, ncs + (t) * 64 + 32); } else { _Pragma("unroll") for (int r = 0; r < 16; ++r) C[r] = rowt; } } while (0)
#define CSRC(C) (C)
#define NEWREF() do { rowt -= dl; } while (0)
    float l_reg = 0.f; f32x16 o[2]; o[0] = f32x16{}; o[1] = f32x16{};
    const int qrel = wrow + r32;
#define CMASK(P0, P1, t) do { const int jb_ = (t) - jdiag; if (MODE == 1) wmask(P0, P1, jb_, qrel, hi); else if (jb_ >= 0) cmask(P0, P1, jb_, qrel, hi); } while (0)
    bool resc = false;
#define RESC() do { if constexpr (TRK) if (resc) { asm volatile("s_waitcnt lgkmcnt(0)" ::: "memory"); \
      _Pragma("unroll") for (int d_ = 0; d_ < 2; ++d_) _Pragma("unroll") for (int r = 0; r < 16; ++r) o[d_][r] *= wsf[crow(r, hi)]; } } while (0)
    f32x16 pA0, pA1, pB0, pB1;
    int sl_prev = 0, sl_cur = 0, sl_next = SLOTB;
#define ROT() do { sl_prev = sl_cur; sl_cur = sl_next; sl_next = (sl_next == (NSLOT - 1) * SLOTB) ? 0 : sl_next + SLOTB; } while (0)
    DMA_K(2, 2 * SLOTB);
    WAIT_BAR(3);
    if constexpr (MODE == 0) rowt -= ((const LAS float*)(shm3 + LDS_NCS))[q0 + wid * QBLK + r32];
    CI0(pA0, 0); CI1(pA1, 0);
    { const char* kb = Kbase + hi * 1024 + r32 * 16;
#pragma unroll
      for (int d0 = 0; d0 < 4; ++d0) {
          const bf16x8 b0 = *reinterpret_cast<const bf16x8*>(kb + d0 * 2048);
          const bf16x8 b1 = *reinterpret_cast<const bf16x8*>(kb + d0 * 2048 + 512);
          if (d0 == 0) { pA0 = __builtin_amdgcn_mfma_f32_32x32x16_bf16(b0, qr[0], CSRC(pA0), 0, 0, 0); pA1 = __builtin_amdgcn_mfma_f32_32x32x16_bf16(b1, qr[0], CSRC(pA1), 0, 0, 0); }
          else { pA0 = __builtin_amdgcn_mfma_f32_32x32x16_bf16(b0, qr[d0], pA0, 0, 0, 0); pA1 = __builtin_amdgcn_mfma_f32_32x32x16_bf16(b1, qr[d0], pA1, 0, 0, 0); } } }
    CMASK(pA0, pA1, 0);
    if constexpr (TRK) { const float rm = rowmax(pA0, pA1);
      if (__builtin_expect(__any(rm > (float)THRL), 0)) { const float dl = __builtin_fmaxf(rm, 0.f); mhat += dl; NEWREF();
          _Pragma("unroll") for (int r = 0; r < 16; ++r) { pA0[r] -= dl; pA1[r] -= dl; } } }
    _Pragma("unroll") for (int r = 0; r < 16; ++r) pA0[r] = __builtin_amdgcn_exp2f(pA0[r]);
    _Pragma("unroll") for (int r = 0; r < 16; ++r) pA1[r] = __builtin_amdgcn_exp2f(pA1[r]);
    WAIT_BAR(0);
    if constexpr (MODE != 1) DMA_K(3, 0);
    DMA_V(1, SLOTB);
    ROT();
    kload8(kf, kp0 + sl_cur);
    WAIT_BAR(2);
    s16x4 vlo[8], vhi[8]; u32x4 pw0, pw1, pw2, pw3;
#define PKW(P, B) cvt_pk_bf16(P[B], P[B + 1])
#define PAF(k) __builtin_bit_cast(bf16x8, pw##k)
#define VFR(i) (bf16x8){vlo[i][0], vlo[i][1], vlo[i][2], vlo[i][3], vhi[i][0], vhi[i][1], vhi[i][2], vhi[i][3]}
#define PIN(x) asm volatile("" : "+v"(x))
#define GAPA(MF, A0, A1, A2, A3, W0, W1, PW) do { MF; sacc += A0; sacc += A1; sacc += A2; sacc += A3; PIN(sacc); W0; W1; PIN(PW); SBAR(); } while (0)
#define EX(v) __builtin_amdgcn_exp2f(v)
#define GAPB(MF, X, B) do { MF; X[B] = EX(X[B]); X[B + 1] = EX(X[B + 1]); X[B + 2] = EX(X[B + 2]); X[B + 3] = EX(X[B + 3]); PIN(X); SBAR(); } while (0)
#define VRD(i) do { vlo[i] = vtr(vp_ + (((i) >> 2) * 4096 + ((i) & 3) * 1024)); vhi[i] = vtr(vp_ + (((i) >> 2) * 4096 + ((i) & 3) * 1024 + 512)); } while (0)
#define KRD(G, j) do { if (G) { kload2(kf, kp0 + sl_next, j); SBAR(); } } while (0)
#define STEP(C0, C1, P0, P1, t, GK, GV, GL) do { SBAR(); \
    const lds_cptr vp_ = vp0 + sl_prev; \
    CI0(C0, t); VRD(0); SBAR(); float sacc = (P0[0] + P0[1]); \
    GAPA(C0 = __builtin_amdgcn_mfma_f32_32x32x16_bf16(kf[0], qr[0], CSRC(C0), 0, 0, 0), P0[2], P0[3], P0[4], P0[5],     pw0[0] = PKW(P0, 0), pw0[1] = PKW(P0, 2), pw0); \
    CI1(C1, t); VRD(4); SBAR(); GAPA(C1 = __builtin_amdgcn_mfma_f32_32x32x16_bf16(kf[1], qr[0], CSRC(C1), 0, 0, 0), P0[6], P0[7], P0[8], P0[9],     pw0[2] = PKW(P0, 4), pw0[3] = PKW(P0, 6), pw0); \
    VRD(1); SBAR(); GAPA(C0 = __builtin_amdgcn_mfma_f32_32x32x16_bf16(kf[2], qr[1], C0, 0, 0, 0),   P0[10], P0[11], P0[12], P0[13], pw1[0] = PKW(P0, 8), pw1[1] = PKW(P0, 10), pw1); \
    VRD(5); SBAR(); GAPA(C1 = __builtin_amdgcn_mfma_f32_32x32x16_bf16(kf[3], qr[1], C1, 0, 0, 0),   P0[14], P0[15], P1[0], P1[1],   pw1[2] = PKW(P0, 12), pw1[3] = PKW(P0, 14), pw1); \
    VRD(2); SBAR(); GAPA(C0 = __builtin_amdgcn_mfma_f32_32x32x16_bf16(kf[4], qr[2], C0, 0, 0, 0),   P1[2], P1[3], P1[4], P1[5],     pw2[0] = PKW(P1, 0), pw2[1] = PKW(P1, 2), pw2); \
    VRD(6); SBAR(); GAPA(C1 = __builtin_amdgcn_mfma_f32_32x32x16_bf16(kf[5], qr[2], C1, 0, 0, 0),   P1[6], P1[7], P1[8], P1[9],     pw2[2] = PKW(P1, 4), pw2[3] = PKW(P1, 6), pw2); \
    VRD(3); SBAR(); GAPA(C0 = __builtin_amdgcn_mfma_f32_32x32x16_bf16(kf[6], qr[3], C0, 0, 0, 0),   P1[10], P1[11], P1[12], P1[13], pw3[0] = PKW(P1, 8), pw3[1] = PKW(P1, 10), pw3); \
    VRD(7); SBAR(); GAPA(C1 = __builtin_amdgcn_mfma_f32_32x32x16_bf16(kf[7], qr[3], C1, 0, 0, 0),   P1[14], P1[15], 0.f, 0.f,       pw3[2] = PKW(P1, 12), pw3[3] = PKW(P1, 14), pw3); \
    l_reg += sacc; \
    if (GK) { DMA_K((t) + 3, sl_cur); } if (GV) { DMA_V((t) + 1, sl_next); } \
    CMASK(C0, C1, t); \
    if constexpr (TRK) { float a = MX3(C0[0], C0[1], C1[0]), b = MX3(C0[2], C0[3], C1[1]); a = MX3(a, C1[2], C1[3]); \
      _Pragma("unroll") for (int r = 4; r < 16; r += 4) { a = MX3(a, C0[r], C0[r + 1]); b = MX3(b, C0[r + 2], C0[r + 3]); a = MX3(a, C1[r], C1[r + 1]); b = MX3(b, C1[r + 2], C1[r + 3]); } \
      float rm = __builtin_fmaxf(a, b); { auto rr = __builtin_amdgcn_permlane32_swap(__float_as_uint(rm), __float_as_uint(rm), false, false); rm = __builtin_fmaxf(__uint_as_float(rr[0]), __uint_as_float(rr[1])); } \
      resc = false; \
      if (__builtin_expect(__any(rm > (float)THRL), 0)) { const float dl = __builtin_fmaxf(rm, 0.f); mhat += dl; NEWREF(); \
        _Pragma("unroll") for (int r = 0; r < 16; ++r) { C0[r] -= dl; C1[r] -= dl; } \
        const float f = __builtin_amdgcn_exp2f(-dl); l_reg *= f; if (hi == 0) wsf[r32] = f; resc = true; } } \
    SBAR(); \
    GAPB(o[0] = __builtin_amdgcn_mfma_f32_32x32x16_bf16(PAF(0), VFR(0), o[0], 0, 0, 0), C0, 0); \
    GAPB(o[1] = __builtin_amdgcn_mfma_f32_32x32x16_bf16(PAF(0), VFR(4), o[1], 0, 0, 0), C0, 4); \
    KRD(GL, 0); GAPB(o[0] = __builtin_amdgcn_mfma_f32_32x32x16_bf16(PAF(1), VFR(1), o[0], 0, 0, 0), C0, 8); \
    KRD(GL, 1); GAPB(o[1] = __builtin_amdgcn_mfma_f32_32x32x16_bf16(PAF(1), VFR(5), o[1], 0, 0, 0), C0, 12); \
    KRD(GL, 2); GAPB(o[0] = __builtin_amdgcn_mfma_f32_32x32x16_bf16(PAF(2), VFR(2), o[0], 0, 0, 0), C1, 0); \
    KRD(GL, 3); GAPB(o[1] = __builtin_amdgcn_mfma_f32_32x32x16_bf16(PAF(2), VFR(6), o[1], 0, 0, 0), C1, 4); \
    GAPB(o[0] = __builtin_amdgcn_mfma_f32_32x32x16_bf16(PAF(3), VFR(3), o[0], 0, 0, 0), C1, 8); \
    GAPB(o[1] = __builtin_amdgcn_mfma_f32_32x32x16_bf16(PAF(3), VFR(7), o[1], 0, 0, 0), C1, 12); \
    } while (0)
    int t = 1;
    if constexpr (MODE == 0) {
#undef CMASK
#define CMASK(P0, P1, t) do {} while (0)
        for (; t + 5 < NT; t += 2) {
            STEP(pB0, pB1, pA0, pA1, t, true, true, true);     WAIT_BAR(2); RESC(); ROT();
            STEP(pA0, pA1, pB0, pB1, t + 1, true, true, true); WAIT_BAR(2); RESC(); ROT();
        }
#undef CMASK
#define CMASK(P0, P1, t) do { const int jb_ = (t) - jdiag; if (MODE == 1) wmask(P0, P1, jb_, qrel, hi); else if (jb_ >= 0) cmask(P0, P1, jb_, qrel, hi); } while (0)
    }
#define ENDW(tt) do { if ((tt) + 3 < NT) { WAIT_BAR(2); } else if ((tt) + 2 < NT) { WAIT_BAR(1); } else { WAIT_BAR(0); } } while (0)
#define DRAIN(PX0, PX1) do { float sacc = PX0[0] + PX0[1]; _Pragma("unroll") for (int r = 2; r < 16; ++r) sacc += PX0[r]; _Pragma("unroll") for (int r = 0; r < 16; ++r) sacc += PX1[r]; l_reg += sacc; \
      pw0 = (u32x4){PKW(PX0, 0), PKW(PX0, 2), PKW(PX0, 4), PKW(PX0, 6)}; pw1 = (u32x4){PKW(PX0, 8), PKW(PX0, 10), PKW(PX0, 12), PKW(PX0, 14)}; pw2 = (u32x4){PKW(PX1, 0), PKW(PX1, 2), PKW(PX1, 4), PKW(PX1, 6)}; pw3 = (u32x4){PKW(PX1, 8), PKW(PX1, 10), PKW(PX1, 12), PKW(PX1, 14)}; \
      SBAR(); pv(o, vb0 + sl_cur, PAF(0), PAF(1), PAF(2), PAF(3)); } while (0)
    if constexpr (MODE == 1) {
        STEP(pB0, pB1, pA0, pA1, 1, false, true, true);   WAIT_BAR(0); RESC(); ROT();
        STEP(pA0, pA1, pB0, pB1, 2, false, false, false); RESC();
        DRAIN(pA0, pA1);
    } else {
        for (; t + 1 < NT; t += 2) {
            STEP(pB0, pB1, pA0, pA1, t, (t + 3 < NT), (t + 1 < NT), (t + 1 < NT));     ENDW(t);     RESC(); ROT();
            STEP(pA0, pA1, pB0, pB1, t + 1, (t + 4 < NT), (t + 2 < NT), (t + 2 < NT)); ENDW(t + 1); RESC(); ROT();
        }
        STEP(pB0, pB1, pA0, pA1, NT - 1, false, false, false); RESC();
        DRAIN(pB0, pB1);
    }
#undef DRAIN
    if (tid == 0) qslot[0] = qval;
    asm volatile("s_waitcnt lgkmcnt(0)\n\ts_barrier" ::: "memory");
    pos2 = __builtin_amdgcn_readfirstlane(qslot[0]);
    { NextU nx = nx1; int target = pos1;
      if (nx.Kh == nullptr) { nx = dec.next(pos2); target = pos2; }
      primed_pos = -1;
      if (nx.Kh != nullptr) { prime_unit(nx.Kh, nx.Vh, nx.KP, nx.t0, nx.ncsg, nx.qb, lds0, lane, wid); primed_pos = target; } }
#undef PKW
#undef PAF
#undef VFR
#undef PIN
#undef GAPA
#undef GAPB
#undef EX
#undef VRD
#undef KRD
#undef STEP
#undef ENDW
    { auto rr = __builtin_amdgcn_permlane32_swap(__float_as_uint(l_reg), __float_as_uint(l_reg), false, false); l_reg = __uint_as_float(rr[0]) + __uint_as_float(rr[1]); }
    if constexpr (MODE == 1) l_reg += __builtin_amdgcn_exp2f(sinkl2 - mhat);
    if (hi == 0) wsf[32 + r32] = l_reg; asm volatile("s_waitcnt lgkmcnt(0)" ::: "memory");
    float rli[16];
#pragma unroll
    for (int r = 0; r < 16; ++r) rli[r] = __builtin_amdgcn_rcpf(wsf[32 + crow(r, hi)]);
    if constexpr (P3A_FP8 != 0) {
        unsigned char* Ow8 = (unsigned char*)Oh + (long)(q0 + wrow) * 512 + wcol;
        unsigned char* stg8 = (unsigned char*)(shm + LDS_OST) + wid * 4096;
#pragma unroll
        for (int r = 0; r < 16; ++r) { const int orow = crow(r, hi); const float sc = rli[r] * 32.0f;
#pragma unroll
            for (int d0 = 0; d0 < 2; ++d0) stg8[orow * 64 + d0 * 32 + r32] = (unsigned char)(__builtin_amdgcn_cvt_pk_fp8_f32(clamp448(o[d0][r] * sc), 0.f, 0, false) & 0xff); }
        asm volatile("s_waitcnt lgkmcnt(0)" ::: "memory");
#pragma unroll
        for (int i = 0; i < 2; ++i) { const int row = i * 16 + (lane >> 2), ch = lane & 3; const u32x4 v = *(const u32x4*)(stg8 + row * 64 + ch * 16); *(u32x4*)(Ow8 + (long)row * 512 + ch * 16) = v; }
    } else {
    bf16* Ow = Oh + (long)(q0 + wrow) * QP + wcol;
    { bf16* stg = (bf16*)(shm + LDS_OST) + wid * 2048;
#pragma unroll
      for (int r = 0; r < 16; ++r) { const int orow = crow(r, hi);
#pragma unroll
          for (int d0 = 0; d0 < 2; ++d0) stg[orow * 64 + d0 * 32 + r32] = __float2bfloat16(o[d0][r] * rli[r]); }
      asm volatile("s_waitcnt lgkmcnt(0)" ::: "memory");
#pragma unroll
      for (int i = 0; i < 4; ++i) { const int row = i * 8 + (lane >> 3), ch = lane & 7; const u32x4 v = *(const u32x4*)(stg + row * 64 + ch * 8); *(u32x4*)(Ow + (long)row * QP + ch * 8) = v; } }
    }
    asm volatile("s_waitcnt lgkmcnt(0)" ::: "memory");
#undef DMA_K
#undef DMA_V
#undef CMASK
#undef RESC
#undef ROT
#undef CI0
#undef CI1
#undef CSRC
#undef NEWREF
}
#undef SBAR
#undef WAIT_BAR
#undef MX3
}

constexpr int NWAVES = 8;
constexpr int N_PHASES = 9;
constexpr size_t MiB = 1u << 20;
constexpr size_t WS_CTL = 0, CTL_ZERO_BYTES = 64 * 1024;
constexpr size_t WS_LOGF = 2 * MiB;
constexpr size_t WS_NCS = 3 * MiB;
constexpr size_t WS_TOKE = 4 * MiB, WS_TOKR = 4 * MiB + 512 * 1024, WS_TOKG = 5 * MiB;
constexpr size_t WS_TS = 6 * MiB, WS_ORDER = 6 * MiB + 64 * 1024;
constexpr size_t WS_ROWTOK = 8 * MiB;
constexpr size_t WS_WOA = 16 * MiB, WS_WOB = 17 * MiB, WS_WOUT = 18 * MiB, WS_WIN = 20 * MiB;
constexpr size_t WS_WIN8 = 29 * MiB;
constexpr size_t WS_XN8 = 560 * MiB;
constexpr size_t WS_WGU = 32 * MiB, WS_WD = 160 * MiB;
constexpr size_t WS_XN = 224 * MiB;
constexpr size_t WS_QA = 288 * MiB, WS_KA = 320 * MiB, WS_VA = 328 * MiB, WS_QF = 336 * MiB, WS_KF = 368 * MiB, WS_VF = 400 * MiB;
constexpr size_t WS_GT = 432 * MiB, WS_MG = 560 * MiB, WS_OA = 624 * MiB, WS_OB = 656 * MiB;
constexpr size_t WS_ACT = 288 * MiB;
constexpr size_t WS_YB = 560 * MiB;
constexpr size_t WS_X1 = 832 * MiB;
constexpr size_t WS_WOA8 = 12 * MiB, WS_WOB8 = 13 * MiB;
constexpr size_t WS_RMS = 6 * MiB + 256 * 1024;
constexpr size_t WS_WOUT8 = 7 * MiB;
constexpr size_t WS_MG8 = 688 * MiB;
constexpr size_t WS_END = 896 * MiB;
constexpr int CW_CNT = 64;
constexpr int CW_DONE = 128, CW_QCTR = 192;
constexpr int CW_BAR = 1024;
constexpr int MISC_BAR = 8192;
constexpr int RING_BYTES = 131072, MISC_OFF = RING_BYTES, LDS_BYTES = 163840;
constexpr int MISC_TOKL = 12544, TOKL_UNITS = 19;

struct Args { const void* in[21]; float* out; unsigned char* ws; int ph_lo, ph_hi; };

struct Frame { LAS unsigned char* lds; int tid, lane, wave, vcu, G; };

__device__ __forceinline__ float wave_sum(float v) {
#pragma unroll
    for (int o = 1; o < 64; o <<= 1) v += __shfl_xor(v, o);
    return v;
}

__device__ __forceinline__ int rowmap_in(int c) {
    int T, wc, d;
    if (c < 512) { const int hh = c >> 6; T = hh >> 2; wc = hh & 3; d = c & 63; }
    else if (c < 640) { T = 2; wc = (c - 512) >> 6; d = c & 63; }
    else if (c < 768) { T = 2; wc = 2 + ((c - 640) >> 6); d = c & 63; }
    else if (c < COL_FL) { const int cc = c - 768, sect = cc >> 9, hh = (cc & 511) >> 6; T = 3 + 2 * sect + (hh >> 2); wc = hh & 3; d = cc & 63; }
    else if (c < COL_GL) return -1;
    else { const int g = c - COL_GL, gc = g & 255; return 256 * (9 + (g >> 8)) + 128 * ((gc >> 3) & 1) + 32 * ((gc >> 6) & 3) + 16 * ((gc >> 2) & 1) + 4 * ((gc >> 4) & 3) + (gc & 3); }
    return 256 * T + 128 * (d >> 5) + 32 * wc + perm32s(d & 31);
}
__device__ __forceinline__ int rowmap_in16(int c) { const int r = rowmap_in(c); return (!P1_FP8 || r < 7 * 256) ? r : -1; }
__device__ __forceinline__ int rowmap_in8(int c) { const int r = rowmap_in(c); return r >= 7 * 256 ? r - 7 * 256 : -1; }
__device__ __forceinline__ int rowmap_perm(int c) { return (c & ~31) + perm32s(c & 31); }
__device__ __forceinline__ int rowmap_d16(int c) { return (c & ~255) + 128 * ((c >> 3) & 1) + 32 * ((c >> 6) & 3) + 16 * ((c >> 2) & 1) + 4 * ((c >> 4) & 3) + (c & 3); }
__device__ __forceinline__ int rowmap_gu(int c) { const int bj = c >> 10, f = c & 1023; return 256 * (f >> 7) + 128 * bj + 32 * ((f >> 5) & 3) + perm32s(f & 31); }
template <int MAP> __device__ __forceinline__ void transpose_item(const float* W, int K, int N, bf16_t* WT, int kb, int nb, int lane) {
    const int k0 = 64 * kb + 8 * (lane >> 3), n0 = 32 * nb + 4 * (lane & 7);
    if (n0 >= N) return;
    f32x4 v[8];
#pragma unroll
    for (int kk = 0; kk < 8; ++kk) v[kk] = *(const f32x4*)(W + (size_t)(k0 + kk) * N + n0);
#pragma unroll
    for (int j = 0; j < 4; ++j) { const int c = n0 + j; const int row = MAP == 0 ? rowmap_in16(c) : MAP == 1 ? rowmap_perm(c) : MAP == 2 ? c : rowmap_gu(c);
        if (row >= 0) { u32x4 o; o.x = cvt_pk_bf16(v[0][j], v[1][j]); o.y = cvt_pk_bf16(v[2][j], v[3][j]); o.z = cvt_pk_bf16(v[4][j], v[5][j]); o.w = cvt_pk_bf16(v[6][j], v[7][j]);
            *(u32x4*)(WT + (size_t)row * K + k0) = o; } }
}

template <int MAP> __device__ __forceinline__ bool f8_item_load(const float* W, int K, int N, int kb, int nb, int lane, f32x4 (&v)[16]) {
    const int k0 = 128 * kb + 16 * (lane >> 3), n0 = 32 * nb + 4 * (lane & 7);
    if (n0 >= N) return false;
    if (MAP == 0 && rowmap_in8(n0) < 0) return false;
#pragma unroll
    for (int kk = 0; kk < 16; ++kk) v[kk] = __builtin_nontemporal_load((const f32x4*)(W + (size_t)(k0 + kk) * N + n0));
    return true;
}
template <int MAP> __device__ __forceinline__ void f8_item_store(int K, unsigned char* WT, int kb, int nb, int lane, const f32x4 (&v)[16]) {
    const int k0 = 128 * kb + 16 * (lane >> 3), n0 = 32 * nb + 4 * (lane & 7);
#pragma unroll
    for (int j = 0; j < 4; ++j) { const int c = n0 + j; const int row = MAP == 0 ? rowmap_in8(c) : MAP == 1 ? rowmap_perm(c) : MAP == 4 ? rowmap_d16(c) : rowmap_gu(c);
        u32x4 o; o.x = pk4_fp8(v[0][j] * W8_SCALE, v[1][j] * W8_SCALE, v[2][j] * W8_SCALE, v[3][j] * W8_SCALE); o.y = pk4_fp8(v[4][j] * W8_SCALE, v[5][j] * W8_SCALE, v[6][j] * W8_SCALE, v[7][j] * W8_SCALE);
        o.z = pk4_fp8(v[8][j] * W8_SCALE, v[9][j] * W8_SCALE, v[10][j] * W8_SCALE, v[11][j] * W8_SCALE); o.w = pk4_fp8(v[12][j] * W8_SCALE, v[13][j] * W8_SCALE, v[14][j] * W8_SCALE, v[15][j] * W8_SCALE);
        *(u32x4*)(WT + (size_t)row * K + k0) = o; }
}
template <int MAP> __device__ __forceinline__ void transpose_item_f8(const float* W, int K, int N, unsigned char* WT, int kb, int nb, int lane) {
    f32x4 v[16]; if (f8_item_load<MAP>(W, K, N, kb, nb, lane, v)) f8_item_store<MAP>(K, WT, kb, nb, lane, v);
}

constexpr int MOE_ITEMS = N_EXP * (8 * 64 + 8 * 32);
__device__ __forceinline__ void moe_item_decode(const Args& a, int r, const float*& W, unsigned char*& WT, int& N, int& kb, int& nb, bool& gu) {
    unsigned char* ws = a.ws; constexpr int I_GU = 8 * 64, I_D = 8 * 32;
    if (r < N_EXP * I_GU) { const int e = r / I_GU, q = r % I_GU; W = (const float*)a.in[17] + (size_t)e * 1024 * 2048; WT = ws + WS_WGU + (size_t)e * 2048 * 1024; N = 2048; kb = q / 64; nb = q % 64; gu = true; }
    else { r -= N_EXP * I_GU; const int e = r / I_D, q = r % I_D; W = (const float*)a.in[19] + (size_t)e * 1024 * 1024; WT = ws + WS_WD + (size_t)e * 1024 * 1024; N = 1024; kb = q / 32; nb = q % 32; gu = false; }
}
__device__ __forceinline__ void moe_weight_item2(const Args& a, int r0, int r1, int lane, volatile LAS int* qslot = nullptr, int qval = 0, bool qwrite = false) {
    const float *W0, *W1; unsigned char *T0, *T1; int N0, N1, kb0, kb1, nb0, nb1; bool g0, g1;
    moe_item_decode(a, r0, W0, T0, N0, kb0, nb0, g0); moe_item_decode(a, r1, W1, T1, N1, kb1, nb1, g1);
    f32x4 v0[16], v1[16];
    (void)f8_item_load<3>(W0, 1024, N0, kb0, nb0, lane, v0); (void)f8_item_load<3>(W1, 1024, N1, kb1, nb1, lane, v1);
    asm volatile("" ::: "memory");
    if (qwrite) qslot[0] = qval;
    if (g0) f8_item_store<3>(1024, T0, kb0, nb0, lane, v0); else f8_item_store<4>(1024, T0, kb0, nb0, lane, v0);
    if (g1) f8_item_store<3>(1024, T1, kb1, nb1, lane, v1); else f8_item_store<4>(1024, T1, kb1, nb1, lane, v1);
}

__device__ __forceinline__ void p0_prologue(const Frame& F, const Args& a) {
    unsigned char* ws = a.ws;
    const float* x = (const float*)a.in[0]; const float* g1 = (const float*)a.in[2]; const float* w_in = (const float*)a.in[3]; const float* b_forget = (const float*)a.in[4];
    const int gw = F.vcu * NWAVES + F.wave, NGW = F.G * NWAVES;
    constexpr int I_IN = 16 * 137, I_IN8 = 8 * 137, I_OA = 8 * 32, I_OUT = 16 * 32, I_GU = 8 * 64, I_D = 8 * 32;
    constexpr int NITEMS = I_IN + I_IN8 + 2 * I_OA + I_OUT;
    for (int it = gw; it < NITEMS; it += NGW) {
        int r = it;
        if (r < I_IN) { transpose_item<0>(w_in, 1024, IN_W, (bf16_t*)(ws + WS_WIN), r / 137, r % 137, F.lane); continue; } r -= I_IN;
        if (r < I_IN8) { if (P1_FP8) transpose_item_f8<0>(w_in, 1024, IN_W, ws + WS_WIN8, r / 137, r % 137, F.lane); continue; } r -= I_IN8;
        if (r < I_OA) { if (P3A_FP8) { if (r < 4 * 32) transpose_item_f8<1>((const float*)a.in[11], 512, 1024, ws + WS_WOA8, r / 32, r % 32, F.lane); }
                        else transpose_item<1>((const float*)a.in[11], 512, 1024, (bf16_t*)(ws + WS_WOA), r / 32, r % 32, F.lane); continue; } r -= I_OA;
        if (r < I_OA) { if (P3A_FP8) { if (r < 4 * 32) transpose_item_f8<1>((const float*)a.in[12], 512, 1024, ws + WS_WOB8, r / 32, r % 32, F.lane); }
                        else transpose_item<1>((const float*)a.in[12], 512, 1024, (bf16_t*)(ws + WS_WOB), r / 32, r % 32, F.lane); continue; } r -= I_OA;
        if (P3B_FP8) { if (r < 8 * 32) transpose_item_f8<1>((const float*)a.in[13], 1024, 1024, ws + WS_WOUT8, r / 32, r % 32, F.lane); }
        else transpose_item<1>((const float*)a.in[13], 1024, 1024, (bf16_t*)(ws + WS_WOUT), r / 32, r % 32, F.lane);
    }
    LAS float* wfl = (LAS float*)F.lds;
    for (int c = F.tid; c < 1024; c += NWAVES * 64) { const f32x4 u0 = *(const f32x4*)(w_in + (size_t)c * IN_W + COL_FL), u1 = *(const f32x4*)(w_in + (size_t)c * IN_W + COL_FL + 4);
        *(LAS f32x4*)(wfl + c * 8) = u0; *(LAS f32x4*)(wfl + c * 8 + 4) = u1; }
    __syncthreads();
    f32x4 wf[16][2], gv[4];
#pragma unroll
    for (int j = 0; j < 4; ++j) { gv[j] = *(const f32x4*)(g1 + 256 * j + 4 * F.lane);
#pragma unroll
        for (int i = 0; i < 4; ++i) { const int c = 256 * j + 4 * F.lane + i; wf[4 * j + i][0] = *(const LAS f32x4*)(wfl + c * 8); wf[4 * j + i][1] = *(const LAS f32x4*)(wfl + c * 8 + 4); } }
    float bfv = 0.f; if (F.lane < 8) bfv = b_forget[F.lane];
    bf16_t* XN = (bf16_t*)(ws + WS_XN); unsigned char* XN8 = ws + WS_XN8; float* LOGF = (float*)(ws + WS_LOGF);
    f32x4 nv[4];
    if (gw < NTOK) {
#pragma unroll
        for (int j = 0; j < 4; ++j) nv[j] = ((const f32x4*)(x + (size_t)gw * 1024) + F.lane)[64 * j]; }
    for (int m = gw; m < NTOK; m += NGW) {
        f32x4 v[4]; float s = 0.f;
#pragma unroll
        for (int j = 0; j < 4; ++j) v[j] = nv[j];
        if (m + NGW < NTOK) {
#pragma unroll
            for (int j = 0; j < 4; ++j) nv[j] = ((const f32x4*)(x + (size_t)(m + NGW) * 1024) + F.lane)[64 * j]; }
#pragma unroll
        for (int j = 0; j < 4; ++j) { s += (v[j][0] * v[j][0] + v[j][1] * v[j][1]) + (v[j][2] * v[j][2] + v[j][3] * v[j][3]); }
        const float rstd = rsqrtf(wave_sum(s) * (1.0f / 1024.0f) + EPS);
        if (XREC && F.lane == 0) ((float*)(ws + WS_RMS))[m] = __builtin_amdgcn_rcpf(rstd);
        float fl[8];
#pragma unroll
        for (int h = 0; h < 8; ++h) fl[h] = 0.f;
        u32x2* o8 = (u32x2*)(XN + (size_t)m * 1024) + F.lane;
#pragma unroll
        for (int j = 0; j < 4; ++j) { v[j] = v[j] * rstd * gv[j];
            u32x2 w; w.x = cvt_pk_bf16(v[j][0], v[j][1]); w.y = cvt_pk_bf16(v[j][2], v[j][3]); o8[64 * j] = w;
            if (P1_FP8) ((unsigned*)(XN8 + (size_t)m * 1024))[64 * j + F.lane] = pk4_fp8(v[j][0], v[j][1], v[j][2], v[j][3]);
#pragma unroll
            for (int i = 0; i < 4; ++i) {
#pragma unroll
                for (int h = 0; h < 4; ++h) { fl[h] += v[j][i] * wf[4 * j + i][0][h]; fl[4 + h] += v[j][i] * wf[4 * j + i][1][h]; } } }
        float mine = 0.f;
#pragma unroll
        for (int h = 0; h < 8; ++h) { const float t = wave_sum(fl[h]); if (F.lane == h) mine = t; }
        if (F.lane < 8) { const float z = mine + bfv; LOGF[(size_t)m * 8 + F.lane] = fminf(z, 0.f) - log1pf(__expf(-fabsf(z))); }
    }
}

__device__ __forceinline__ void p1_cumsum(const Frame& F, const Args& a, int bh) {
    const float* LOGF = (const float*)(a.ws + WS_LOGF); float* NCS = (float*)(a.ws + WS_NCS);
    const int b = bh >> 3, h = bh & 7; LAS double* wtot = (LAS double*)F.lds; LAS float* ncl = (LAS float*)(F.lds + 1024); LAS float* smx = (LAS float*)(F.lds + 512);
    double v[16]; double run = 0.0;
#pragma unroll
    for (int j = 0; j < 16; ++j) { run += (double)LOGF[((size_t)b * SEQ + 16 * F.tid + j) * 8 + h]; v[j] = run; }
    double incl = run;
#pragma unroll
    for (int o = 1; o < 64; o <<= 1) { const double t = __shfl_up(incl, o); if (F.lane >= o) incl += t; }
    if (F.lane == 63) wtot[F.wave] = incl;
    if (F.wave == 0) {
        float mq = fabsf(((const float*)a.in[9])[F.lane]), mk = fabsf(((const float*)a.in[10])[F.lane]);
#pragma unroll
        for (int o = 1; o < 64; o <<= 1) { mq = fmaxf(mq, __shfl_xor(mq, o)); mk = fmaxf(mk, __shfl_xor(mk, o)); }
        if (F.lane == 0) smx[0] = 64.0f * C2 * mq * mk;
    }
    __syncthreads();
    double base = incl - run;
    for (int w = 0; w < F.wave; ++w) base += wtot[w];
    float* dst = NCS + (size_t)bh * SEQ + 16 * F.tid;
#pragma unroll
    for (int j = 0; j < 4; ++j) { f32x4 o;
#pragma unroll
        for (int i = 0; i < 4; ++i) o[i] = (float)(-(base + v[4 * j + i]) * 1.4426950408889634);
        *(f32x4*)(dst + 4 * j) = o; *(LAS f32x4*)(ncl + 16 * F.tid + 4 * j) = o; }
    __syncthreads();
    LAS float* tms = (LAS float*)(F.lds + 1024 + 32768); LAS float* FQ = tms + 128; LAS float* tops = FQ + 132;
    { const int tile = F.tid >> 2; const float top = ncl[64 * tile + 63]; float pm = 0.f;
#pragma unroll
      for (int i = 0; i < 4; ++i) { const f32x4 n4 = *(const LAS f32x4*)(ncl + 16 * F.tid + 4 * i);
          pm += (__builtin_amdgcn_exp2f(n4[0] - top) + __builtin_amdgcn_exp2f(n4[1] - top)) + (__builtin_amdgcn_exp2f(n4[2] - top) + __builtin_amdgcn_exp2f(n4[3] - top)); }
      pm += __shfl_xor(pm, 1); pm += __shfl_xor(pm, 2);
      if ((F.tid & 3) == 0) { tms[tile] = pm; tops[tile] = top; } }
    __syncthreads();
    if (F.tid <= 128) { const int j = F.tid; float fq = -INFINITY;
        if (j >= 1) { const float top = tops[j - 1]; float q = 0.f; const int i0 = j > 16 ? j - 16 : 0;
            for (int i = i0; i < j; ++i) q += tms[i] * __builtin_amdgcn_exp2f(tops[i] - top);
            if (i0 > 0) q += 64.0f * (float)i0 * __builtin_amdgcn_exp2f(tops[i0 - 1] - top);
            fq = __builtin_amdgcn_logf(q) + top; }
        FQ[j] = fq; }
    __syncthreads();
    int* TS = (int*)(a.ws + WS_TS);
    if (F.tid < 32) { const int qb = F.tid; const float thr = ncl[256 * qb] - (27.05f + 2.1f * smx[0]); int lo_ = 0, hi_ = 4 * qb;
        while (lo_ < hi_) { const int mid = (lo_ + hi_ + 1) >> 1; if (FQ[mid] < thr) lo_ = mid; else hi_ = mid - 1; }
        TS[bh * 32 + qb] = lo_ & ~1; }
    __threadfence();
    __syncthreads();
    LAS int* flag = (LAS int*)(F.lds + 768);
    if (F.tid == 0) flag[0] = (int)__hip_atomic_fetch_add((unsigned*)(a.ws + WS_CTL) + CW_DONE, 1u, __ATOMIC_RELAXED, __HIP_MEMORY_SCOPE_AGENT);
    __syncthreads();
    if (flag[0] == 31) {
        __threadfence();
        LAS int* hist = (LAS int*)(F.lds + 2048); LAS int* cst = hist + 80;
        if (F.tid < 160) hist[F.tid] = 0;
        __syncthreads();
        int c[2];
#pragma unroll
        for (int k = 0; k < 2; ++k) { const int u = F.tid + 512 * k; const int t0 = (int)__hip_atomic_load((unsigned*)TS + u, __ATOMIC_RELAXED, __HIP_MEMORY_SCOPE_AGENT); c[k] = (4 * (u & 31) + 4 - t0) >> 1; atomicAdd((int*)(hist + c[k]), 1); }
        __syncthreads();
        if (F.tid == 0) { int s0 = 0; for (int cc = 79; cc >= 0; --cc) { cst[cc] = s0; s0 += hist[cc]; } }
        __syncthreads();
        int* ORD = (int*)(a.ws + WS_ORDER);
#pragma unroll
        for (int k = 0; k < 2; ++k) { const int u = F.tid + 512 * k; const int p = atomicAdd((int*)(cst + c[k]), 1); ORD[p] = u | ((4 * (u & 31) + 4 - 2 * c[k]) << 16); }
    }
    __syncthreads();
}

__device__ __forceinline__ void p2_attention(const Frame& F, const Args& a, char* lds) {
    using attn_body::bf16;
    unsigned char* ws = a.ws; const float* sinks = (const float*)a.in[8];
    const bf16* QA = (const bf16*)(ws + WS_QA); const bf16* KA = (const bf16*)(ws + WS_KA); const bf16* VA = (const bf16*)(ws + WS_VA);
    const bf16* QF = (const bf16*)(ws + WS_QF); const bf16* KF = (const bf16*)(ws + WS_KF); const bf16* VF = (const bf16*)(ws + WS_VF);
    bf16* OA = (bf16*)(ws + WS_OA); bf16* OB = (bf16*)(ws + WS_OB);
    const float* NCS = (const float*)(ws + WS_NCS);
    constexpr int OES = P3A_FP8 ? 2 : 1;
    const int* TS = (const int*)(ws + WS_TS); const int* ORD = (const int*)(ws + WS_ORDER); unsigned* qctr = (unsigned*)(ws + WS_CTL) + CW_QCTR;
    volatile LAS int* qi = (volatile LAS int*)(F.lds + MISC_OFF + 12288);
    bool fixedref;
    { float fq_ = fabsf(((const float*)a.in[9])[F.lane]), fk_ = fabsf(((const float*)a.in[10])[F.lane]), sq_ = fabsf(((const float*)a.in[6])[F.lane]), sk_ = fabsf(((const float*)a.in[7])[F.lane]), sn_ = fabsf(sinks[F.lane & 7]);
#pragma unroll
      for (int o = 1; o < 64; o <<= 1) { fq_ = fmaxf(fq_, __shfl_xor(fq_, o)); fk_ = fmaxf(fk_, __shfl_xor(fk_, o)); sq_ = fmaxf(sq_, __shfl_xor(sq_, o)); sk_ = fmaxf(sk_, __shfl_xor(sk_, o)); sn_ = fmaxf(sn_, __shfl_xor(sn_, o)); }
      const float bound = 2.1f * 64.0f * C2 * fmaxf(fq_ * fk_, sq_ * sk_);
      fixedref = __builtin_amdgcn_readfirstlane((int)((bound <= 60.0f) && (sn_ * LOG2E + bound <= 60.0f))) != 0; }
    LAS int* ordl = (LAS int*)(F.lds + 118784);
    for (int i = F.tid; i < 1024; i += NWAVES * 64) ordl[i] = ORD[i];
    __syncthreads();
    if (F.tid == 0) { qi[0] = (int)__hip_atomic_fetch_add(qctr, 1u, __ATOMIC_RELAXED, __HIP_MEMORY_SCOPE_AGENT); qi[1] = (int)__hip_atomic_fetch_add(qctr, 1u, __ATOMIC_RELAXED, __HIP_MEMORY_SCOPE_AGENT); }
    __syncthreads();
    int pos = __builtin_amdgcn_readfirstlane(qi[0]), pos1 = __builtin_amdgcn_readfirstlane(qi[1]);
    __syncthreads();
    using attn_body::P2Dec;
    static_assert(MOE_ITEMS == 1536 * 16, "chunking of the expert weight items");
    P2Dec dec; dec.KF = KF; dec.VF = VF; dec.KA = KA; dec.VA = VA; dec.NCS = NCS; dec.ordl = ordl;
    int primed_pos = -1, it = 0;
    while (pos < P2Dec::QPOS) {
        int nxt = 0;
        if (F.tid == 0) nxt = (int)__hip_atomic_fetch_add(qctr, 1u, __ATOMIC_RELAXED, __HIP_MEMORY_SCOPE_AGENT);
        volatile LAS int* slot = qi + (it & 1);
        int pos2;
        const int idx = P2Dec::unit_of(pos);
        if (idx < 0) {
            const int chunk = P2Dec::chunk_of(pos);
            moe_weight_item2(a, chunk * 16 + F.wave, chunk * 16 + 8 + F.wave, F.lane, slot, nxt, F.tid == 0);
            __syncthreads();
            pos2 = __builtin_amdgcn_readfirstlane(slot[0]);
        } else {
            const attn_body::NextU nx1 = dec.next(pos1); const bool primed = primed_pos == pos;
            if (idx < 1024) {
                const int od = __builtin_amdgcn_readfirstlane(ordl[idx]), u = od & 0xffff, t0 = od >> 16, bh = u >> 5, qb = u & 31, b = bh >> 3, h = bh & 7;
                if (fixedref) attn_body::attn_unit<0, 8, false>(qb, t0, QF + (size_t)b * SEQ * 512 + h * 64, KF + (size_t)b * SEQ * 512 + h * 64, VF + (size_t)b * SEQ * 512 + h * 64, OB + ((size_t)b * SEQ * 512 + h * 64) / OES, 512, 0.f, lds, NCS + (size_t)bh * SEQ, primed, nx1, pos1, dec, slot, nxt, pos2, primed_pos);
                else attn_body::attn_unit<0, 8, true>(qb, t0, QF + (size_t)b * SEQ * 512 + h * 64, KF + (size_t)b * SEQ * 512 + h * 64, VF + (size_t)b * SEQ * 512 + h * 64, OB + ((size_t)b * SEQ * 512 + h * 64) / OES, 512, 0.f, lds, NCS + (size_t)bh * SEQ, primed, nx1, pos1, dec, slot, nxt, pos2, primed_pos);
            } else {
                const int u = idx - 1024, bk = u >> 7, qb = 127 - (u & 127), b = bk >> 1, kvh = bk & 1; const float snk = sinks[kvh * 4 + (F.wave >> 1)] * LOG2E;
                if (fixedref) attn_body::attn_unit<1, 8, false>(qb, 0, QA + (size_t)b * SEQ * 512 + kvh * 256, KA + (size_t)b * SEQ * 128 + kvh * 64, VA + (size_t)b * SEQ * 128 + kvh * 64, OA + ((size_t)b * SEQ * 512 + kvh * 256) / OES, 128, snk, lds, nullptr, primed, nx1, pos1, dec, slot, nxt, pos2, primed_pos);
                else attn_body::attn_unit<1, 8, true>(qb, 0, QA + (size_t)b * SEQ * 512 + kvh * 256, KA + (size_t)b * SEQ * 128 + kvh * 64, VA + (size_t)b * SEQ * 128 + kvh * 64, OA + ((size_t)b * SEQ * 512 + kvh * 256) / OES, 128, snk, lds, nullptr, primed, nx1, pos1, dec, slot, nxt, pos2, primed_pos);
            }
        }
        pos = pos1; pos1 = pos2; ++it;
    }
    __syncthreads();
}

template <int NC> __device__ __forceinline__ void top4_of(float (&cv)[NC], int (&ce)[NC], float (&tv)[4], int (&te)[4]) {
#pragma unroll
    for (int k = 0; k < 4; ++k) { float bv = -INFINITY; int be = 1 << 20;
#pragma unroll
        for (int i = 0; i < NC; ++i) { const bool t = (cv[i] > bv) | ((cv[i] == bv) & (ce[i] < be)); bv = t ? cv[i] : bv; be = t ? ce[i] : be; }
        tv[k] = bv; te[k] = be;
#pragma unroll
        for (int i = 0; i < NC; ++i) cv[i] = (ce[i] == be) ? -INFINITY : cv[i]; }
}
__device__ __forceinline__ void p4_router(const Frame& F, const Args& a, const bool dry) {
    unsigned char* ws = a.ws; const bf16_t* X1 = (const bf16_t*)(ws + WS_X1); const float* g2 = (const float*)a.in[14]; const float* wr_ = (const float*)a.in[15]; const float* br = (const float*)a.in[16];
    LAS unsigned char* WL = F.lds;
    LAS int* lcnt = (LAS int*)(F.lds + MISC_OFF); LAS int* lbase = lcnt + 32; LAS int* asg_e = lcnt + 64; LAS float* asg_g = (LAS float*)(lcnt + 64 + 512);
    for (int ci = F.tid; ci < 4096; ci += NWAVES * 64) { const int ks = ci >> 7, et = (ci >> 6) & 1, kq = (ci >> 4) & 3, er = ci & 15, e = 16 * et + er, k0 = 64 * (ks >> 1) + 16 * kq + 8 * (ks & 1);
        float w[8];
#pragma unroll
        for (int j = 0; j < 8; ++j) w[j] = g2[k0 + j] * wr_[(k0 + j) * 32 + e];
        u32x4 o; o.x = cvt_pk_bf16(w[0], w[1]); o.y = cvt_pk_bf16(w[2], w[3]); o.z = cvt_pk_bf16(w[4], w[5]); o.w = cvt_pk_bf16(w[6], w[7]);
        *(LAS u32x4*)(WL + ci * 16) = o; }
    if (F.tid < 32) lcnt[F.tid] = 0;
    __syncthreads();
    unsigned char* H2 = ws + WS_XN; unsigned* gcnt = (unsigned*)(ws + WS_CTL) + CW_CNT;
    int* TOKE = (int*)(ws + WS_TOKE); int* TOKR = (int*)(ws + WS_TOKR); float* TOKG = (float*)(ws + WS_TOKG); int* ROWTOK = (int*)(ws + WS_ROWTOK);
    const int tokl = F.lane & 15, kq = F.lane >> 4;
    for (int rb = blockIdx.x; rb < NTOK / 128; rb += F.G) {
        const int lrow = F.wave * 16 + tokl, m = rb * 128 + lrow;
        const bf16_t* xrow = X1 + (size_t)m * 1024 + 16 * kq;
        f32x4 acc0 = (f32x4){0.f, 0.f, 0.f, 0.f}, acc1 = (f32x4){0.f, 0.f, 0.f, 0.f}; float ss = 0.f;
#pragma unroll 4
        for (int ql = 0; ql < 16; ++ql) {
            const u32x4 x0 = *(const u32x4*)(xrow + 64 * ql), x1v = *(const u32x4*)(xrow + 64 * ql + 8);
#pragma unroll
            for (int d = 0; d < 4; ++d) { const float p = bf_lo(x0[d]), q = bf_hi(x0[d]), r = bf_lo(x1v[d]), t = bf_hi(x1v[d]); ss += (p * p + q * q) + (r * r + t * t); }
            const LAS unsigned char* wp = WL + ql * 4096 + F.lane * 16;
            acc0 = __builtin_amdgcn_mfma_f32_16x16x32_bf16(*(const LAS bf16x8*)(wp), __builtin_bit_cast(bf16x8, x0), acc0, 0, 0, 0);
            acc1 = __builtin_amdgcn_mfma_f32_16x16x32_bf16(*(const LAS bf16x8*)(wp + 1024), __builtin_bit_cast(bf16x8, x0), acc1, 0, 0, 0);
            acc0 = __builtin_amdgcn_mfma_f32_16x16x32_bf16(*(const LAS bf16x8*)(wp + 2048), __builtin_bit_cast(bf16x8, x1v), acc0, 0, 0, 0);
            acc1 = __builtin_amdgcn_mfma_f32_16x16x32_bf16(*(const LAS bf16x8*)(wp + 3072), __builtin_bit_cast(bf16x8, x1v), acc1, 0, 0, 0);
        }
        ss += __shfl_xor(ss, 16); ss += __shfl_xor(ss, 32);
        const float rstd = rsqrtf(ss * (1.0f / 1024.0f) + EPS);
        float cv[8]; int ce[8];
#pragma unroll
        for (int r = 0; r < 4; ++r) { ce[r] = 4 * kq + r; ce[4 + r] = 16 + 4 * kq + r; cv[r] = acc0[r] * rstd + br[4 * kq + r]; cv[4 + r] = acc1[r] * rstd + br[16 + 4 * kq + r]; }
        float tv[4]; int te[4];
        top4_of<8>(cv, ce, tv, te);
#pragma unroll
        for (int o = 16; o <= 32; o <<= 1) {
            float mv[8]; int me[8];
#pragma unroll
            for (int k = 0; k < 4; ++k) { mv[k] = tv[k]; me[k] = te[k]; mv[4 + k] = __shfl_xor(tv[k], o); me[4 + k] = __shfl_xor(te[k], o); }
            top4_of<8>(mv, me, tv, te);
        }
        if (kq == 0) {
            float ex[4], z = 0.f;
#pragma unroll
            for (int k = 0; k < 4; ++k) { ex[k] = __expf(tv[k] - tv[0]); z += ex[k]; }
#pragma unroll
            for (int k = 0; k < 4; ++k) { asg_e[lrow * 4 + k] = te[k]; asg_g[lrow * 4 + k] = ex[k] / z; }
        }
        unsigned char* hrow = H2 + (size_t)m * 1024 + 16 * kq;
#pragma unroll 4
        for (int ql = 0; ql < 16; ++ql) {
            const u32x4 x0 = *(const u32x4*)(xrow + 64 * ql), x1v = *(const u32x4*)(xrow + 64 * ql + 8);
            const f32x4 g0 = *(const f32x4*)(g2 + 64 * ql + 16 * kq), g1 = *(const f32x4*)(g2 + 64 * ql + 16 * kq + 4), g2v = *(const f32x4*)(g2 + 64 * ql + 16 * kq + 8), g3 = *(const f32x4*)(g2 + 64 * ql + 16 * kq + 12);
            u32x4 o;
            o.x = pk4_fp8(bf_lo(x0[0]) * rstd * g0[0], bf_hi(x0[0]) * rstd * g0[1], bf_lo(x0[1]) * rstd * g0[2], bf_hi(x0[1]) * rstd * g0[3]);
            o.y = pk4_fp8(bf_lo(x0[2]) * rstd * g1[0], bf_hi(x0[2]) * rstd * g1[1], bf_lo(x0[3]) * rstd * g1[2], bf_hi(x0[3]) * rstd * g1[3]);
            o.z = pk4_fp8(bf_lo(x1v[0]) * rstd * g2v[0], bf_hi(x1v[0]) * rstd * g2v[1], bf_lo(x1v[1]) * rstd * g2v[2], bf_hi(x1v[1]) * rstd * g2v[3]);
            o.w = pk4_fp8(bf_lo(x1v[2]) * rstd * g3[0], bf_hi(x1v[2]) * rstd * g3[1], bf_lo(x1v[3]) * rstd * g3[2], bf_hi(x1v[3]) * rstd * g3[3]);
            *(u32x4*)(hrow + 64 * ql) = o;
        }
        __syncthreads();
        if (dry) continue;
        const int e = asg_e[F.tid]; const int lrank = atomicAdd((int*)(lcnt + e), 1);
        __syncthreads();
        if (F.tid < 32) { const int c = lcnt[F.tid]; lbase[F.tid] = c ? (int)atomicAdd(gcnt + F.tid, (unsigned)c) : 0; }
        __syncthreads();
        const int rank = lbase[e] + lrank, tok = rb * 128 + (F.tid >> 2);
        ROWTOK[(size_t)e * NTOK + rank] = tok; TOKE[tok * 4 + (F.tid & 3)] = e; TOKR[tok * 4 + (F.tid & 3)] = rank; TOKG[tok * 4 + (F.tid & 3)] = asg_g[F.tid];
        __syncthreads();
        if (F.tid < 32) lcnt[F.tid] = 0;
        __syncthreads();
    }
}

__device__ __forceinline__ int build_group_tables(const Frame& F, const Args& a, LAS int* cnt, LAS int* pt, LAS int* tile_e) {
    const unsigned* gcnt = (const unsigned*)(a.ws + WS_CTL) + CW_CNT;
    __syncthreads();
    if (F.tid < 32) cnt[F.tid] = (int)__hip_atomic_load(gcnt + F.tid, __ATOMIC_RELAXED, __HIP_MEMORY_SCOPE_AGENT);
    __syncthreads();
    if (F.tid == 0) { int s = 0; for (int e = 0; e < 32; ++e) { pt[e] = s; s += (cnt[e] + 255) >> 8; } pt[32] = s; }
    __syncthreads();
    const int MT = pt[32];
    for (int e = 0; e < 32; ++e) { const int lo = pt[e], n = pt[e + 1] - lo; for (int i = F.tid; i < n; i += NWAVES * 64) tile_e[lo + i] = e; }
    __syncthreads();
    return MT;
}

__device__ __forceinline__ void p7_combine(const Frame& F, const Args& a, const LAS int* pt, float* dst) {
    unsigned char* ws = a.ws; const bf16_t* X1 = (const bf16_t*)(ws + WS_X1); const unsigned char* YB = ws + WS_YB;
    const int* TOKE = (const int*)(ws + WS_TOKE); const int* TOKR = (const int*)(ws + WS_TOKR); const float* TOKG = (const float*)(ws + WS_TOKG);
    const int gw = F.vcu * NWAVES + F.wave, NGW = F.G * NWAVES;
    for (int m = gw; m < NTOK; m += NGW) {
        size_t pos[4]; float g[4];
#pragma unroll
        for (int k = 0; k < 4; ++k) { const int e = TOKE[m * 4 + k]; pos[k] = (size_t)(256 * pt[e] + TOKR[m * 4 + k]) * 1024; g[k] = TOKG[m * 4 + k]; }
#pragma unroll
        for (int j = 0; j < 2; ++j) { const int c0 = 512 * j + 8 * F.lane; float* dp = dst + (size_t)m * 1024 + c0;
            f32x4 o0, o1; { float xx[8]; epi::unpack8(*(const u32x4*)(X1 + (size_t)m * 1024 + c0), xx); o0 = (f32x4){xx[0], xx[1], xx[2], xx[3]}; o1 = (f32x4){xx[4], xx[5], xx[6], xx[7]}; }
#pragma unroll
            for (int k = 0; k < 4; ++k) { float y[8]; { const u32x2 w8 = *(const u32x2*)(YB + pos[k] + c0); y[0] = __builtin_amdgcn_cvt_f32_fp8((int)w8.x, 0); y[1] = __builtin_amdgcn_cvt_f32_fp8((int)w8.x, 1); y[2] = __builtin_amdgcn_cvt_f32_fp8((int)w8.x, 2); y[3] = __builtin_amdgcn_cvt_f32_fp8((int)w8.x, 3);
                  y[4] = __builtin_amdgcn_cvt_f32_fp8((int)w8.y, 0); y[5] = __builtin_amdgcn_cvt_f32_fp8((int)w8.y, 1); y[6] = __builtin_amdgcn_cvt_f32_fp8((int)w8.y, 2); y[7] = __builtin_amdgcn_cvt_f32_fp8((int)w8.y, 3); }
#pragma unroll
                for (int i = 0; i < 4; ++i) { o0[i] += g[k] * y[i]; o1[i] += g[k] * y[4 + i]; } }
            *(f32x4*)dp = o0; *(f32x4*)(dp + 4) = o1; }
    }
}

#define XB_TMO      128
#define XB_XCNT(j)  (256  + 64 * (j))
#define XB_XSUB(j)  (1280 + 64 * (j))
#define XB_XGEN(j)  (2304 + 64 * (j))
#define XB_TOP      3328
#define XB_TOPGEN   3392
#define XCD_BAR_WORDS 3456
#define XB_SPIN_CAP (1u << 20)
__device__ __forceinline__ unsigned xb_ld(unsigned* p)              { return __hip_atomic_load(p, __ATOMIC_RELAXED, __HIP_MEMORY_SCOPE_AGENT); }
__device__ __forceinline__ unsigned xb_add(unsigned* p, unsigned v) { return __hip_atomic_fetch_add(p, v, __ATOMIC_RELAXED, __HIP_MEMORY_SCOPE_AGENT); }
__device__ __forceinline__ unsigned xb_xcc_id() { return (unsigned)__builtin_amdgcn_s_getreg((3 << 11) | 20) & 0xFu; }
#define XB_SPIN(cond, bar) do { unsigned _sp = 0; while (cond) { __builtin_amdgcn_s_sleep(1); \
    if ((++_sp & 255u) == 0u) { if (xb_ld(&(bar)[XB_TMO])) break; if (_sp > XB_SPIN_CAP) { atomicAdd(&(bar)[XB_TMO], 1u); break; } } } } while (0)
struct XcdBarrier { unsigned* bar; unsigned x; volatile LAS unsigned* st; };
__device__ __forceinline__ XcdBarrier xcd_barrier_post(unsigned* bar, volatile LAS unsigned* st) {
    XcdBarrier b; b.bar = bar; b.x = xb_xcc_id(); b.st = st;
    if (threadIdx.x == 0) (void)xb_add(&bar[XB_XCNT(b.x)], 1u);
    return b;
}
__device__ __forceinline__ void xcd_barrier_complete(unsigned* bar, unsigned x, unsigned& nloc, unsigned& nx) {
    const unsigned G = gridDim.x * gridDim.y * gridDim.z;
    unsigned sum, cnt, mine, sp = 0u;
    for (;;) {
        sum = 0u; cnt = 0u; mine = 0u;
#pragma unroll
        for (unsigned j = 0; j < 16; ++j) { const unsigned c = xb_ld(&bar[XB_XCNT(j)]); sum += c; cnt += (c > 0u) ? 1u : 0u; mine = (j == x) ? c : mine; }
        if (sum == G) break;
        __builtin_amdgcn_s_sleep(1);
        if ((++sp & 255u) == 0u) { if (xb_ld(&bar[XB_TMO])) break; if (sp > XB_SPIN_CAP) { atomicAdd(&bar[XB_TMO], 1u); break; } }
    }
    nloc = mine > 0u ? mine : 1u; nx = cnt > 0u ? cnt : 1u;
}
__device__ __forceinline__ void xcd_barrier(const XcdBarrier& b) {
    asm volatile("s_waitcnt vmcnt(0)" ::: "memory");
    __syncthreads();
    if (threadIdx.x == 0) {
        unsigned* bar = b.bar;
        __builtin_amdgcn_s_waitcnt(0);
        unsigned nloc = b.st[0], nx = b.st[1];
        if (nloc == 0u) { xcd_barrier_complete(bar, b.x, nloc, nx); b.st[0] = nloc; b.st[1] = nx; }
        const unsigned old = xb_add(&bar[XB_XSUB(b.x)], 1u);
        const unsigned gen = old / nloc;
        if (old + 1u == (gen + 1u) * nloc) {
            __builtin_amdgcn_fence(__ATOMIC_RELEASE, "agent");
            asm volatile("s_waitcnt vmcnt(0)" ::: "memory");
            const unsigned og = xb_add(&bar[XB_TOP], 1u);
            const unsigned tg = og / nx;
            if (og + 1u == (tg + 1u) * nx) xb_add(&bar[XB_TOPGEN], 1u);
            else XB_SPIN(xb_ld(&bar[XB_TOPGEN]) == tg, bar);
            __builtin_amdgcn_fence(__ATOMIC_ACQUIRE, "agent");
            xb_add(&bar[XB_XGEN(b.x)], 1u);
            asm volatile("s_waitcnt vmcnt(0)" ::: "memory");
        } else {
            XB_SPIN(xb_ld(&bar[XB_XGEN(b.x)]) == gen, bar);
            __builtin_amdgcn_fence(__ATOMIC_ACQUIRE, "agent");
            asm volatile("s_waitcnt vmcnt(0)" ::: "memory");
        }
    }
    __syncthreads();
}

__global__ void __launch_bounds__(NWAVES * 64, 2) hyb_fwd(Args args) {
    extern __shared__ __attribute__((aligned(16))) unsigned char lds_raw[];
#define MKFRAME() Frame F; F.lds = (LAS unsigned char*)lds_raw; F.tid = opaque_tid(); F.lane = F.tid & 63; F.wave = __builtin_amdgcn_readfirstlane(F.tid >> 6); \
    F.G = gridDim.x; { const int bx = blockIdx.x; F.vcu = (F.G % 8 == 0) ? (bx % 8) * (F.G / 8) + bx / 8 : bx; }
    unsigned char* ws = args.ws;
    const int lo = args.ph_lo, hi = args.ph_hi;
#ifndef PHASE_MASK
#define PHASE_MASK 0x1ff
#endif
#define IN(k) (((PHASE_MASK >> (k)) & 1) && lo <= (k) && (k) < hi)
#define BOTH(k) (IN(k) && IN((k) + 1))
#ifndef REPEAT_MASK
#define REPEAT_MASK 0
#endif
#define NREP(k) (1 + ((REPEAT_MASK >> (k)) & 1))
    volatile LAS unsigned* bst = (volatile LAS unsigned*)((LAS unsigned char*)lds_raw + MISC_OFF + MISC_BAR);
    if (threadIdx.x < 4) bst[threadIdx.x] = 0u;
    __syncthreads();
    XcdBarrier xbar; xbar.bar = (unsigned*)(ws + WS_CTL) + CW_BAR; xbar.x = 0; xbar.st = bst;
    if (hi - lo > 1) xbar = xcd_barrier_post((unsigned*)(ws + WS_CTL) + CW_BAR, bst);
#define GRID_BAR() xcd_barrier(xbar)
    LAS int* t_cnt = (LAS int*)((LAS unsigned char*)lds_raw + MISC_OFF); LAS int* t_pt = t_cnt + 64; LAS int* t_tile = t_cnt + 128;
    constexpr size_t TS1024 = (size_t)256 * 1024 * 2, TS512 = (size_t)256 * 512 * 2;

    if (IN(0)) { MKFRAME(); for (int rep = 0; rep < NREP(0); ++rep) { if (rep) GRID_BAR(); p0_prologue(F, args); } if (BOTH(0)) GRID_BAR(); }
    if (IN(1)) {
        MKFRAME();
        for (int bh = blockIdx.x; bh < 32; bh += F.G) p1_cumsum(F, args, bh);
        pg8::DenseOrder S{NTOK / 256, P1_FP8 ? 7 : IN_TILES, F.G, (int)blockIdx.x, (const char*)(ws + WS_XN), (const char*)(ws + WS_WIN), TS1024};
        pg8::SplitOrder S8{NTOK / 256, 10, F.G, (int)blockIdx.x, 7, (const char*)(ws + WS_XN8), (const char*)(ws + WS_WIN8), TS512};
        epi::EpiIn E{(bf16_t*)(ws + WS_QA), (bf16_t*)(ws + WS_KA), (bf16_t*)(ws + WS_VA), (bf16_t*)(ws + WS_QF), (bf16_t*)(ws + WS_KF), (bf16_t*)(ws + WS_VF), ws + WS_GT,
                     (const int*)args.in[1], (const float*)args.in[6], (const float*)args.in[7], (const float*)args.in[9], (const float*)args.in[10], (const float*)args.in[5]};
        for (int rep = 0; rep < NREP(1); ++rep) { if (rep) GRID_BAR(); pg8::gemm_phase<epi::EpiIn, pg8::DenseOrder, false>(F.lds, 1024, S, E); if (P1_FP8) pg8::gemm_phase<epi::EpiIn, pg8::SplitOrder, false, true>(F.lds, 512, S8, E); }
        if (BOTH(1)) GRID_BAR();
    }
    if (IN(2)) { MKFRAME(); for (int rep = 0; rep < NREP(2); ++rep) { if (rep) { GRID_BAR(); if (blockIdx.x == 0 && threadIdx.x == 0) __hip_atomic_store((unsigned*)(ws + WS_CTL) + CW_QCTR, 0u, __ATOMIC_RELAXED, __HIP_MEMORY_SCOPE_AGENT); GRID_BAR(); } p2_attention(F, args, (char*)lds_raw); } if (BOTH(2)) GRID_BAR(); }
    if (IN(3)) {
        MKFRAME();
        pg8::PairOrder S{NTOK / 256, 4, F.G, (int)blockIdx.x, (const char*)(ws + WS_OA), (const char*)(ws + WS_OB), (const char*)(ws + (P3A_FP8 ? WS_WOA8 : WS_WOA)), (const char*)(ws + (P3A_FP8 ? WS_WOB8 : WS_WOB)), P3A_FP8 ? TS512 / 2 : TS512};
        epi::EpiMerge E{ws + WS_GT, (bf16_t*)(ws + WS_MG), ws + WS_MG8};
        for (int rep = 0; rep < NREP(3); ++rep) { if (rep) GRID_BAR();
            if (P3A_FP8) pg8::gemm_phase<epi::EpiMerge, pg8::PairOrder, false, true, 0x7a7a7a7au>(F.lds, 256, S, E);
            else pg8::gemm_phase<epi::EpiMerge, pg8::PairOrder, false>(F.lds, 512, S, E); }
        if (BOTH(3)) GRID_BAR();
    }
    if (IN(4)) {
        MKFRAME();
        pg8::DenseOrder S{NTOK / 256, 4, F.G, (int)blockIdx.x, (const char*)(ws + (P3B_FP8 ? WS_MG8 : WS_MG)), (const char*)(ws + (P3B_FP8 ? WS_WOUT8 : WS_WOUT)), P3B_FP8 ? TS512 : TS1024};
        bool rec;
        { const float* g1p = (const float*)args.in[2]; float mn = fminf(fabsf(g1p[F.tid]), fabsf(g1p[F.tid + 512]));
#pragma unroll
          for (int o = 1; o < 64; o <<= 1) mn = fminf(mn, __shfl_xor(mn, o));
          LAS float* red = (LAS float*)(F.lds + MISC_OFF);
          __syncthreads(); if (F.lane == 0) red[F.wave] = mn; __syncthreads();
          float all = red[0];
#pragma unroll
          for (int w = 1; w < NWAVES; ++w) all = fminf(all, red[w]);
          rec = __builtin_amdgcn_readfirstlane((int)(all >= 0.015625f)) != 0; __syncthreads(); }
        epi::EpiResid E{(const float*)args.in[0], (bf16_t*)(ws + WS_X1), (const bf16_t*)(ws + WS_XN), (const float*)(ws + WS_RMS), (const float*)args.in[2], rec};
        for (int rep = 0; rep < NREP(4); ++rep) { if (rep) GRID_BAR();
            if (P3B_FP8) pg8::gemm_phase<epi::EpiResid, pg8::DenseOrder, false, true, 0x7a7a7a7au>(F.lds, 512, S, E);
            else pg8::gemm_phase<epi::EpiResid, pg8::DenseOrder, false>(F.lds, 1024, S, E); }
        if (BOTH(4)) GRID_BAR();
    }
    if (IN(5)) { MKFRAME(); if (NREP(5) > 1) { p4_router(F, args, true); GRID_BAR(); } p4_router(F, args, false); if (BOTH(5)) GRID_BAR(); }
    if (IN(6)) {
        MKFRAME();
        const int MT = build_group_tables(F, args, t_cnt, t_pt, t_tile);
        LAS int* tokl = (LAS int*)(F.lds + MISC_OFF + MISC_TOKL);
        pg8::GroupOrder S{MT, 8, F.G, (int)blockIdx.x, t_tile, t_pt, t_cnt, (const char*)(ws + WS_XN), (const char*)(ws + WS_WGU), TS512, 2048, tokl, true};
        { const int* ROWTOK = (const int*)(ws + WS_ROWTOK);
          int tv[TOKL_UNITS];
#pragma unroll
          for (int ui = 0; ui < TOKL_UNITS; ++ui) { const long L = (long)ui * F.G + (int)blockIdx.x; tv[ui] = 0;
              if (L < (long)MT * 8 && F.tid < 256) { int pm, pn; pg8::tile_map((int)L, MT, 8, pm, pn); const int e = t_tile[pm], idx = (pm - t_pt[e]) * 256 + F.tid; if (idx < t_cnt[e]) tv[ui] = ROWTOK[(size_t)e * NTOK + idx]; } }
          if (F.tid < 256) {
#pragma unroll
              for (int ui = 0; ui < TOKL_UNITS; ++ui) tokl[ui * 256 + F.tid] = tv[ui]; }
          __syncthreads(); }
        epi::EpiSwiglu E{(const float*)args.in[18], ws + WS_ACT};
        for (int rep = 0; rep < NREP(6); ++rep) { if (rep) GRID_BAR(); pg8::gemm_phase<epi::EpiSwiglu, pg8::GroupOrder, true, true>(F.lds, 512, S, E); }
        if (BOTH(6)) GRID_BAR();
    }
    if (IN(7)) {
        MKFRAME();
        const int MT = build_group_tables(F, args, t_cnt, t_pt, t_tile);
        pg8::GroupOrder S{MT, 4, F.G, (int)blockIdx.x, t_tile, t_pt, t_cnt, (const char*)(ws + WS_ACT), (const char*)(ws + WS_WD), TS512, 1024, (const LAS int*)nullptr, false};
        epi::EpiDown E{(const float*)args.in[20], ws + WS_YB};
        for (int rep = 0; rep < NREP(7); ++rep) { if (rep) GRID_BAR(); pg8::gemm_phase<epi::EpiDown, pg8::GroupOrder, false, true>(F.lds, 512, S, E); }
        if (BOTH(7)) GRID_BAR();
    }
    if (IN(8)) { MKFRAME(); (void)build_group_tables(F, args, t_cnt, t_pt, t_tile); if (NREP(8) > 1) { p7_combine(F, args, t_pt, (float*)(ws + 896 * MiB)); GRID_BAR(); } p7_combine(F, args, t_pt, args.out); }
#undef IN
#undef BOTH
#undef GRID_BAR
#undef MKFRAME
}

extern "C" void kernel_launch(void* const* d_in, const int* in_sizes, int n_in, void* d_out, int out_size, void* d_ws, size_t ws_size, hipStream_t stream) {
    static int grid = 0;
    if (grid == 0) {
        if (n_in != 21 || in_sizes[0] != NTOK * D_MODEL || out_size != NTOK * D_MODEL || ws_size < WS_END) {
            fprintf(stderr, "kernel_launch: unexpected shapes (n_in %d, in0 %d, out %d, ws %zu); nothing launched\n", n_in, n_in > 0 ? in_sizes[0] : -1, out_size, ws_size); grid = -1; return; }
        int dev = 0, cus = 0, per_cu = 0;
        if (hipGetDevice(&dev) != hipSuccess || hipDeviceGetAttribute(&cus, hipDeviceAttributeMultiprocessorCount, dev) != hipSuccess) { fprintf(stderr, "kernel_launch: device query failed\n"); grid = -1; return; }
        if (hipFuncSetAttribute((const void*)hyb_fwd, hipFuncAttributeMaxDynamicSharedMemorySize, LDS_BYTES) != hipSuccess) { fprintf(stderr, "kernel_launch: hipFuncSetAttribute failed\n"); grid = -1; return; }
        if (hipOccupancyMaxActiveBlocksPerMultiprocessor(&per_cu, (const void*)hyb_fwd, NWAVES * 64, LDS_BYTES) != hipSuccess || per_cu < 1) { fprintf(stderr, "kernel_launch: occupancy query says %d\n", per_cu); per_cu = 1; }
        (void)hipGetLastError();
        grid = cus;
        if (grid > cus * per_cu) grid = cus * per_cu;
    }
    if (grid < 0) return;
    (void)hipMemsetAsync((char*)d_ws + WS_CTL, 0, CTL_ZERO_BYTES, stream);
    Args a{};
    for (int i = 0; i < 21; ++i) a.in[i] = d_in[i];
    a.out = (float*)d_out; a.ws = (unsigned char*)d_ws;
#if MK_N_LAUNCHES == 1
    a.ph_lo = 0; a.ph_hi = N_PHASES;
    void* kargs[] = {&a};
    hipError_t e = hipLaunchCooperativeKernel((const void*)hyb_fwd, dim3(grid), dim3(NWAVES * 64), kargs, LDS_BYTES, stream);
    if (e != hipSuccess) fprintf(stderr, "kernel_launch: cooperative launch failed: %s (grid %d)\n", hipGetErrorString(e), grid);
#else
    for (int p = 0; p < N_PHASES; ++p) { a.ph_lo = p; a.ph_hi = p + 1; hipLaunchKernelGGL(hyb_fwd, dim3(grid), dim3(NWAVES * 64), LDS_BYTES, stream, a); }
#endif
}
```

```cpp
#include <hip/hip_runtime.h>
#include <hip/hip_cooperative_groups.h>
#include <hip/hip_bf16.h>
#include <cstdio>
#include <cstdint>
namespace cg = cooperative_groups;

#ifndef XREC
#define XREC 1
#endif
#ifndef P3A_FP8
#define P3A_FP8 1
#endif
#ifndef P3B_FP8
#define P3B_FP8 1
#endif
#ifndef P1_FP8
#define P1_FP8 1
#endif
#ifndef MK_N_LAUNCHES
#define MK_N_LAUNCHES 1
#endif

#define LAS __attribute__((address_space(3)))
typedef unsigned short bf16_t;
typedef short bf16x8 __attribute__((ext_vector_type(8)));
typedef short s16x4 __attribute__((ext_vector_type(4)));
typedef float f32x2 __attribute__((ext_vector_type(2)));
typedef float f32x4 __attribute__((ext_vector_type(4)));
typedef float f32x16 __attribute__((ext_vector_type(16)));
typedef unsigned u32x2 __attribute__((ext_vector_type(2)));
typedef unsigned u32x4 __attribute__((ext_vector_type(4)));
typedef int i32x4_t __attribute__((ext_vector_type(4)));

constexpr int D_MODEL = 1024, BATCH = 4, SEQ = 8192, NTOK = BATCH * SEQ;
constexpr int HD = 64, SWA_QH = 8, SWA_KVH = 2, FOX_H = 8, N_EXP = 32, TOPK = 4, D_FF = 1024;
constexpr int IN_W = 4360, COL_FL = 2304, COL_GL = 2312;
constexpr int IN_TILES = 17;
constexpr float EPS = 1e-6f;
constexpr float LOG2E = 1.4426950408889634f;
constexpr float C2 = 0.125f * LOG2E;
constexpr int CAP_TILES = (NTOK * TOPK) / 256 + N_EXP;

__device__ __forceinline__ unsigned cvt_pk_bf16(float lo, float hi) { typedef __bf16 b2 __attribute__((ext_vector_type(2))); f32x2 v = {lo, hi}; b2 b = __builtin_convertvector(v, b2); return __builtin_bit_cast(unsigned, b); }
__device__ __forceinline__ float bf_lo(unsigned u) { return __uint_as_float(u << 16); }
__device__ __forceinline__ float bf_hi(unsigned u) { return __uint_as_float(u & 0xffff0000u); }
__device__ __forceinline__ float bf2f(short s) { return __uint_as_float(((unsigned)(unsigned short)s) << 16); }
__device__ __forceinline__ float clamp448(float x) { return __builtin_fminf(__builtin_fmaxf(x, -448.0f), 448.0f); }
__device__ __forceinline__ unsigned pk4_fp8(float a, float b, float c, float d) {
    int r = __builtin_amdgcn_cvt_pk_fp8_f32(clamp448(a), clamp448(b), 0, false); r = __builtin_amdgcn_cvt_pk_fp8_f32(clamp448(c), clamp448(d), r, true); return (unsigned)r; }
__device__ __forceinline__ unsigned pk4_fp8_nc(float a, float b, float c, float d) { int r = __builtin_amdgcn_cvt_pk_fp8_f32(a, b, 0, false); r = __builtin_amdgcn_cvt_pk_fp8_f32(c, d, r, true); return (unsigned)r; }
typedef int i32x8 __attribute__((ext_vector_type(8)));
constexpr float W8_SCALE = 32.0f;
__device__ __forceinline__ int opaque_tid() { int t = threadIdx.x; asm volatile("" : "+v"(t)); return t; }
__host__ __device__ __forceinline__ int perm32s(int p) { return 16 * ((p >> 2) & 1) + 4 * (p >> 3) + (p & 3); }

namespace pg8 {
constexpr int BM = 256, BK = 64, HALF = 128, HTB = HALF * BK * 2  , STAGE_BYTES = 8 * HTB, NXCD = 8, WGM = 4;
__host__ __device__ __forceinline__ int lds_byte(int r, int c) { const int st = (r >> 4) * 2 + (c >> 5), rr = r & 15, cc = c & 31, ob = rr * 64 + cc * 2; return st * 1024 + (ob ^ (((ob >> 9) & 1) << 5)); }
__host__ __device__ __forceinline__ void stage_rc(int b, int& R, int& C) { const int st = b / 1024, sb = b % 1024, swz = sb ^ (((sb >> 9) & 1) << 5); R = (st >> 1) * 16 + swz / 64; C = (st & 1) * 32 + (swz % 64) / 2; }

struct Unit { int pm, pn, e; const char* a; const char* b; const LAS int* gtab; int gcnt; };

__device__ __forceinline__ void tile_map(int L, int nM, int nN, int& pm, int& pn) {
    const int nwg = nM * nN; int wgid = L; { const int q = nwg / NXCD, r = nwg % NXCD, xcd = wgid % NXCD, off = wgid / NXCD; wgid = (xcd < r ? xcd * (q + 1) : r * (q + 1) + (xcd - r) * q) + off; }
    const int nig = WGM * nN, gid = wgid / nig, fm = gid * WGM, gsz = (nM - fm) < WGM ? (nM - fm) : WGM;
    pm = fm + ((wgid % nig) % gsz); pn = (wgid % nig) / gsz;
}
struct DenseOrder {
    int nM, nN, G, c; const char* A; const char* B; size_t tstep;
    __device__ __forceinline__ bool next(int i, Unit& u) const {
        const long L = (long)i * G + c; if (L >= (long)nM * nN) return false;
        tile_map((int)L, nM, nN, u.pm, u.pn); u.e = 0; u.a = A + (size_t)u.pm * tstep; u.b = B + (size_t)u.pn * tstep; u.gtab = nullptr; u.gcnt = 0; return true; }
};
struct SplitOrder {
    int nM, nN, G, c, pn0; const char* A; const char* B; size_t tstep;
    __device__ __forceinline__ bool next(int i, Unit& u) const {
        long L;
        if (G == 256 && nM * nN == 1280) { if (c < 128) { if (i >= 4) return false; L = (long)i * 128 + c; } else { if (i >= 6) return false; L = 512 + (long)i * 128 + (c - 128); } }
        else { L = (long)i * G + c; if (L >= (long)nM * nN) return false; }
        tile_map((int)L, nM, nN, u.pm, u.pn); u.e = 0; u.a = A + (size_t)u.pm * tstep; u.b = B + (size_t)u.pn * tstep; u.pn += pn0; u.gtab = nullptr; u.gcnt = 0; return true; }
};
struct PairOrder {
    int nM, nN, G, c; const char* A0; const char* A1; const char* B0; const char* B1; size_t tstep;
    __device__ __forceinline__ bool next(int i, Unit& u) const {
        const long L = (long)(i >> 1) * G + c; if (L >= (long)nM * nN) return false;
        tile_map((int)L, nM, nN, u.pm, u.pn); u.e = i & 1; u.a = ((i & 1) ? A1 : A0) + (size_t)u.pm * tstep; u.b = ((i & 1) ? B1 : B0) + (size_t)u.pn * tstep; u.gtab = nullptr; u.gcnt = 0; return true; }
};
struct GroupOrder {
    int MT, nN, G, c; const LAS int* tile_e; const LAS int* pt; const LAS int* cnt; const char* A; const char* B; size_t tstep; int brows; const LAS int* tokl; bool gather;
    __device__ __forceinline__ bool next(int i, Unit& u) const {
        const long L = (long)i * G + c; if (L >= (long)MT * nN) return false;
        tile_map((int)L, MT, nN, u.pm, u.pn); const int e = tile_e[u.pm]; u.e = e;
        u.b = B + ((size_t)e * brows + (size_t)u.pn * BM) / BM * tstep;
        if (gather) { u.a = A; u.gtab = tokl + i * BM; u.gcnt = BM; }
        else { u.a = A + (size_t)u.pm * tstep; u.gtab = nullptr; u.gcnt = 0; }
        return true; }
};

template <class Epi, class Sched, bool GATHER, bool FP8 = false, unsigned ASC = 0x7f7f7f7fu>
__device__ __forceinline__ void gemm_phase(LAS unsigned char* lds, const int K, const Sched& S, const Epi& E) {
    const int tid = opaque_tid(), wid = __builtin_amdgcn_readfirstlane(tid >> 6), lane = tid & 63, wr = wid >> 2, wc = wid & 3, fr = lane & 15, fq = lane >> 4;
    const int nt = K / BK;
    unsigned voffA[2], voffB[2]; int RA[2]; unsigned CA2[2];
#pragma unroll
    for (int i = 0; i < 2; ++i) { int R, C; stage_rc(tid * 16 + i * 8192, R, C); voffA[i] = (unsigned)(R * K + C) * 2u; voffB[i] = voffA[i]; RA[i] = R; CA2[i] = (unsigned)C * 2u; }
    const size_t kstep = (size_t)(BK * 2);
    const size_t hstep = (size_t)HALF * K * 2;
    const unsigned ldsw = (unsigned)wid * 1024u;
    const int aoff = lds_byte(wr * 64 + fr, fq * 8), boff = lds_byte(wc * 32 + fr, fq * 8);
#define PG8_SA(b, h) (((b) * 2 + (h)) * HTB)
#define PG8_SB(b, h) ((4 + (b) * 2 + (h)) * HTB)
#define PG8_STAGE(bufoff, gbase, voff) do { _Pragma("unroll") for (int _i = 0; _i < 2; ++_i) \
        __builtin_amdgcn_global_load_lds((const unsigned*)((const char*)(gbase) + (voff)[_i]), (LAS unsigned*)(lds + (bufoff) + ldsw + _i * 8192), 16, 0, 0); } while (0)
#define PG8_STAGE_A(bufoff, gbase, h, NXT) do { if constexpr (GATHER) { unsigned _v[2]; _v[0] = (NXT) ? nv[h][0] : cv[h][0]; _v[1] = (NXT) ? nv[h][1] : cv[h][1]; PG8_STAGE(bufoff, gbase, _v); } \
        else { PG8_STAGE(bufoff, (const char*)(gbase) + (h) * hstep, voffA); } } while (0)
#define PG8_LOADG(u, v) do { _Pragma("unroll") for (int _h = 0; _h < 2; ++_h) _Pragma("unroll") for (int _i = 0; _i < 2; ++_i) { const int _r = _h * HALF + RA[_i]; \
        const int _tok = (u).gtab[_r]; v[_h][_i] = (unsigned)_tok * (unsigned)(K * 2) + CA2[_i]; } } while (0)
#define PG8_LDA(dst, b, h) do { _Pragma("unroll") for (int m = 0; m < 4; ++m) _Pragma("unroll") for (int k = 0; k < 2; ++k) dst[m][k] = *(const LAS bf16x8*)(lds + PG8_SA(b, h) + aoff + m * 2048 + k * 1024); } while (0)
#define PG8_LDB(dst, b, h) do { _Pragma("unroll") for (int n = 0; n < 2; ++n) _Pragma("unroll") for (int k = 0; k < 2; ++k) dst[n][k] = *(const LAS bf16x8*)(lds + PG8_SB(b, h) + boff + n * 2048 + k * 1024); } while (0)
#define PG8_CAT(x) __builtin_shufflevector(__builtin_bit_cast(i32x4_t, x[0]), __builtin_bit_cast(i32x4_t, x[1]), 0, 1, 2, 3, 4, 5, 6, 7)
#define PG8_MMA(ai, bj, At, Bt) do { __builtin_amdgcn_s_setprio(1); if constexpr (FP8) { _Pragma("unroll") for (int m = 0; m < 4; ++m) _Pragma("unroll") for (int n = 0; n < 2; ++n) \
        asm volatile("v_mfma_scale_f32_16x16x128_f8f6f4 %0, %1, %2, %0, %3, %4 op_sel_hi:[0,0,0]" : "+v"(acc[ai][bj][m][n]) : "v"(PG8_CAT(Bt[n])), "v"(PG8_CAT(At[m])), "v"(0x7a7a7a7a), "v"(ASC)); } \
        else { _Pragma("unroll") for (int m = 0; m < 4; ++m) _Pragma("unroll") for (int n = 0; n < 2; ++n) _Pragma("unroll") for (int k = 0; k < 2; ++k) \
        acc[ai][bj][m][n] = __builtin_amdgcn_mfma_f32_16x16x32_bf16(Bt[n][k], At[m][k], acc[ai][bj][m][n], 0, 0, 0); } __builtin_amdgcn_s_setprio(0); } while (0)
#define PG8_WAIT_V(n) asm volatile("s_waitcnt vmcnt(" #n ")" ::: "memory")
#define PG8_WAIT_L(n) asm volatile("s_waitcnt lgkmcnt(" #n ")" ::: "memory")
#define PG8_BAR __builtin_amdgcn_s_barrier()
#define PG8_SCHED __builtin_amdgcn_sched_barrier(0)
    Unit cur, nxt; int ui = 0;
    if (!S.next(0, cur)) return;
    f32x4 acc[2][2][4][2];
#pragma unroll
    for (int a = 0; a < 2; ++a)
#pragma unroll
        for (int b = 0; b < 2; ++b)
#pragma unroll
            for (int m = 0; m < 4; ++m)
#pragma unroll
                for (int n = 0; n < 2; ++n) acc[a][b][m][n] = (f32x4){0.f, 0.f, 0.f, 0.f};
    bf16x8 At[4][2], B0[2][2], B1[2][2];
    unsigned cv[2][2] = {{0u, 0u}, {0u, 0u}}, nv[2][2] = {{0u, 0u}, {0u, 0u}};
    const char* cA = cur.a; const char* cB = cur.b;
    if constexpr (GATHER) { PG8_LOADG(cur, cv); }
    PG8_STAGE(PG8_SB(0, 0), cB, voffB); PG8_STAGE(PG8_SB(0, 1), cB + hstep, voffB); PG8_STAGE_A(PG8_SA(0, 0), cA, 0, false); PG8_STAGE_A(PG8_SA(0, 1), cA, 1, false);
    if (wr == 1) PG8_BAR;
    PG8_WAIT_V(2); PG8_BAR;
    PG8_STAGE(PG8_SB(1, 0), cB + kstep, voffB); PG8_STAGE_A(PG8_SA(1, 0), cA + kstep, 0, false); PG8_STAGE(PG8_SB(1, 1), cB + hstep + kstep, voffB);
    PG8_WAIT_V(6); PG8_BAR;
    for (;;) {
        const bool has_next = S.next(ui + 1, nxt);
        const char* nA = has_next ? nxt.a : cA; const char* nB = has_next ? nxt.b : cB;
        if constexpr (GATHER) {
            if (has_next) { PG8_LOADG(nxt, nv); }
            else {
#pragma unroll
                for (int h = 0; h < 2; ++h)
#pragma unroll
                    for (int i = 0; i < 2; ++i) nv[h][i] = cv[h][i]; }
        }
#pragma clang loop unroll(disable)
        for (int t = 0; t < nt; t += 2) {
            const bool last = (t == nt - 2);
            const char* a1 = cA + (size_t)(t + 1) * kstep;
            const char* a2 = last ? nA : cA + (size_t)(t + 2) * kstep; const char* b2 = last ? nB : cB + (size_t)(t + 2) * kstep;
            const char* a3 = a2 + kstep; const char* b3 = b2 + kstep;
            PG8_LDB(B0, 0, 0); PG8_LDB(B1, 0, 1); PG8_SCHED; PG8_LDA(At, 0, 0); PG8_STAGE_A(PG8_SA(1, 1), a1, 1, false);
            PG8_WAIT_V(8); PG8_WAIT_L(0); PG8_BAR; PG8_MMA(0, 0, At, B0); PG8_MMA(0, 1, At, B1); PG8_BAR; PG8_SCHED;
            PG8_LDA(At, 0, 1); PG8_STAGE(PG8_SB(0, 0), b2, voffB); PG8_STAGE(PG8_SB(0, 1), b2 + hstep, voffB); PG8_STAGE_A(PG8_SA(0, 0), a2, 0, last);
            PG8_WAIT_V(8); PG8_WAIT_L(0); PG8_BAR; PG8_MMA(1, 0, At, B0); PG8_MMA(1, 1, At, B1); PG8_BAR; PG8_SCHED;
            PG8_LDB(B0, 1, 0); PG8_LDB(B1, 1, 1); PG8_SCHED; PG8_LDA(At, 1, 0); PG8_STAGE_A(PG8_SA(0, 1), a2, 1, last);
            PG8_WAIT_V(8); PG8_WAIT_L(0); PG8_BAR; PG8_MMA(0, 0, At, B0); PG8_MMA(0, 1, At, B1); PG8_BAR; PG8_SCHED;
            PG8_LDA(At, 1, 1); PG8_STAGE(PG8_SB(1, 0), b3, voffB); PG8_STAGE(PG8_SB(1, 1), b3 + hstep, voffB); PG8_STAGE_A(PG8_SA(1, 0), a3, 0, last);
            PG8_WAIT_V(8); PG8_WAIT_L(0); PG8_BAR; PG8_MMA(1, 0, At, B0); PG8_MMA(1, 1, At, B1); PG8_BAR; PG8_SCHED;
        }
        if constexpr (FP8) asm volatile("s_nop 15\n\ts_nop 7" ::: "memory");
        if (wr == 0) PG8_BAR;
        bool keep = false;
        if constexpr (Epi::PAIR_KEEP) keep = (cur.e == 0);
        if constexpr (Epi::PAIR_KEEP) { if (keep) E.rescale(acc, cur, wr, wc, fr, fq); else E(acc, cur, wr, wc, fr, fq); } else E(acc, cur, wr, wc, fr, fq);
        if (!has_next) break;
        if (!keep) {
#pragma unroll
        for (int a = 0; a < 2; ++a)
#pragma unroll
            for (int b = 0; b < 2; ++b)
#pragma unroll
                for (int m = 0; m < 4; ++m)
#pragma unroll
                    for (int n = 0; n < 2; ++n) acc[a][b][m][n] = (f32x4){0.f, 0.f, 0.f, 0.f};
        }
        cur = nxt; cA = nA; cB = nB; ++ui;
        if constexpr (GATHER) {
#pragma unroll
            for (int h = 0; h < 2; ++h)
#pragma unroll
                for (int i = 0; i < 2; ++i) cv[h][i] = nv[h][i]; }
        if (wr == 1) PG8_BAR;
    }
    PG8_WAIT_V(0);
    PG8_BAR;
#undef PG8_SA
#undef PG8_SB
#undef PG8_STAGE
#undef PG8_STAGE_A
#undef PG8_LOADG
#undef PG8_LDA
#undef PG8_LDB
#undef PG8_MMA
#undef PG8_CAT
#undef PG8_WAIT_V
#undef PG8_WAIT_L
#undef PG8_BAR
#undef PG8_SCHED
}
}

namespace epi {
using pg8::Unit;
__device__ __forceinline__ u32x4 pack8(const f32x4& a, const f32x4& b) { u32x4 w; w.x = cvt_pk_bf16(a[0], a[1]); w.y = cvt_pk_bf16(a[2], a[3]); w.z = cvt_pk_bf16(b[0], b[1]); w.w = cvt_pk_bf16(b[2], b[3]); return w; }
__device__ __forceinline__ void unpack8(const u32x4& w, float (&f)[8]) { f[0] = bf_lo(w.x); f[1] = bf_hi(w.x); f[2] = bf_lo(w.y); f[3] = bf_hi(w.y); f[4] = bf_lo(w.z); f[5] = bf_hi(w.z); f[6] = bf_lo(w.w); f[7] = bf_hi(w.w); }
__device__ __forceinline__ float sigmoidf_(float z) { return __builtin_amdgcn_rcpf(1.0f + __expf(-z)); }

struct EpiIn {
    static constexpr bool PAIR_KEEP = false;
    bf16_t *QA, *KA, *VA, *QF, *KF, *VF; unsigned char* GT; const int* pos; const float *qn_s, *kn_s, *qn_f, *kn_f, *b_gate;
    __device__ __forceinline__ void operator()(const f32x4 (&acc)[2][2][4][2], const Unit& u, int wr, int wc, int fr, int fq) const {
        const int pn = u.pn; const int row0 = u.pm * 256 + wr * 64 + fr;
        if (pn >= 9) {
            const int col0 = (pn - 9) * 256 + wc * 64 + 16 * fq;
            f32x4 bv[2][2];
#pragma unroll
            for (int bj = 0; bj < 2; ++bj)
#pragma unroll
                for (int n = 0; n < 2; ++n) bv[bj][n] = *(const f32x4*)(b_gate + col0 + bj * 8 + 4 * n) * (-LOG2E);
#pragma unroll
            for (int ai = 0; ai < 2; ++ai)
#pragma unroll
                for (int m = 0; m < 4; ++m) { u32x4 w;
#pragma unroll
                    for (int bj = 0; bj < 2; ++bj)
#pragma unroll
                        for (int n = 0; n < 2; ++n) { const f32x4 v = acc[ai][bj][m][n]; unsigned r = 0;
#pragma unroll
                            for (int i = 0; i < 4; ++i) { const float sg = __builtin_amdgcn_rcpf(1.0f + __builtin_amdgcn_exp2f(__builtin_fmaf(v[i], -LOG2E, bv[bj][n][i])));
                                r = __builtin_amdgcn_cvt_pk_u8_f32(__builtin_fmaf(sg, 255.0f, 0.5f), i, r); }
                            w[2 * bj + n] = r; }
                    *(u32x4*)(GT + (size_t)(row0 + ai * 128 + m * 16) * 2048 + col0) = w; }
            return;
        }
        bf16_t* dst; int pitch, hcol; const float* nw; bool rope; float scale;
        if (pn < 2)       { dst = QA; pitch = 512; hcol = (4 * pn + wc) * 64; nw = qn_s; rope = true; scale = C2; }
        else if (pn == 2) { if (wc < 2) { dst = KA; pitch = 128; hcol = wc * 64; nw = kn_s; rope = true; scale = 1.f; } else { dst = VA; pitch = 128; hcol = (wc - 2) * 64; nw = nullptr; rope = false; scale = 1.f; } }
        else if (pn < 5)  { dst = QF; pitch = 512; hcol = (4 * (pn - 3) + wc) * 64; nw = qn_f; rope = false; scale = C2; }
        else if (pn < 7)  { dst = KF; pitch = 512; hcol = (4 * (pn - 5) + wc) * 64; nw = kn_f; rope = false; scale = 1.f; }
        else              { dst = VF; pitch = 512; hcol = (4 * (pn - 7) + wc) * 64; nw = nullptr; rope = false; scale = 1.f; }
        f32x4 wv[2][2]; float inv[2][4];
#pragma unroll
        for (int bj = 0; bj < 2; ++bj)
#pragma unroll
            for (int n = 0; n < 2; ++n) { wv[bj][n] = nw ? *(const f32x4*)(nw + 32 * bj + 8 * fq + 4 * n) : (f32x4){1.f, 1.f, 1.f, 1.f}; wv[bj][n] = wv[bj][n] * scale; }
#pragma unroll
        for (int n = 0; n < 2; ++n)
#pragma unroll
            for (int i = 0; i < 4; ++i) inv[n][i] = exp2f(-(float)(8 * fq + 4 * n + i) * (13.287712379549449f / 32.0f)) * 0.15915494309189535f;
        float posf[8];
#pragma unroll
        for (int g = 0; g < 8; ++g) posf[g] = rope ? (float)pos[row0 + (g >> 2) * 128 + (g & 3) * 16] : 0.f;
#pragma unroll
        for (int ai = 0; ai < 2; ++ai)
#pragma unroll
            for (int m = 0; m < 4; ++m) {
                const int row = row0 + ai * 128 + m * 16;
                f32x4 v[2][2];
#pragma unroll
                for (int bj = 0; bj < 2; ++bj)
#pragma unroll
                    for (int n = 0; n < 2; ++n) v[bj][n] = acc[ai][bj][m][n];
                if (nw) {
                    float ss = 0.f;
#pragma unroll
                    for (int bj = 0; bj < 2; ++bj)
#pragma unroll
                        for (int n = 0; n < 2; ++n) ss += (v[bj][n][0] * v[bj][n][0] + v[bj][n][1] * v[bj][n][1]) + (v[bj][n][2] * v[bj][n][2] + v[bj][n][3] * v[bj][n][3]);
                    ss += __shfl_xor(ss, 16); ss += __shfl_xor(ss, 32);
                    const float rstd = rsqrtf(ss * (1.0f / 64.0f) + EPS);
#pragma unroll
                    for (int bj = 0; bj < 2; ++bj)
#pragma unroll
                        for (int n = 0; n < 2; ++n) v[bj][n] = v[bj][n] * rstd * wv[bj][n];
                }
                if (rope) {
                    const float p = posf[ai * 4 + m];
#pragma unroll
                    for (int n = 0; n < 2; ++n)
#pragma unroll
                        for (int i = 0; i < 4; ++i) { float rev = p * inv[n][i]; rev = rev - floorf(rev); const float sn = __builtin_amdgcn_sinf(rev), cs = __builtin_amdgcn_cosf(rev);
                            const float x1 = v[0][n][i], x2 = v[1][n][i]; v[0][n][i] = x1 * cs - x2 * sn; v[1][n][i] = x2 * cs + x1 * sn; }
                }
                bf16_t* rowp = dst + (size_t)row * pitch + hcol + 8 * fq;
                *(u32x4*)(rowp) = pack8(v[0][0], v[0][1]);
                *(u32x4*)(rowp + 32) = pack8(v[1][0], v[1][1]);
            }
    }
};

struct EpiMerge {
    static constexpr bool PAIR_KEEP = (P3B_FP8 != 0);
    const unsigned char* GT; bf16_t* MG; unsigned char* MG8;
    __device__ __forceinline__ void rescale(f32x4 (&acc)[2][2][4][2], const Unit& u, int wr, int wc, int fr, int fq) const {
        const int row0 = u.pm * 256 + wr * 64 + fr, col0 = u.pn * 256 + wc * 32 + 8 * fq;
#pragma unroll
        for (int hf = 0; hf < 2; ++hf) {
            u32x2 ga8[4][2], gb8[4][2];
#pragma unroll
            for (int m = 0; m < 4; ++m)
#pragma unroll
                for (int bj = 0; bj < 2; ++bj) { const unsigned char* p = GT + (size_t)(row0 + hf * 128 + m * 16) * 2048 + col0 + bj * 128; ga8[m][bj] = *(const u32x2*)p; gb8[m][bj] = *(const u32x2*)(p + 1024); }
#pragma unroll
            for (int m = 0; m < 4; ++m)
#pragma unroll
                for (int bj = 0; bj < 2; ++bj)
#pragma unroll
                    for (int n = 0; n < 2; ++n) { const unsigned ga = n ? ga8[m][bj].y : ga8[m][bj].x, gb = n ? gb8[m][bj].y : gb8[m][bj].x;
#pragma unroll
                        for (int i = 0; i < 4; ++i) acc[hf][bj][m][n][i] *= (float)((ga >> (8 * i)) & 255u) * __builtin_amdgcn_rcpf(fmaxf((float)((gb >> (8 * i)) & 255u), 0.5f)); }
            __builtin_amdgcn_sched_barrier(0);
        }
    }
    __device__ __forceinline__ void operator()(const f32x4 (&acc)[2][2][4][2], const Unit& u, int wr, int wc, int fr, int fq) const {
        const int row0 = u.pm * 256 + wr * 64 + fr, col0 = u.pn * 256 + wc * 32 + 8 * fq, part = u.e;
        if constexpr (PAIR_KEEP) {
            u32x2 gb8[8][2];
#pragma unroll
            for (int g = 0; g < 8; ++g)
#pragma unroll
                for (int bj = 0; bj < 2; ++bj) gb8[g][bj] = *(const u32x2*)(GT + (size_t)(row0 + (g >> 2) * 128 + (g & 3) * 16) * 2048 + 1024 + col0 + bj * 128);
            asm volatile("" ::: "memory");
#pragma unroll
            for (int g = 0; g < 8; ++g)
#pragma unroll
                for (int bj = 0; bj < 2; ++bj) { float f[8];
#pragma unroll
                    for (int n = 0; n < 2; ++n) { const unsigned gb = n ? gb8[g][bj].y : gb8[g][bj].x; const f32x4 v = acc[g >> 2][bj][g & 3][n];
#pragma unroll
                        for (int i = 0; i < 4; ++i) f[4 * n + i] = v[i] * (fmaxf((float)((gb >> (8 * i)) & 255u), 0.5f) * (32.0f / 255.0f)); }
                    u32x2 w8; w8.x = pk4_fp8(f[0], f[1], f[2], f[3]); w8.y = pk4_fp8(f[4], f[5], f[6], f[7]);
                    *(u32x2*)(MG8 + (size_t)(row0 + (g >> 2) * 128 + (g & 3) * 16) * 1024 + col0 + bj * 128) = w8; }
            return;
        }
        u32x2 g8[8][2]; u32x4 mg[8][2];
#define EM_ROW(g) (row0 + ((g) >> 2) * 128 + ((g) & 3) * 16)
#define EM_LDMG(g) do { _Pragma("unroll") for (int bj = 0; bj < 2; ++bj) mg[g][bj] = part ? *(const u32x4*)(MG + (size_t)EM_ROW(g) * 1024 + col0 + bj * 128) : (u32x4){0u, 0u, 0u, 0u}; } while (0)
#pragma unroll
        for (int g = 0; g < 8; ++g)
#pragma unroll
            for (int bj = 0; bj < 2; ++bj) g8[g][bj] = *(const u32x2*)(GT + (size_t)EM_ROW(g) * 2048 + part * 1024 + col0 + bj * 128);
        EM_LDMG(0); EM_LDMG(1);
        asm volatile("" ::: "memory");
#pragma unroll
        for (int g = 0; g < 8; ++g) {
            u32x4 ov[2];
#pragma unroll
            for (int bj = 0; bj < 2; ++bj) { const unsigned ga = g8[g][bj].x, gb = g8[g][bj].y; float o[8]; unpack8(mg[g][bj], o);
                f32x4 v0 = acc[g >> 2][bj][g & 3][0], v1 = acc[g >> 2][bj][g & 3][1];
#pragma unroll
                for (int i = 0; i < 4; ++i) { v0[i] = v0[i] * ((float)((ga >> (8 * i)) & 255u) * (1.0f / 255.0f)) + o[i]; v1[i] = v1[i] * ((float)((gb >> (8 * i)) & 255u) * (1.0f / 255.0f)) + o[4 + i]; }
                ov[bj] = pack8(v0, v1); }
            if (g + 2 < 8) { EM_LDMG(g + 2); }
            asm volatile("" ::: "memory");
#pragma unroll
            for (int bj = 0; bj < 2; ++bj) {
                if (P3B_FP8 && part) { float f[8]; unpack8(ov[bj], f); u32x2 w8; w8.x = pk4_fp8(f[0] * 32.0f, f[1] * 32.0f, f[2] * 32.0f, f[3] * 32.0f); w8.y = pk4_fp8(f[4] * 32.0f, f[5] * 32.0f, f[6] * 32.0f, f[7] * 32.0f);
                    *(u32x2*)(MG8 + (size_t)EM_ROW(g) * 1024 + col0 + bj * 128) = w8; }
                else *(u32x4*)(MG + (size_t)EM_ROW(g) * 1024 + col0 + bj * 128) = ov[bj]; }
            asm volatile("" ::: "memory");
        }
#undef EM_ROW
#undef EM_LDMG
    }
};

struct EpiResid {
    static constexpr bool PAIR_KEEP = false;
    const float* X; bf16_t* O; const bf16_t* XN; const float* RMS; const float* G1; bool rec;
    __device__ __forceinline__ void operator()(const f32x4 (&acc)[2][2][4][2], const Unit& u, int wr, int wc, int fr, int fq) const {
        const int row0 = u.pm * 256 + wr * 64 + fr, col0 = u.pn * 256 + wc * 32 + 8 * fq;
#define ER_OFF(g) ((size_t)(row0 + ((g) >> 2) * 128 + ((g) & 3) * 16) * 1024 + col0)
        if (XREC != 0 && rec) {
            u32x4 xn[8][2]; float rm[8]; f32x4 ig[2][2];
#define XR_LD(g) do { rm[g] = RMS[row0 + ((g) >> 2) * 128 + ((g) & 3) * 16]; _Pragma("unroll") for (int bj = 0; bj < 2; ++bj) xn[g][bj] = *(const u32x4*)(XN + ER_OFF(g) + bj * 128); } while (0)
#pragma unroll
            for (int bj = 0; bj < 2; ++bj)
#pragma unroll
                for (int n = 0; n < 2; ++n) { const f32x4 gg = *(const f32x4*)(G1 + col0 + bj * 128 + 4 * n);
#pragma unroll
                    for (int i = 0; i < 4; ++i) ig[bj][n][i] = __builtin_amdgcn_rcpf(gg[i]); }
            XR_LD(0); XR_LD(1); XR_LD(2);
            asm volatile("" ::: "memory");
#pragma unroll
            for (int g = 0; g < 8; ++g) {
                u32x4 ov[2];
#pragma unroll
                for (int bj = 0; bj < 2; ++bj) { float f[8]; unpack8(xn[g][bj], f); f32x4 v0, v1;
#pragma unroll
                    for (int i = 0; i < 4; ++i) { v0[i] = __builtin_fmaf(f[i] * rm[g], ig[bj][0][i], acc[g >> 2][bj][g & 3][0][i]); v1[i] = __builtin_fmaf(f[4 + i] * rm[g], ig[bj][1][i], acc[g >> 2][bj][g & 3][1][i]); }
                    ov[bj] = pack8(v0, v1); }
                if (g + 3 < 8) { XR_LD(g + 3); }
                asm volatile("" ::: "memory");
#pragma unroll
                for (int bj = 0; bj < 2; ++bj) *(u32x4*)(O + ER_OFF(g) + bj * 128) = ov[bj];
                asm volatile("" ::: "memory");
            }
#undef XR_LD
        } else {
        f32x4 xr[8][2][2];
#define ER_LD(g) do { _Pragma("unroll") for (int bj = 0; bj < 2; ++bj) _Pragma("unroll") for (int n = 0; n < 2; ++n) xr[g][bj][n] = *(const f32x4*)(X + ER_OFF(g) + bj * 128 + n * 4); } while (0)
        ER_LD(0); ER_LD(1); ER_LD(2);
        asm volatile("" ::: "memory");
#pragma unroll
        for (int g = 0; g < 8; ++g) {
            u32x4 ov[2];
#pragma unroll
            for (int bj = 0; bj < 2; ++bj) ov[bj] = pack8(xr[g][bj][0] + acc[g >> 2][bj][g & 3][0], xr[g][bj][1] + acc[g >> 2][bj][g & 3][1]);
            if (g + 3 < 8) { ER_LD(g + 3); }
            asm volatile("" ::: "memory");
#pragma unroll
            for (int bj = 0; bj < 2; ++bj) *(u32x4*)(O + ER_OFF(g) + bj * 128) = ov[bj];
            asm volatile("" ::: "memory");
        }
#undef ER_LD
        }
#undef ER_OFF
    }
};

struct EpiSwiglu {
    static constexpr bool PAIR_KEEP = false;
    const float* bgu; unsigned char* ACT;
    __device__ __forceinline__ void operator()(const f32x4 (&acc)[2][2][4][2], const Unit& u, int wr, int wc, int fr, int fq) const {
        const int row0 = u.pm * 256 + wr * 64 + fr, f0 = u.pn * 128 + wc * 32 + 8 * fq; const float* be = bgu + (size_t)u.e * 2048;
        f32x4 bg[2], bu[2];
#pragma unroll
        for (int n = 0; n < 2; ++n) { bg[n] = *(const f32x4*)(be + f0 + 4 * n); bu[n] = *(const f32x4*)(be + 1024 + f0 + 4 * n) + 1.0f; }
#pragma unroll
        for (int ai = 0; ai < 2; ++ai)
#pragma unroll
            for (int m = 0; m < 4; ++m) { f32x4 o[2];
#pragma unroll
                for (int n = 0; n < 2; ++n) { const f32x4 g = acc[ai][0][m][n] + bg[n], uu = acc[ai][1][m][n] + bu[n];
#pragma unroll
                    for (int i = 0; i < 4; ++i) { const float gc = fminf(g[i], 7.0f), up = __builtin_amdgcn_fmed3f(uu[i], -6.0f, 8.0f);
                        o[n][i] = up * (gc * __builtin_amdgcn_rcpf(1.0f + __builtin_amdgcn_exp2f(gc * (-1.702f * LOG2E)))); } }
                u32x2 w; w.x = pk4_fp8_nc(o[0][0], o[0][1], o[0][2], o[0][3]); w.y = pk4_fp8_nc(o[1][0], o[1][1], o[1][2], o[1][3]); *(u32x2*)(ACT + (size_t)(row0 + ai * 128 + m * 16) * 1024 + f0) = w; }
    }
};

struct EpiDown {
    static constexpr bool PAIR_KEEP = false;
    const float* bd; unsigned char* YB;
    __device__ __forceinline__ void operator()(const f32x4 (&acc)[2][2][4][2], const Unit& u, int wr, int wc, int fr, int fq) const {
        const int row0 = u.pm * 256 + wr * 64 + fr, col0 = u.pn * 256 + wc * 64 + 16 * fq; const float* be = bd + (size_t)u.e * 1024;
        f32x4 bv[2][2];
#pragma unroll
        for (int bj = 0; bj < 2; ++bj)
#pragma unroll
            for (int n = 0; n < 2; ++n) bv[bj][n] = *(const f32x4*)(be + col0 + bj * 8 + 4 * n);
#pragma unroll
        for (int ai = 0; ai < 2; ++ai)
#pragma unroll
            for (int m = 0; m < 4; ++m) { u32x4 w;
                { const f32x4 v0 = acc[ai][0][m][0] + bv[0][0], v1 = acc[ai][0][m][1] + bv[0][1]; w.x = pk4_fp8(v0[0], v0[1], v0[2], v0[3]); w.y = pk4_fp8(v1[0], v1[1], v1[2], v1[3]); }
                { const f32x4 v0 = acc[ai][1][m][0] + bv[1][0], v1 = acc[ai][1][m][1] + bv[1][1]; w.z = pk4_fp8(v0[0], v0[1], v0[2], v0[3]); w.w = pk4_fp8(v1[0], v1[1], v1[2], v1[3]); }
                *(u32x4*)(YB + (size_t)(row0 + ai * 128 + m * 16) * 1024 + col0) = w; }
    }
};
}

namespace attn_body {
using bf16 = __hip_bfloat16;
constexpr int QP = 512;
constexpr int NW = 8, QBLK = 32, QB = QBLK * NW, KVBLK = 64;
constexpr float NEGV = -1.0e30f;
__device__ __forceinline__ int crow(int r, int hi) { return (r & 3) + 8 * (r >> 2) + 4 * hi; }
#define SBAR() __builtin_amdgcn_sched_barrier(0)
__device__ __forceinline__ void cmask(f32x16& p0, f32x16& p1, int jb, int qrel, int hi) {
    int d = qrel - (64 * jb + 4 * hi); asm volatile("" : "+v"(d));
#pragma unroll
    for (int r = 0; r < 16; ++r) { const int c = (r & 3) + 8 * (r >> 2); if (d < c) p0[r] = NEGV; if (d < c + 32) p1[r] = NEGV; }
}
__device__ __forceinline__ void wmask(f32x16& p0, f32x16& p1, int jb, int qrel, int hi) {
    int d = qrel - (64 * jb + 4 * hi); asm volatile("" : "+v"(d));
#pragma unroll
    for (int r = 0; r < 16; ++r) { const int c = (r & 3) + 8 * (r >> 2); if ((unsigned)(d - c) > 127u) p0[r] = NEGV; if ((unsigned)(d - c - 32) > 127u) p1[r] = NEGV; }
}
constexpr int NSLOT = 3, SLOTB = 8192;
constexpr int LDS_K = 0, LDS_V = NSLOT * SLOTB, LDS_WS = 2 * NSLOT * SLOTB, LDS_OST = LDS_WS + NW * 64 * 4, LDS_NCS = LDS_OST + NW * 4096, LDS_BYTES = LDS_NCS + SEQ * 4;
__device__ __forceinline__ void glds16(const void* gsrc, unsigned lds_dst) { unsigned keep;
    asm volatile("s_mov_b32 %0, m0\n\ts_mov_b32 m0, %2\n\ts_nop 0\n\tglobal_load_lds_dwordx4 %1, off\n\ts_mov_b32 m0, %0" : "=&s"(keep) : "v"(gsrc), "s"(lds_dst) : "memory"); }
#define WAIT_BAR(N) asm volatile("s_waitcnt vmcnt(" #N ") lgkmcnt(0)\n\ts_barrier" ::: "memory")
typedef LAS const char* lds_cptr;
typedef short v4i16_t __attribute__((ext_vector_type(4)));
__device__ __forceinline__ void kload8(bf16x8* kf, lds_cptr kp) {
    kf[0] = *(const LAS bf16x8*)(kp);        kf[1] = *(const LAS bf16x8*)(kp + 512);
    kf[2] = *(const LAS bf16x8*)(kp + 2048); kf[3] = *(const LAS bf16x8*)(kp + 2560);
    kf[4] = *(const LAS bf16x8*)(kp + 4096); kf[5] = *(const LAS bf16x8*)(kp + 4608);
    kf[6] = *(const LAS bf16x8*)(kp + 6144); kf[7] = *(const LAS bf16x8*)(kp + 6656);
}
__device__ __forceinline__ void kload2(bf16x8* kf, lds_cptr kp, int j) { kf[2 * j] = *(const LAS bf16x8*)(kp + j * 2048); kf[2 * j + 1] = *(const LAS bf16x8*)(kp + j * 2048 + 512); }
__device__ __forceinline__ s16x4 vtr(lds_cptr p) { return __builtin_bit_cast(s16x4, __builtin_amdgcn_ds_read_tr16_b64_v4i16((LAS v4i16_t*)p)); }
#define MX3(a, b, c) __builtin_fmaxf(__builtin_fmaxf((a), (b)), (c))
__device__ __forceinline__ float rowmax(const f32x16& p0, const f32x16& p1) {
    float a = MX3(p0[0], p0[1], p1[0]), b = MX3(p0[2], p0[3], p1[1]); a = MX3(a, p1[2], p1[3]);
#pragma unroll
    for (int r = 4; r < 16; r += 4) { a = MX3(a, p0[r], p0[r + 1]); b = MX3(b, p0[r + 2], p0[r + 3]); a = MX3(a, p1[r], p1[r + 1]); b = MX3(b, p1[r + 2], p1[r + 3]); }
    const float m = __builtin_fmaxf(a, b); auto rr = __builtin_amdgcn_permlane32_swap(__float_as_uint(m), __float_as_uint(m), false, false);
    return __builtin_fmaxf(__uint_as_float(rr[0]), __uint_as_float(rr[1]));
}
__device__ __forceinline__ void cinit_half(f32x16& c, float rowt, const LAS float* nc) {
#pragma unroll
    for (int g = 0; g < 4; ++g) { const f32x4 a = *(const LAS f32x4*)(nc + 8 * g);
#pragma unroll
        for (int j = 0; j < 4; ++j) c[4 * g + j] = rowt + a[j]; }
}
__device__ __forceinline__ void pv(f32x16* o, int vb, bf16x8 pa0, bf16x8 pa1, bf16x8 pa2, bf16x8 pa3) {
#pragma unroll
    for (int d0 = 0; d0 < 2; ++d0) { s16x4 lo[4], hi[4];
#pragma unroll
        for (int ks = 0; ks < 4; ++ks) {
            asm volatile("ds_read_b64_tr_b16 %0,%1 offset:%c2" : "=&v"(lo[ks]) : "v"(vb), "i"(d0 * 4096 + ks * 1024) : "memory");
            asm volatile("ds_read_b64_tr_b16 %0,%1 offset:%c2" : "=&v"(hi[ks]) : "v"(vb), "i"(d0 * 4096 + ks * 1024 + 512) : "memory"); }
        asm volatile("s_waitcnt lgkmcnt(0)" ::: "memory"); SBAR();
#define PK(k) (bf16x8){lo[k][0], lo[k][1], lo[k][2], lo[k][3], hi[k][0], hi[k][1], hi[k][2], hi[k][3]}
        o[d0] = __builtin_amdgcn_mfma_f32_32x32x16_bf16(pa0, PK(0), o[d0], 0, 0, 0);
        o[d0] = __builtin_amdgcn_mfma_f32_32x32x16_bf16(pa1, PK(1), o[d0], 0, 0, 0);
        o[d0] = __builtin_amdgcn_mfma_f32_32x32x16_bf16(pa2, PK(2), o[d0], 0, 0, 0);
        o[d0] = __builtin_amdgcn_mfma_f32_32x32x16_bf16(pa3, PK(3), o[d0], 0, 0, 0);
#undef PK
    }
}

struct NextU { const bf16* Kh; const bf16* Vh; const float* ncsg; int KP, t0, qb; };
__device__ __forceinline__ void prime_unit(const bf16* Kh, const bf16* Vh, const int KP, const int t0, const float* ncsg, const int qb, const unsigned lds0, const int lane, const int wid) {
    const bf16* ksrc = Kh + (long)(t0 * KVBLK + lane) * KP + wid * 8;
    const bf16* vsrc = Vh + (long)(t0 * KVBLK + 16 * (wid & 3) + (lane >> 2)) * KP + (wid >> 2) * 32 + (lane & 3) * 8;
    const unsigned kdst = lds0 + LDS_K + wid * 1024, vdst = lds0 + LDS_V + wid * 1024;
    glds16(ksrc, (unsigned)__builtin_amdgcn_readfirstlane(kdst)); glds16(vsrc, (unsigned)__builtin_amdgcn_readfirstlane(vdst)); glds16(ksrc + (long)KVBLK * KP, (unsigned)__builtin_amdgcn_readfirstlane(kdst + SLOTB));
    if (ncsg != nullptr) for (int i = (t0 >> 2) + wid; i <= qb; i += NW) glds16((const char*)ncsg + i * 1024 + lane * 16, (unsigned)__builtin_amdgcn_readfirstlane(lds0 + LDS_NCS + i * 1024));
}
struct P2Dec {
    const bf16 *KF, *VF, *KA, *VA; const float* NCS; const LAS int* ordl;
    static constexpr int QPOS = 2048 + 1536;
    __device__ __forceinline__ static int unit_of(int p) {
        if (p < 256) return p;
        if (p < 2048) { const int q = p - 256, g = q / 7, r = q - 7 * g; return (r == 0 || r == 2 || r == 4) ? 256 + 3 * g + (r >> 1) : -1; }
        const int q = p - 2048, pq = q / 3, pr = q - 3 * pq; return pr == 2 ? -1 : 1024 + 2 * pq + pr; }
    __device__ __forceinline__ static int chunk_of(int p) { if (p < 2048) { const int q = p - 256, g = q / 7, r = q - 7 * g; return 4 * g + (r == 6 ? 3 : (r >> 1)); } return 1024 + (p - 2048) / 3; }
    __device__ __forceinline__ NextU next(int p) const {
        NextU nx; nx.Kh = nullptr; nx.Vh = nullptr; nx.ncsg = nullptr; nx.KP = 0; nx.t0 = 0; nx.qb = 0;
        if (p >= QPOS) return nx;
        const int idx = unit_of(p);
        if (idx < 0) return nx;
        if (idx < 1024) { const int od = __builtin_amdgcn_readfirstlane(ordl[idx]), u = od & 0xffff, bh = u >> 5, b = bh >> 3, h = bh & 7;
            nx.Kh = KF + (size_t)b * SEQ * 512 + h * 64; nx.Vh = VF + (size_t)b * SEQ * 512 + h * 64; nx.ncsg = NCS + (size_t)bh * SEQ; nx.KP = 512; nx.t0 = od >> 16; nx.qb = u & 31; }
        else { const int u = idx - 1024, bk = u >> 7, qb = 127 - (u & 127), b = bk >> 1, kvh = bk & 1;
            nx.Kh = KA + (size_t)b * SEQ * 128 + kvh * 64; nx.Vh = VA + (size_t)b * SEQ * 128 + kvh * 64; nx.KP = 128; nx.t0 = qb < 2 ? 0 : qb - 2; nx.qb = qb; }
        return nx; }
};
template <int MODE, int THRL, bool TRK> __device__ __forceinline__ void attn_unit(int qb, int t0f, const bf16* Qh, const bf16* __restrict__ Kh, const bf16* __restrict__ Vh, bf16* Oh, const int KP, const float sinkl2, char* shm, const float* ncsg, const bool primed, const NextU nx1, const int pos1, const P2Dec& dec, volatile LAS int* qslot, const int qval, int& pos2, int& primed_pos) {
    const int tid = opaque_tid(), lane = tid & 63, r32 = lane & 31, hi = lane >> 5; const int wid = __builtin_amdgcn_readfirstlane(tid >> 6);
    const int q0 = MODE == 1 ? qb * 64 : qb * QB;
    const int t0 = (MODE == 1) ? (qb < 2 ? 0 : qb - 2) : t0f;
    const int NT = MODE == 1 ? 3 : (q0 + QB) / KVBLK - t0;
    const int wrow = MODE == 1 ? (wid & 1) * QBLK : wid * QBLK, wcol = MODE == 1 ? (wid >> 1) * 64 : 0;
    const int jdiag = MODE == 1 ? qb - t0 : NT - 4;
    const bf16* Qw = Qh + (long)(q0 + wrow) * QP + wcol;
    const unsigned lds0 = (unsigned)(uintptr_t)shm;
    float* wsf = (float*)(shm + LDS_WS) + wid * 64;
    const bf16* ksrc = Kh + (long)(t0 * KVBLK + lane) * KP + wid * 8;
    const bf16* vsrc = Vh + (long)(t0 * KVBLK + 16 * (wid & 3) + (lane >> 2)) * KP + (wid >> 2) * 32 + (lane & 3) * 8;
    const unsigned kdst = lds0 + LDS_K + wid * 1024, vdst = lds0 + LDS_V + wid * 1024;
    const long tstride = (long)KVBLK * KP;
#define DMA_K(t, slot) glds16(ksrc + (long)(t) * tstride, (unsigned)__builtin_amdgcn_readfirstlane(kdst + (slot)))
#define DMA_V(t, slot) glds16(vsrc + (long)(t) * tstride, (unsigned)__builtin_amdgcn_readfirstlane(vdst + (slot)))
    const int vb0 = (int)(lds0 + LDS_V) + ((lane >> 4) & 1) * 32 + (lane & 3) * 8 + (4 * hi + ((lane & 15) >> 2)) * 64;
    const char* Kbase = shm + LDS_K; bf16x8 kf[8];
    const lds_cptr shm3 = (lds_cptr)shm; const lds_cptr kp0 = shm3 + LDS_K + hi * 1024 + r32 * 16; const lds_cptr vp0 = shm3 + LDS_V + ((lane >> 4) & 1) * 32 + (lane & 3) * 8 + (4 * hi + ((lane & 15) >> 2)) * 64;
    const LAS float* ncs = (const LAS float*)(shm3 + LDS_NCS) + t0 * 64 + 4 * hi;
    if (!primed) prime_unit(Kh, Vh, KP, t0, MODE == 0 ? ncsg : nullptr, qb, lds0, lane, wid);
    bf16x8 qr[4]; float mhat;
    { bf16x8 kd[4];
#pragma unroll
      for (int d0 = 0; d0 < 4; ++d0) { qr[d0] = *reinterpret_cast<const bf16x8*>(&Qw[(long)r32 * QP + d0 * 16 + hi * 8]); kd[d0] = *reinterpret_cast<const bf16x8*>(&Kh[(long)(q0 + wrow + r32) * KP + d0 * 16 + hi * 8]); }
      float dg = 0.f;
#pragma unroll
      for (int d0 = 0; d0 < 4; ++d0)
#pragma unroll
          for (int j = 0; j < 8; ++j) dg += bf2f(qr[d0][j]) * bf2f(kd[d0][j]);
      auto rr = __builtin_amdgcn_permlane32_swap(__float_as_uint(dg), __float_as_uint(dg), false, false);
      mhat = __uint_as_float(rr[0]) + __uint_as_float(rr[1]); }
    float rowt = -mhat;
#define CI0(C, t) do { if constexpr (MODE == 0) { cinit_half(C, rowt, ncs + (t) * 64); } else { _Pragma("unroll") for (int r = 0; r < 16; ++r) C[r] = rowt; } } while (0)
#define CI1(C, t) do { if constexpr (MODE == 0) { cinit_half(C, rowt, ncs + (t) * 64 + 32); } else { _Pragma("unroll") for (int r = 0; r < 16; ++r) C[r] = rowt; } } while (0)
#define CSRC(C) (C)
#define NEWREF() do { rowt -= dl; } while (0)
    float l_reg = 0.f; f32x16 o[2]; o[0] = f32x16{}; o[1] = f32x16{};
    const int qrel = wrow + r32;
#define CMASK(P0, P1, t) do { const int jb_ = (t) - jdiag; if (MODE == 1) wmask(P0, P1, jb_, qrel, hi); else if (jb_ >= 0) cmask(P0, P1, jb_, qrel, hi); } while (0)
    bool resc = false;
#define RESC() do { if constexpr (TRK) if (resc) { asm volatile("s_waitcnt lgkmcnt(0)" ::: "memory"); \
      _Pragma("unroll") for (int d_ = 0; d_ < 2; ++d_) _Pragma("unroll") for (int r = 0; r < 16; ++r) o[d_][r] *= wsf[crow(r, hi)]; } } while (0)
    f32x16 pA0, pA1, pB0, pB1;
    int sl_prev = 0, sl_cur = 0, sl_next = SLOTB;
#define ROT() do { sl_prev = sl_cur; sl_cur = sl_next; sl_next = (sl_next == (NSLOT - 1) * SLOTB) ? 0 : sl_next + SLOTB; } while (0)
    DMA_K(2, 2 * SLOTB);
    WAIT_BAR(3);
    if constexpr (MODE == 0) rowt -= ((const LAS float*)(shm3 + LDS_NCS))[q0 + wid * QBLK + r32];
    CI0(pA0, 0); CI1(pA1, 0);
    { const char* kb = Kbase + hi * 1024 + r32 * 16;
#pragma unroll
      for (int d0 = 0; d0 < 4; ++d0) {
          const bf16x8 b0 = *reinterpret_cast<const bf16x8*>(kb + d0 * 2048);
          const bf16x8 b1 = *reinterpret_cast<const bf16x8*>(kb + d0 * 2048 + 512);
          if (d0 == 0) { pA0 = __builtin_amdgcn_mfma_f32_32x32x16_bf16(b0, qr[0], CSRC(pA0), 0, 0, 0); pA1 = __builtin_amdgcn_mfma_f32_32x32x16_bf16(b1, qr[0], CSRC(pA1), 0, 0, 0); }
          else { pA0 = __builtin_amdgcn_mfma_f32_32x32x16_bf16(b0, qr[d0], pA0, 0, 0, 0); pA1 = __builtin_amdgcn_mfma_f32_32x32x16_bf16(b1, qr[d0], pA1, 0, 0, 0); } } }
    CMASK(pA0, pA1, 0);
    if constexpr (TRK) { const float rm = rowmax(pA0, pA1);
      if (__builtin_expect(__any(rm > (float)THRL), 0)) { const float dl = __builtin_fmaxf(rm, 0.f); mhat += dl; NEWREF();
          _Pragma("unroll") for (int r = 0; r < 16; ++r) { pA0[r] -= dl; pA1[r] -= dl; } } }
    _Pragma("unroll") for (int r = 0; r < 16; ++r) pA0[r] = __builtin_amdgcn_exp2f(pA0[r]);
    _Pragma("unroll") for (int r = 0; r < 16; ++r) pA1[r] = __builtin_amdgcn_exp2f(pA1[r]);
    WAIT_BAR(0);
    if constexpr (MODE != 1) DMA_K(3, 0);
    DMA_V(1, SLOTB);
    ROT();
    kload8(kf, kp0 + sl_cur);
    WAIT_BAR(2);
    s16x4 vlo[8], vhi[8]; u32x4 pw0, pw1, pw2, pw3;
#define PKW(P, B) cvt_pk_bf16(P[B], P[B + 1])
#define PAF(k) __builtin_bit_cast(bf16x8, pw##k)
#define VFR(i) (bf16x8){vlo[i][0], vlo[i][1], vlo[i][2], vlo[i][3], vhi[i][0], vhi[i][1], vhi[i][2], vhi[i][3]}
#define PIN(x) asm volatile("" : "+v"(x))
#define GAPA(MF, A0, A1, A2, A3, W0, W1, PW) do { MF; sacc += A0; sacc += A1; sacc += A2; sacc += A3; PIN(sacc); W0; W1; PIN(PW); SBAR(); } while (0)
#define EX(v) __builtin_amdgcn_exp2f(v)
#define GAPB(MF, X, B) do { MF; X[B] = EX(X[B]); X[B + 1] = EX(X[B + 1]); X[B + 2] = EX(X[B + 2]); X[B + 3] = EX(X[B + 3]); PIN(X); SBAR(); } while (0)
#define VRD(i) do { vlo[i] = vtr(vp_ + (((i) >> 2) * 4096 + ((i) & 3) * 1024)); vhi[i] = vtr(vp_ + (((i) >> 2) * 4096 + ((i) & 3) * 1024 + 512)); } while (0)
#define KRD(G, j) do { if (G) { kload2(kf, kp0 + sl_next, j); SBAR(); } } while (0)
#define STEP(C0, C1, P0, P1, t, GK, GV, GL) do { SBAR(); \
    const lds_cptr vp_ = vp0 + sl_prev; \
    CI0(C0, t); VRD(0); SBAR(); float sacc = (P0[0] + P0[1]); \
    GAPA(C0 = __builtin_amdgcn_mfma_f32_32x32x16_bf16(kf[0], qr[0], CSRC(C0), 0, 0, 0), P0[2], P0[3], P0[4], P0[5],     pw0[0] = PKW(P0, 0), pw0[1] = PKW(P0, 2), pw0); \
    CI1(C1, t); VRD(4); SBAR(); GAPA(C1 = __builtin_amdgcn_mfma_f32_32x32x16_bf16(kf[1], qr[0], CSRC(C1), 0, 0, 0), P0[6], P0[7], P0[8], P0[9],     pw0[2] = PKW(P0, 4), pw0[3] = PKW(P0, 6), pw0); \
    VRD(1); SBAR(); GAPA(C0 = __builtin_amdgcn_mfma_f32_32x32x16_bf16(kf[2], qr[1], C0, 0, 0, 0),   P0[10], P0[11], P0[12], P0[13], pw1[0] = PKW(P0, 8), pw1[1] = PKW(P0, 10), pw1); \
    VRD(5); SBAR(); GAPA(C1 = __builtin_amdgcn_mfma_f32_32x32x16_bf16(kf[3], qr[1], C1, 0, 0, 0),   P0[14], P0[15], P1[0], P1[1],   pw1[2] = PKW(P0, 12), pw1[3] = PKW(P0, 14), pw1); \
    VRD(2); SBAR(); GAPA(C0 = __builtin_amdgcn_mfma_f32_32x32x16_bf16(kf[4], qr[2], C0, 0, 0, 0),   P1[2], P1[3], P1[4], P1[5],     pw2[0] = PKW(P1, 0), pw2[1] = PKW(P1, 2), pw2); \
    VRD(6); SBAR(); GAPA(C1 = __builtin_amdgcn_mfma_f32_32x32x16_bf16(kf[5], qr[2], C1, 0, 0, 0),   P1[6], P1[7], P1[8], P1[9],     pw2[2] = PKW(P1, 4), pw2[3] = PKW(P1, 6), pw2); \
    VRD(3); SBAR(); GAPA(C0 = __builtin_amdgcn_mfma_f32_32x32x16_bf16(kf[6], qr[3], C0, 0, 0, 0),   P1[10], P1[11], P1[12], P1[13], pw3[0] = PKW(P1, 8), pw3[1] = PKW(P1, 10), pw3); \
    VRD(7); SBAR(); GAPA(C1 = __builtin_amdgcn_mfma_f32_32x32x16_bf16(kf[7], qr[3], C1, 0, 0, 0),   P1[14], P1[15], 0.f, 0.f,       pw3[2] = PKW(P1, 12), pw3[3] = PKW(P1, 14), pw3); \
    l_reg += sacc; \
    if (GK) { DMA_K((t) + 3, sl_cur); } if (GV) { DMA_V((t) + 1, sl_next); } \
    CMASK(C0, C1, t); \
    if constexpr (TRK) { float a = MX3(C0[0], C0[1], C1[0]), b = MX3(C0[2], C0[3], C1[1]); a = MX3(a, C1[2], C1[3]); \
      _Pragma("unroll") for (int r = 4; r < 16; r += 4) { a = MX3(a, C0[r], C0[r + 1]); b = MX3(b, C0[r + 2], C0[r + 3]); a = MX3(a, C1[r], C1[r + 1]); b = MX3(b, C1[r + 2], C1[r + 3]); } \
      float rm = __builtin_fmaxf(a, b); { auto rr = __builtin_amdgcn_permlane32_swap(__float_as_uint(rm), __float_as_uint(rm), false, false); rm = __builtin_fmaxf(__uint_as_float(rr[0]), __uint_as_float(rr[1])); } \
      resc = false; \
      if (__builtin_expect(__any(rm > (float)THRL), 0)) { const float dl = __builtin_fmaxf(rm, 0.f); mhat += dl; NEWREF(); \
        _Pragma("unroll") for (int r = 0; r < 16; ++r) { C0[r] -= dl; C1[r] -= dl; } \
        const float f = __builtin_amdgcn_exp2f(-dl); l_reg *= f; if (hi == 0) wsf[r32] = f; resc = true; } } \
    SBAR(); \
    GAPB(o[0] = __builtin_amdgcn_mfma_f32_32x32x16_bf16(PAF(0), VFR(0), o[0], 0, 0, 0), C0, 0); \
    GAPB(o[1] = __builtin_amdgcn_mfma_f32_32x32x16_bf16(PAF(0), VFR(4), o[1], 0, 0, 0), C0, 4); \
    KRD(GL, 0); GAPB(o[0] = __builtin_amdgcn_mfma_f32_32x32x16_bf16(PAF(1), VFR(1), o[0], 0, 0, 0), C0, 8); \
    KRD(GL, 1); GAPB(o[1] = __builtin_amdgcn_mfma_f32_32x32x16_bf16(PAF(1), VFR(5), o[1], 0, 0, 0), C0, 12); \
    KRD(GL, 2); GAPB(o[0] = __builtin_amdgcn_mfma_f32_32x32x16_bf16(PAF(2), VFR(2), o[0], 0, 0, 0), C1, 0); \
    KRD(GL, 3); GAPB(o[1] = __builtin_amdgcn_mfma_f32_32x32x16_bf16(PAF(2), VFR(6), o[1], 0, 0, 0), C1, 4); \
    GAPB(o[0] = __builtin_amdgcn_mfma_f32_32x32x16_bf16(PAF(3), VFR(3), o[0], 0, 0, 0), C1, 8); \
    GAPB(o[1] = __builtin_amdgcn_mfma_f32_32x32x16_bf16(PAF(3), VFR(7), o[1], 0, 0, 0), C1, 12); \
    } while (0)
    int t = 1;
    if constexpr (MODE == 0) {
#undef CMASK
#define CMASK(P0, P1, t) do {} while (0)
        for (; t + 5 < NT; t += 2) {
            STEP(pB0, pB1, pA0, pA1, t, true, true, true);     WAIT_BAR(2); RESC(); ROT();
            STEP(pA0, pA1, pB0, pB1, t + 1, true, true, true); WAIT_BAR(2); RESC(); ROT();
        }
#undef CMASK
#define CMASK(P0, P1, t) do { const int jb_ = (t) - jdiag; if (MODE == 1) wmask(P0, P1, jb_, qrel, hi); else if (jb_ >= 0) cmask(P0, P1, jb_, qrel, hi); } while (0)
    }
#define ENDW(tt) do { if ((tt) + 3 < NT) { WAIT_BAR(2); } else if ((tt) + 2 < NT) { WAIT_BAR(1); } else { WAIT_BAR(0); } } while (0)
#define DRAIN(PX0, PX1) do { float sacc = PX0[0] + PX0[1]; _Pragma("unroll") for (int r = 2; r < 16; ++r) sacc += PX0[r]; _Pragma("unroll") for (int r = 0; r < 16; ++r) sacc += PX1[r]; l_reg += sacc; \
      pw0 = (u32x4){PKW(PX0, 0), PKW(PX0, 2), PKW(PX0, 4), PKW(PX0, 6)}; pw1 = (u32x4){PKW(PX0, 8), PKW(PX0, 10), PKW(PX0, 12), PKW(PX0, 14)}; pw2 = (u32x4){PKW(PX1, 0), PKW(PX1, 2), PKW(PX1, 4), PKW(PX1, 6)}; pw3 = (u32x4){PKW(PX1, 8), PKW(PX1, 10), PKW(PX1, 12), PKW(PX1, 14)}; \
      SBAR(); pv(o, vb0 + sl_cur, PAF(0), PAF(1), PAF(2), PAF(3)); } while (0)
    if constexpr (MODE == 1) {
        STEP(pB0, pB1, pA0, pA1, 1, false, true, true);   WAIT_BAR(0); RESC(); ROT();
        STEP(pA0, pA1, pB0, pB1, 2, false, false, false); RESC();
        DRAIN(pA0, pA1);
    } else {
        for (; t + 1 < NT; t += 2) {
            STEP(pB0, pB1, pA0, pA1, t, (t + 3 < NT), (t + 1 < NT), (t + 1 < NT));     ENDW(t);     RESC(); ROT();
            STEP(pA0, pA1, pB0, pB1, t + 1, (t + 4 < NT), (t + 2 < NT), (t + 2 < NT)); ENDW(t + 1); RESC(); ROT();
        }
        STEP(pB0, pB1, pA0, pA1, NT - 1, false, false, false); RESC();
        DRAIN(pB0, pB1);
    }
#undef DRAIN
    if (tid == 0) qslot[0] = qval;
    asm volatile("s_waitcnt lgkmcnt(0)\n\ts_barrier" ::: "memory");
    pos2 = __builtin_amdgcn_readfirstlane(qslot[0]);
    { NextU nx = nx1; int target = pos1;
      if (nx.Kh == nullptr) { nx = dec.next(pos2); target = pos2; }
      primed_pos = -1;
      if (nx.Kh != nullptr) { prime_unit(nx.Kh, nx.Vh, nx.KP, nx.t0, nx.ncsg, nx.qb, lds0, lane, wid); primed_pos = target; } }
#undef PKW
#undef PAF
#undef VFR
#undef PIN
#undef GAPA
#undef GAPB
#undef EX
#undef VRD
#undef KRD
#undef STEP
#undef ENDW
    { auto rr = __builtin_amdgcn_permlane32_swap(__float_as_uint(l_reg), __float_as_uint(l_reg), false, false); l_reg = __uint_as_float(rr[0]) + __uint_as_float(rr[1]); }
    if constexpr (MODE == 1) l_reg += __builtin_amdgcn_exp2f(sinkl2 - mhat);
    if (hi == 0) wsf[32 + r32] = l_reg; asm volatile("s_waitcnt lgkmcnt(0)" ::: "memory");
    float rli[16];
#pragma unroll
    for (int r = 0; r < 16; ++r) rli[r] = __builtin_amdgcn_rcpf(wsf[32 + crow(r, hi)]);
    if constexpr (P3A_FP8 != 0) {
        unsigned char* Ow8 = (unsigned char*)Oh + (long)(q0 + wrow) * 512 + wcol;
        unsigned char* stg8 = (unsigned char*)(shm + LDS_OST) + wid * 4096;
#pragma unroll
        for (int r = 0; r < 16; ++r) { const int orow = crow(r, hi); const float sc = rli[r] * 32.0f;
#pragma unroll
            for (int d0 = 0; d0 < 2; ++d0) stg8[orow * 64 + d0 * 32 + r32] = (unsigned char)(__builtin_amdgcn_cvt_pk_fp8_f32(clamp448(o[d0][r] * sc), 0.f, 0, false) & 0xff); }
        asm volatile("s_waitcnt lgkmcnt(0)" ::: "memory");
#pragma unroll
        for (int i = 0; i < 2; ++i) { const int row = i * 16 + (lane >> 2), ch = lane & 3; const u32x4 v = *(const u32x4*)(stg8 + row * 64 + ch * 16); *(u32x4*)(Ow8 + (long)row * 512 + ch * 16) = v; }
    } else {
    bf16* Ow = Oh + (long)(q0 + wrow) * QP + wcol;
    { bf16* stg = (bf16*)(shm + LDS_OST) + wid * 2048;
#pragma unroll
      for (int r = 0; r < 16; ++r) { const int orow = crow(r, hi);
#pragma unroll
          for (int d0 = 0; d0 < 2; ++d0) stg[orow * 64 + d0 * 32 + r32] = __float2bfloat16(o[d0][r] * rli[r]); }
      asm volatile("s_waitcnt lgkmcnt(0)" ::: "memory");
#pragma unroll
      for (int i = 0; i < 4; ++i) { const int row = i * 8 + (lane >> 3), ch = lane & 7; const u32x4 v = *(const u32x4*)(stg + row * 64 + ch * 8); *(u32x4*)(Ow + (long)row * QP + ch * 8) = v; } }
    }
    asm volatile("s_waitcnt lgkmcnt(0)" ::: "memory");
#undef DMA_K
#undef DMA_V
#undef CMASK
#undef RESC
#undef ROT
#undef CI0
#undef CI1
#undef CSRC
#undef NEWREF
}
#undef SBAR
#undef WAIT_BAR
#undef MX3
}

constexpr int NWAVES = 8;
constexpr int N_PHASES = 9;
constexpr size_t MiB = 1u << 20;
constexpr size_t WS_CTL = 0, CTL_ZERO_BYTES = 64 * 1024;
constexpr size_t WS_LOGF = 2 * MiB;
constexpr size_t WS_NCS = 3 * MiB;
constexpr size_t WS_TOKE = 4 * MiB, WS_TOKR = 4 * MiB + 512 * 1024, WS_TOKG = 5 * MiB;
constexpr size_t WS_TS = 6 * MiB, WS_ORDER = 6 * MiB + 64 * 1024;
constexpr size_t WS_ROWTOK = 8 * MiB;
constexpr size_t WS_WOA = 16 * MiB, WS_WOB = 17 * MiB, WS_WOUT = 18 * MiB, WS_WIN = 20 * MiB;
constexpr size_t WS_WIN8 = 29 * MiB;
constexpr size_t WS_XN8 = 560 * MiB;
constexpr size_t WS_WGU = 32 * MiB, WS_WD = 160 * MiB;
constexpr size_t WS_XN = 224 * MiB;
constexpr size_t WS_QA = 288 * MiB, WS_KA = 320 * MiB, WS_VA = 328 * MiB, WS_QF = 336 * MiB, WS_KF = 368 * MiB, WS_VF = 400 * MiB;
constexpr size_t WS_GT = 432 * MiB, WS_MG = 560 * MiB, WS_OA = 624 * MiB, WS_OB = 656 * MiB;
constexpr size_t WS_ACT = 288 * MiB;
constexpr size_t WS_YB = 560 * MiB;
constexpr size_t WS_X1 = 832 * MiB;
constexpr size_t WS_WOA8 = 12 * MiB, WS_WOB8 = 13 * MiB;
constexpr size_t WS_RMS = 6 * MiB + 256 * 1024;
constexpr size_t WS_WOUT8 = 7 * MiB;
constexpr size_t WS_MG8 = 688 * MiB;
constexpr size_t WS_END = 896 * MiB;
constexpr int CW_CNT = 64;
constexpr int CW_DONE = 128, CW_QCTR = 192;
constexpr int CW_BAR = 1024;
constexpr int MISC_BAR = 8192;
constexpr int RING_BYTES = 131072, MISC_OFF = RING_BYTES, LDS_BYTES = 163840;
constexpr int MISC_TOKL = 12544, TOKL_UNITS = 19;

struct Args { const void* in[21]; float* out; unsigned char* ws; int ph_lo, ph_hi; };

struct Frame { LAS unsigned char* lds; int tid, lane, wave, vcu, G; };

__device__ __forceinline__ float wave_sum(float v) {
#pragma unroll
    for (int o = 1; o < 64; o <<= 1) v += __shfl_xor(v, o);
    return v;
}

__device__ __forceinline__ int rowmap_in(int c) {
    int T, wc, d;
    if (c < 512) { const int hh = c >> 6; T = hh >> 2; wc = hh & 3; d = c & 63; }
    else if (c < 640) { T = 2; wc = (c - 512) >> 6; d = c & 63; }
    else if (c < 768) { T = 2; wc = 2 + ((c - 640) >> 6); d = c & 63; }
    else if (c < COL_FL) { const int cc = c - 768, sect = cc >> 9, hh = (cc & 511) >> 6; T = 3 + 2 * sect + (hh >> 2); wc = hh & 3; d = cc & 63; }
    else if (c < COL_GL) return -1;
    else { const int g = c - COL_GL, gc = g & 255; return 256 * (9 + (g >> 8)) + 128 * ((gc >> 3) & 1) + 32 * ((gc >> 6) & 3) + 16 * ((gc >> 2) & 1) + 4 * ((gc >> 4) & 3) + (gc & 3); }
    return 256 * T + 128 * (d >> 5) + 32 * wc + perm32s(d & 31);
}
__device__ __forceinline__ int rowmap_in16(int c) { const int r = rowmap_in(c); return (!P1_FP8 || r < 7 * 256) ? r : -1; }
__device__ __forceinline__ int rowmap_in8(int c) { const int r = rowmap_in(c); return r >= 7 * 256 ? r - 7 * 256 : -1; }
__device__ __forceinline__ int rowmap_perm(int c) { return (c & ~31) + perm32s(c & 31); }
__device__ __forceinline__ int rowmap_d16(int c) { return (c & ~255) + 128 * ((c >> 3) & 1) + 32 * ((c >> 6) & 3) + 16 * ((c >> 2) & 1) + 4 * ((c >> 4) & 3) + (c & 3); }
__device__ __forceinline__ int rowmap_gu(int c) { const int bj = c >> 10, f = c & 1023; return 256 * (f >> 7) + 128 * bj + 32 * ((f >> 5) & 3) + perm32s(f & 31); }
template <int MAP> __device__ __forceinline__ void transpose_item(const float* W, int K, int N, bf16_t* WT, int kb, int nb, int lane) {
    const int k0 = 64 * kb + 8 * (lane >> 3), n0 = 32 * nb + 4 * (lane & 7);
    if (n0 >= N) return;
    f32x4 v[8];
#pragma unroll
    for (int kk = 0; kk < 8; ++kk) v[kk] = *(const f32x4*)(W + (size_t)(k0 + kk) * N + n0);
#pragma unroll
    for (int j = 0; j < 4; ++j) { const int c = n0 + j; const int row = MAP == 0 ? rowmap_in16(c) : MAP == 1 ? rowmap_perm(c) : MAP == 2 ? c : rowmap_gu(c);
        if (row >= 0) { u32x4 o; o.x = cvt_pk_bf16(v[0][j], v[1][j]); o.y = cvt_pk_bf16(v[2][j], v[3][j]); o.z = cvt_pk_bf16(v[4][j], v[5][j]); o.w = cvt_pk_bf16(v[6][j], v[7][j]);
            *(u32x4*)(WT + (size_t)row * K + k0) = o; } }
}

template <int MAP> __device__ __forceinline__ bool f8_item_load(const float* W, int K, int N, int kb, int nb, int lane, f32x4 (&v)[16]) {
    const int k0 = 128 * kb + 16 * (lane >> 3), n0 = 32 * nb + 4 * (lane & 7);
    if (n0 >= N) return false;
    if (MAP == 0 && rowmap_in8(n0) < 0) return false;
#pragma unroll
    for (int kk = 0; kk < 16; ++kk) v[kk] = __builtin_nontemporal_load((const f32x4*)(W + (size_t)(k0 + kk) * N + n0));
    return true;
}
template <int MAP> __device__ __forceinline__ void f8_item_store(int K, unsigned char* WT, int kb, int nb, int lane, const f32x4 (&v)[16]) {
    const int k0 = 128 * kb + 16 * (lane >> 3), n0 = 32 * nb + 4 * (lane & 7);
#pragma unroll
    for (int j = 0; j < 4; ++j) { const int c = n0 + j; const int row = MAP == 0 ? rowmap_in8(c) : MAP == 1 ? rowmap_perm(c) : MAP == 4 ? rowmap_d16(c) : rowmap_gu(c);
        u32x4 o; o.x = pk4_fp8(v[0][j] * W8_SCALE, v[1][j] * W8_SCALE, v[2][j] * W8_SCALE, v[3][j] * W8_SCALE); o.y = pk4_fp8(v[4][j] * W8_SCALE, v[5][j] * W8_SCALE, v[6][j] * W8_SCALE, v[7][j] * W8_SCALE);
        o.z = pk4_fp8(v[8][j] * W8_SCALE, v[9][j] * W8_SCALE, v[10][j] * W8_SCALE, v[11][j] * W8_SCALE); o.w = pk4_fp8(v[12][j] * W8_SCALE, v[13][j] * W8_SCALE, v[14][j] * W8_SCALE, v[15][j] * W8_SCALE);
        *(u32x4*)(WT + (size_t)row * K + k0) = o; }
}
template <int MAP> __device__ __forceinline__ void transpose_item_f8(const float* W, int K, int N, unsigned char* WT, int kb, int nb, int lane) {
    f32x4 v[16]; if (f8_item_load<MAP>(W, K, N, kb, nb, lane, v)) f8_item_store<MAP>(K, WT, kb, nb, lane, v);
}

constexpr int MOE_ITEMS = N_EXP * (8 * 64 + 8 * 32);
__device__ __forceinline__ void moe_item_decode(const Args& a, int r, const float*& W, unsigned char*& WT, int& N, int& kb, int& nb, bool& gu) {
    unsigned char* ws = a.ws; constexpr int I_GU = 8 * 64, I_D = 8 * 32;
    if (r < N_EXP * I_GU) { const int e = r / I_GU, q = r % I_GU; W = (const float*)a.in[17] + (size_t)e * 1024 * 2048; WT = ws + WS_WGU + (size_t)e * 2048 * 1024; N = 2048; kb = q / 64; nb = q % 64; gu = true; }
    else { r -= N_EXP * I_GU; const int e = r / I_D, q = r % I_D; W = (const float*)a.in[19] + (size_t)e * 1024 * 1024; WT = ws + WS_WD + (size_t)e * 1024 * 1024; N = 1024; kb = q / 32; nb = q % 32; gu = false; }
}
__device__ __forceinline__ void moe_weight_item2(const Args& a, int r0, int r1, int lane, volatile LAS int* qslot = nullptr, int qval = 0, bool qwrite = false) {
    const float *W0, *W1; unsigned char *T0, *T1; int N0, N1, kb0, kb1, nb0, nb1; bool g0, g1;
    moe_item_decode(a, r0, W0, T0, N0, kb0, nb0, g0); moe_item_decode(a, r1, W1, T1, N1, kb1, nb1, g1);
    f32x4 v0[16], v1[16];
    (void)f8_item_load<3>(W0, 1024, N0, kb0, nb0, lane, v0); (void)f8_item_load<3>(W1, 1024, N1, kb1, nb1, lane, v1);
    asm volatile("" ::: "memory");
    if (qwrite) qslot[0] = qval;
    if (g0) f8_item_store<3>(1024, T0, kb0, nb0, lane, v0); else f8_item_store<4>(1024, T0, kb0, nb0, lane, v0);
    if (g1) f8_item_store<3>(1024, T1, kb1, nb1, lane, v1); else f8_item_store<4>(1024, T1, kb1, nb1, lane, v1);
}

__device__ __forceinline__ void p0_prologue(const Frame& F, const Args& a) {
    unsigned char* ws = a.ws;
    const float* x = (const float*)a.in[0]; const float* g1 = (const float*)a.in[2]; const float* w_in = (const float*)a.in[3]; const float* b_forget = (const float*)a.in[4];
    const int gw = F.vcu * NWAVES + F.wave, NGW = F.G * NWAVES;
    constexpr int I_IN = 16 * 137, I_IN8 = 8 * 137, I_OA = 8 * 32, I_OUT = 16 * 32, I_GU = 8 * 64, I_D = 8 * 32;
    constexpr int NITEMS = I_IN + I_IN8 + 2 * I_OA + I_OUT;
    for (int it = gw; it < NITEMS; it += NGW) {
        int r = it;
        if (r < I_IN) { transpose_item<0>(w_in, 1024, IN_W, (bf16_t*)(ws + WS_WIN), r / 137, r % 137, F.lane); continue; } r -= I_IN;
        if (r < I_IN8) { if (P1_FP8) transpose_item_f8<0>(w_in, 1024, IN_W, ws + WS_WIN8, r / 137, r % 137, F.lane); continue; } r -= I_IN8;
        if (r < I_OA) { if (P3A_FP8) { if (r < 4 * 32) transpose_item_f8<1>((const float*)a.in[11], 512, 1024, ws + WS_WOA8, r / 32, r % 32, F.lane); }
                        else transpose_item<1>((const float*)a.in[11], 512, 1024, (bf16_t*)(ws + WS_WOA), r / 32, r % 32, F.lane); continue; } r -= I_OA;
        if (r < I_OA) { if (P3A_FP8) { if (r < 4 * 32) transpose_item_f8<1>((const float*)a.in[12], 512, 1024, ws + WS_WOB8, r / 32, r % 32, F.lane); }
                        else transpose_item<1>((const float*)a.in[12], 512, 1024, (bf16_t*)(ws + WS_WOB), r / 32, r % 32, F.lane); continue; } r -= I_OA;
        if (P3B_FP8) { if (r < 8 * 32) transpose_item_f8<1>((const float*)a.in[13], 1024, 1024, ws + WS_WOUT8, r / 32, r % 32, F.lane); }
        else transpose_item<1>((const float*)a.in[13], 1024, 1024, (bf16_t*)(ws + WS_WOUT), r / 32, r % 32, F.lane);
    }
    LAS float* wfl = (LAS float*)F.lds;
    for (int c = F.tid; c < 1024; c += NWAVES * 64) { const f32x4 u0 = *(const f32x4*)(w_in + (size_t)c * IN_W + COL_FL), u1 = *(const f32x4*)(w_in + (size_t)c * IN_W + COL_FL + 4);
        *(LAS f32x4*)(wfl + c * 8) = u0; *(LAS f32x4*)(wfl + c * 8 + 4) = u1; }
    __syncthreads();
    f32x4 wf[16][2], gv[4];
#pragma unroll
    for (int j = 0; j < 4; ++j) { gv[j] = *(const f32x4*)(g1 + 256 * j + 4 * F.lane);
#pragma unroll
        for (int i = 0; i < 4; ++i) { const int c = 256 * j + 4 * F.lane + i; wf[4 * j + i][0] = *(const LAS f32x4*)(wfl + c * 8); wf[4 * j + i][1] = *(const LAS f32x4*)(wfl + c * 8 + 4); } }
    float bfv = 0.f; if (F.lane < 8) bfv = b_forget[F.lane];
    bf16_t* XN = (bf16_t*)(ws + WS_XN); unsigned char* XN8 = ws + WS_XN8; float* LOGF = (float*)(ws + WS_LOGF);
    f32x4 nv[4];
    if (gw < NTOK) {
#pragma unroll
        for (int j = 0; j < 4; ++j) nv[j] = ((const f32x4*)(x + (size_t)gw * 1024) + F.lane)[64 * j]; }
    for (int m = gw; m < NTOK; m += NGW) {
        f32x4 v[4]; float s = 0.f;
#pragma unroll
        for (int j = 0; j < 4; ++j) v[j] = nv[j];
        if (m + NGW < NTOK) {
#pragma unroll
            for (int j = 0; j < 4; ++j) nv[j] = ((const f32x4*)(x + (size_t)(m + NGW) * 1024) + F.lane)[64 * j]; }
#pragma unroll
        for (int j = 0; j < 4; ++j) { s += (v[j][0] * v[j][0] + v[j][1] * v[j][1]) + (v[j][2] * v[j][2] + v[j][3] * v[j][3]); }
        const float rstd = rsqrtf(wave_sum(s) * (1.0f / 1024.0f) + EPS);
        if (XREC && F.lane == 0) ((float*)(ws + WS_RMS))[m] = __builtin_amdgcn_rcpf(rstd);
        float fl[8];
#pragma unroll
        for (int h = 0; h < 8; ++h) fl[h] = 0.f;
        u32x2* o8 = (u32x2*)(XN + (size_t)m * 1024) + F.lane;
#pragma unroll
        for (int j = 0; j < 4; ++j) { v[j] = v[j] * rstd * gv[j];
            u32x2 w; w.x = cvt_pk_bf16(v[j][0], v[j][1]); w.y = cvt_pk_bf16(v[j][2], v[j][3]); o8[64 * j] = w;
            if (P1_FP8) ((unsigned*)(XN8 + (size_t)m * 1024))[64 * j + F.lane] = pk4_fp8(v[j][0], v[j][1], v[j][2], v[j][3]);
#pragma unroll
            for (int i = 0; i < 4; ++i) {
#pragma unroll
                for (int h = 0; h < 4; ++h) { fl[h] += v[j][i] * wf[4 * j + i][0][h]; fl[4 + h] += v[j][i] * wf[4 * j + i][1][h]; } } }
        float mine = 0.f;
#pragma unroll
        for (int h = 0; h < 8; ++h) { const float t = wave_sum(fl[h]); if (F.lane == h) mine = t; }
        if (F.lane < 8) { const float z = mine + bfv; LOGF[(size_t)m * 8 + F.lane] = fminf(z, 0.f) - log1pf(__expf(-fabsf(z))); }
    }
}

__device__ __forceinline__ void p1_cumsum(const Frame& F, const Args& a, int bh) {
    const float* LOGF = (const float*)(a.ws + WS_LOGF); float* NCS = (float*)(a.ws + WS_NCS);
    const int b = bh >> 3, h = bh & 7; LAS double* wtot = (LAS double*)F.lds; LAS float* ncl = (LAS float*)(F.lds + 1024); LAS float* smx = (LAS float*)(F.lds + 512);
    double v[16]; double run = 0.0;
#pragma unroll
    for (int j = 0; j < 16; ++j) { run += (double)LOGF[((size_t)b * SEQ + 16 * F.tid + j) * 8 + h]; v[j] = run; }
    double incl = run;
#pragma unroll
    for (int o = 1; o < 64; o <<= 1) { const double t = __shfl_up(incl, o); if (F.lane >= o) incl += t; }
    if (F.lane == 63) wtot[F.wave] = incl;
    if (F.wave == 0) {
        float mq = fabsf(((const float*)a.in[9])[F.lane]), mk = fabsf(((const float*)a.in[10])[F.lane]);
#pragma unroll
        for (int o = 1; o < 64; o <<= 1) { mq = fmaxf(mq, __shfl_xor(mq, o)); mk = fmaxf(mk, __shfl_xor(mk, o)); }
        if (F.lane == 0) smx[0] = 64.0f * C2 * mq * mk;
    }
    __syncthreads();
    double base = incl - run;
    for (int w = 0; w < F.wave; ++w) base += wtot[w];
    float* dst = NCS + (size_t)bh * SEQ + 16 * F.tid;
#pragma unroll
    for (int j = 0; j < 4; ++j) { f32x4 o;
#pragma unroll
        for (int i = 0; i < 4; ++i) o[i] = (float)(-(base + v[4 * j + i]) * 1.4426950408889634);
        *(f32x4*)(dst + 4 * j) = o; *(LAS f32x4*)(ncl + 16 * F.tid + 4 * j) = o; }
    __syncthreads();
    LAS float* tms = (LAS float*)(F.lds + 1024 + 32768); LAS float* FQ = tms + 128; LAS float* tops = FQ + 132;
    { const int tile = F.tid >> 2; const float top = ncl[64 * tile + 63]; float pm = 0.f;
#pragma unroll
      for (int i = 0; i < 4; ++i) { const f32x4 n4 = *(const LAS f32x4*)(ncl + 16 * F.tid + 4 * i);
          pm += (__builtin_amdgcn_exp2f(n4[0] - top) + __builtin_amdgcn_exp2f(n4[1] - top)) + (__builtin_amdgcn_exp2f(n4[2] - top) + __builtin_amdgcn_exp2f(n4[3] - top)); }
      pm += __shfl_xor(pm, 1); pm += __shfl_xor(pm, 2);
      if ((F.tid & 3) == 0) { tms[tile] = pm; tops[tile] = top; } }
    __syncthreads();
    if (F.tid <= 128) { const int j = F.tid; float fq = -INFINITY;
        if (j >= 1) { const float top = tops[j - 1]; float q = 0.f; const int i0 = j > 16 ? j - 16 : 0;
            for (int i = i0; i < j; ++i) q += tms[i] * __builtin_amdgcn_exp2f(tops[i] - top);
            if (i0 > 0) q += 64.0f * (float)i0 * __builtin_amdgcn_exp2f(tops[i0 - 1] - top);
            fq = __builtin_amdgcn_logf(q) + top; }
        FQ[j] = fq; }
    __syncthreads();
    int* TS = (int*)(a.ws + WS_TS);
    if (F.tid < 32) { const int qb = F.tid; const float thr = ncl[256 * qb] - (27.05f + 2.1f * smx[0]); int lo_ = 0, hi_ = 4 * qb;
        while (lo_ < hi_) { const int mid = (lo_ + hi_ + 1) >> 1; if (FQ[mid] < thr) lo_ = mid; else hi_ = mid - 1; }
        TS[bh * 32 + qb] = lo_ & ~1; }
    __threadfence();
    __syncthreads();
    LAS int* flag = (LAS int*)(F.lds + 768);
    if (F.tid == 0) flag[0] = (int)__hip_atomic_fetch_add((unsigned*)(a.ws + WS_CTL) + CW_DONE, 1u, __ATOMIC_RELAXED, __HIP_MEMORY_SCOPE_AGENT);
    __syncthreads();
    if (flag[0] == 31) {
        __threadfence();
        LAS int* hist = (LAS int*)(F.lds + 2048); LAS int* cst = hist + 80;
        if (F.tid < 160) hist[F.tid] = 0;
        __syncthreads();
        int c[2];
#pragma unroll
        for (int k = 0; k < 2; ++k) { const int u = F.tid + 512 * k; const int t0 = (int)__hip_atomic_load((unsigned*)TS + u, __ATOMIC_RELAXED, __HIP_MEMORY_SCOPE_AGENT); c[k] = (4 * (u & 31) + 4 - t0) >> 1; atomicAdd((int*)(hist + c[k]), 1); }
        __syncthreads();
        if (F.tid == 0) { int s0 = 0; for (int cc = 79; cc >= 0; --cc) { cst[cc] = s0; s0 += hist[cc]; } }
        __syncthreads();
        int* ORD = (int*)(a.ws + WS_ORDER);
#pragma unroll
        for (int k = 0; k < 2; ++k) { const int u = F.tid + 512 * k; const int p = atomicAdd((int*)(cst + c[k]), 1); ORD[p] = u | ((4 * (u & 31) + 4 - 2 * c[k]) << 16); }
    }
    __syncthreads();
}

__device__ __forceinline__ void p2_attention(const Frame& F, const Args& a, char* lds) {
    using attn_body::bf16;
    unsigned char* ws = a.ws; const float* sinks = (const float*)a.in[8];
    const bf16* QA = (const bf16*)(ws + WS_QA); const bf16* KA = (const bf16*)(ws + WS_KA); const bf16* VA = (const bf16*)(ws + WS_VA);
    const bf16* QF = (const bf16*)(ws + WS_QF); const bf16* KF = (const bf16*)(ws + WS_KF); const bf16* VF = (const bf16*)(ws + WS_VF);
    bf16* OA = (bf16*)(ws + WS_OA); bf16* OB = (bf16*)(ws + WS_OB);
    const float* NCS = (const float*)(ws + WS_NCS);
    constexpr int OES = P3A_FP8 ? 2 : 1;
    const int* TS = (const int*)(ws + WS_TS); const int* ORD = (const int*)(ws + WS_ORDER); unsigned* qctr = (unsigned*)(ws + WS_CTL) + CW_QCTR;
    volatile LAS int* qi = (volatile LAS int*)(F.lds + MISC_OFF + 12288);
    bool fixedref;
    { float fq_ = fabsf(((const float*)a.in[9])[F.lane]), fk_ = fabsf(((const float*)a.in[10])[F.lane]), sq_ = fabsf(((const float*)a.in[6])[F.lane]), sk_ = fabsf(((const float*)a.in[7])[F.lane]), sn_ = fabsf(sinks[F.lane & 7]);
#pragma unroll
      for (int o = 1; o < 64; o <<= 1) { fq_ = fmaxf(fq_, __shfl_xor(fq_, o)); fk_ = fmaxf(fk_, __shfl_xor(fk_, o)); sq_ = fmaxf(sq_, __shfl_xor(sq_, o)); sk_ = fmaxf(sk_, __shfl_xor(sk_, o)); sn_ = fmaxf(sn_, __shfl_xor(sn_, o)); }
      const float bound = 2.1f * 64.0f * C2 * fmaxf(fq_ * fk_, sq_ * sk_);
      fixedref = __builtin_amdgcn_readfirstlane((int)((bound <= 60.0f) && (sn_ * LOG2E + bound <= 60.0f))) != 0; }
    LAS int* ordl = (LAS int*)(F.lds + 118784);
    for (int i = F.tid; i < 1024; i += NWAVES * 64) ordl[i] = ORD[i];
    __syncthreads();
    if (F.tid == 0) { qi[0] = (int)__hip_atomic_fetch_add(qctr, 1u, __ATOMIC_RELAXED, __HIP_MEMORY_SCOPE_AGENT); qi[1] = (int)__hip_atomic_fetch_add(qctr, 1u, __ATOMIC_RELAXED, __HIP_MEMORY_SCOPE_AGENT); }
    __syncthreads();
    int pos = __builtin_amdgcn_readfirstlane(qi[0]), pos1 = __builtin_amdgcn_readfirstlane(qi[1]);
    __syncthreads();
    using attn_body::P2Dec;
    static_assert(MOE_ITEMS == 1536 * 16, "chunking of the expert weight items");
    P2Dec dec; dec.KF = KF; dec.VF = VF; dec.KA = KA; dec.VA = VA; dec.NCS = NCS; dec.ordl = ordl;
    int primed_pos = -1, it = 0;
    while (pos < P2Dec::QPOS) {
        int nxt = 0;
        if (F.tid == 0) nxt = (int)__hip_atomic_fetch_add(qctr, 1u, __ATOMIC_RELAXED, __HIP_MEMORY_SCOPE_AGENT);
        volatile LAS int* slot = qi + (it & 1);
        int pos2;
        const int idx = P2Dec::unit_of(pos);
        if (idx < 0) {
            const int chunk = P2Dec::chunk_of(pos);
            moe_weight_item2(a, chunk * 16 + F.wave, chunk * 16 + 8 + F.wave, F.lane, slot, nxt, F.tid == 0);
            __syncthreads();
            pos2 = __builtin_amdgcn_readfirstlane(slot[0]);
        } else {
            const attn_body::NextU nx1 = dec.next(pos1); const bool primed = primed_pos == pos;
            if (idx < 1024) {
                const int od = __builtin_amdgcn_readfirstlane(ordl[idx]), u = od & 0xffff, t0 = od >> 16, bh = u >> 5, qb = u & 31, b = bh >> 3, h = bh & 7;
                if (fixedref) attn_body::attn_unit<0, 8, false>(qb, t0, QF + (size_t)b * SEQ * 512 + h * 64, KF + (size_t)b * SEQ * 512 + h * 64, VF + (size_t)b * SEQ * 512 + h * 64, OB + ((size_t)b * SEQ * 512 + h * 64) / OES, 512, 0.f, lds, NCS + (size_t)bh * SEQ, primed, nx1, pos1, dec, slot, nxt, pos2, primed_pos);
                else attn_body::attn_unit<0, 8, true>(qb, t0, QF + (size_t)b * SEQ * 512 + h * 64, KF + (size_t)b * SEQ * 512 + h * 64, VF + (size_t)b * SEQ * 512 + h * 64, OB + ((size_t)b * SEQ * 512 + h * 64) / OES, 512, 0.f, lds, NCS + (size_t)bh * SEQ, primed, nx1, pos1, dec, slot, nxt, pos2, primed_pos);
            } else {
                const int u = idx - 1024, bk = u >> 7, qb = 127 - (u & 127), b = bk >> 1, kvh = bk & 1; const float snk = sinks[kvh * 4 + (F.wave >> 1)] * LOG2E;
                if (fixedref) attn_body::attn_unit<1, 8, false>(qb, 0, QA + (size_t)b * SEQ * 512 + kvh * 256, KA + (size_t)b * SEQ * 128 + kvh * 64, VA + (size_t)b * SEQ * 128 + kvh * 64, OA + ((size_t)b * SEQ * 512 + kvh * 256) / OES, 128, snk, lds, nullptr, primed, nx1, pos1, dec, slot, nxt, pos2, primed_pos);
                else attn_body::attn_unit<1, 8, true>(qb, 0, QA + (size_t)b * SEQ * 512 + kvh * 256, KA + (size_t)b * SEQ * 128 + kvh * 64, VA + (size_t)b * SEQ * 128 + kvh * 64, OA + ((size_t)b * SEQ * 512 + kvh * 256) / OES, 128, snk, lds, nullptr, primed, nx1, pos1, dec, slot, nxt, pos2, primed_pos);
            }
        }
        pos = pos1; pos1 = pos2; ++it;
    }
    __syncthreads();
}

template <int NC> __device__ __forceinline__ void top4_of(float (&cv)[NC], int (&ce)[NC], float (&tv)[4], int (&te)[4]) {
#pragma unroll
    for (int k = 0; k < 4; ++k) { float bv = -INFINITY; int be = 1 << 20;
#pragma unroll
        for (int i = 0; i < NC; ++i) { const bool t = (cv[i] > bv) | ((cv[i] == bv) & (ce[i] < be)); bv = t ? cv[i] : bv; be = t ? ce[i] : be; }
        tv[k] = bv; te[k] = be;
#pragma unroll
        for (int i = 0; i < NC; ++i) cv[i] = (ce[i] == be) ? -INFINITY : cv[i]; }
}
__device__ __forceinline__ void p4_router(const Frame& F, const Args& a, const bool dry) {
    unsigned char* ws = a.ws; const bf16_t* X1 = (const bf16_t*)(ws + WS_X1); const float* g2 = (const float*)a.in[14]; const float* wr_ = (const float*)a.in[15]; const float* br = (const float*)a.in[16];
    LAS unsigned char* WL = F.lds;
    LAS int* lcnt = (LAS int*)(F.lds + MISC_OFF); LAS int* lbase = lcnt + 32; LAS int* asg_e = lcnt + 64; LAS float* asg_g = (LAS float*)(lcnt + 64 + 512);
    for (int ci = F.tid; ci < 4096; ci += NWAVES * 64) { const int ks = ci >> 7, et = (ci >> 6) & 1, kq = (ci >> 4) & 3, er = ci & 15, e = 16 * et + er, k0 = 64 * (ks >> 1) + 16 * kq + 8 * (ks & 1);
        float w[8];
#pragma unroll
        for (int j = 0; j < 8; ++j) w[j] = g2[k0 + j] * wr_[(k0 + j) * 32 + e];
        u32x4 o; o.x = cvt_pk_bf16(w[0], w[1]); o.y = cvt_pk_bf16(w[2], w[3]); o.z = cvt_pk_bf16(w[4], w[5]); o.w = cvt_pk_bf16(w[6], w[7]);
        *(LAS u32x4*)(WL + ci * 16) = o; }
    if (F.tid < 32) lcnt[F.tid] = 0;
    __syncthreads();
    unsigned char* H2 = ws + WS_XN; unsigned* gcnt = (unsigned*)(ws + WS_CTL) + CW_CNT;
    int* TOKE = (int*)(ws + WS_TOKE); int* TOKR = (int*)(ws + WS_TOKR); float* TOKG = (float*)(ws + WS_TOKG); int* ROWTOK = (int*)(ws + WS_ROWTOK);
    const int tokl = F.lane & 15, kq = F.lane >> 4;
    for (int rb = blockIdx.x; rb < NTOK / 128; rb += F.G) {
        const int lrow = F.wave * 16 + tokl, m = rb * 128 + lrow;
        const bf16_t* xrow = X1 + (size_t)m * 1024 + 16 * kq;
        f32x4 acc0 = (f32x4){0.f, 0.f, 0.f, 0.f}, acc1 = (f32x4){0.f, 0.f, 0.f, 0.f}; float ss = 0.f;
#pragma unroll 4
        for (int ql = 0; ql < 16; ++ql) {
            const u32x4 x0 = *(const u32x4*)(xrow + 64 * ql), x1v = *(const u32x4*)(xrow + 64 * ql + 8);
#pragma unroll
            for (int d = 0; d < 4; ++d) { const float p = bf_lo(x0[d]), q = bf_hi(x0[d]), r = bf_lo(x1v[d]), t = bf_hi(x1v[d]); ss += (p * p + q * q) + (r * r + t * t); }
            const LAS unsigned char* wp = WL + ql * 4096 + F.lane * 16;
            acc0 = __builtin_amdgcn_mfma_f32_16x16x32_bf16(*(const LAS bf16x8*)(wp), __builtin_bit_cast(bf16x8, x0), acc0, 0, 0, 0);
            acc1 = __builtin_amdgcn_mfma_f32_16x16x32_bf16(*(const LAS bf16x8*)(wp + 1024), __builtin_bit_cast(bf16x8, x0), acc1, 0, 0, 0);
            acc0 = __builtin_amdgcn_mfma_f32_16x16x32_bf16(*(const LAS bf16x8*)(wp + 2048), __builtin_bit_cast(bf16x8, x1v), acc0, 0, 0, 0);
            acc1 = __builtin_amdgcn_mfma_f32_16x16x32_bf16(*(const LAS bf16x8*)(wp + 3072), __builtin_bit_cast(bf16x8, x1v), acc1, 0, 0, 0);
        }
        ss += __shfl_xor(ss, 16); ss += __shfl_xor(ss, 32);
        const float rstd = rsqrtf(ss * (1.0f / 1024.0f) + EPS);
        float cv[8]; int ce[8];
#pragma unroll
        for (int r = 0; r < 4; ++r) { ce[r] = 4 * kq + r; ce[4 + r] = 16 + 4 * kq + r; cv[r] = acc0[r] * rstd + br[4 * kq + r]; cv[4 + r] = acc1[r] * rstd + br[16 + 4 * kq + r]; }
        float tv[4]; int te[4];
        top4_of<8>(cv, ce, tv, te);
#pragma unroll
        for (int o = 16; o <= 32; o <<= 1) {
            float mv[8]; int me[8];
#pragma unroll
            for (int k = 0; k < 4; ++k) { mv[k] = tv[k]; me[k] = te[k]; mv[4 + k] = __shfl_xor(tv[k], o); me[4 + k] = __shfl_xor(te[k], o); }
            top4_of<8>(mv, me, tv, te);
        }
        if (kq == 0) {
            float ex[4], z = 0.f;
#pragma unroll
            for (int k = 0; k < 4; ++k) { ex[k] = __expf(tv[k] - tv[0]); z += ex[k]; }
#pragma unroll
            for (int k = 0; k < 4; ++k) { asg_e[lrow * 4 + k] = te[k]; asg_g[lrow * 4 + k] = ex[k] / z; }
        }
        unsigned char* hrow = H2 + (size_t)m * 1024 + 16 * kq;
#pragma unroll 4
        for (int ql = 0; ql < 16; ++ql) {
            const u32x4 x0 = *(const u32x4*)(xrow + 64 * ql), x1v = *(const u32x4*)(xrow + 64 * ql + 8);
            const f32x4 g0 = *(const f32x4*)(g2 + 64 * ql + 16 * kq), g1 = *(const f32x4*)(g2 + 64 * ql + 16 * kq + 4), g2v = *(const f32x4*)(g2 + 64 * ql + 16 * kq + 8), g3 = *(const f32x4*)(g2 + 64 * ql + 16 * kq + 12);
            u32x4 o;
            o.x = pk4_fp8(bf_lo(x0[0]) * rstd * g0[0], bf_hi(x0[0]) * rstd * g0[1], bf_lo(x0[1]) * rstd * g0[2], bf_hi(x0[1]) * rstd * g0[3]);
            o.y = pk4_fp8(bf_lo(x0[2]) * rstd * g1[0], bf_hi(x0[2]) * rstd * g1[1], bf_lo(x0[3]) * rstd * g1[2], bf_hi(x0[3]) * rstd * g1[3]);
            o.z = pk4_fp8(bf_lo(x1v[0]) * rstd * g2v[0], bf_hi(x1v[0]) * rstd * g2v[1], bf_lo(x1v[1]) * rstd * g2v[2], bf_hi(x1v[1]) * rstd * g2v[3]);
            o.w = pk4_fp8(bf_lo(x1v[2]) * rstd * g3[0], bf_hi(x1v[2]) * rstd * g3[1], bf_lo(x1v[3]) * rstd * g3[2], bf_hi(x1v[3]) * rstd * g3[3]);
            *(u32x4*)(hrow + 64 * ql) = o;
        }
        __syncthreads();
        if (dry) continue;
        const int e = asg_e[F.tid]; const int lrank = atomicAdd((int*)(lcnt + e), 1);
        __syncthreads();
        if (F.tid < 32) { const int c = lcnt[F.tid]; lbase[F.tid] = c ? (int)atomicAdd(gcnt + F.tid, (unsigned)c) : 0; }
        __syncthreads();
        const int rank = lbase[e] + lrank, tok = rb * 128 + (F.tid >> 2);
        ROWTOK[(size_t)e * NTOK + rank] = tok; TOKE[tok * 4 + (F.tid & 3)] = e; TOKR[tok * 4 + (F.tid & 3)] = rank; TOKG[tok * 4 + (F.tid & 3)] = asg_g[F.tid];
        __syncthreads();
        if (F.tid < 32) lcnt[F.tid] = 0;
        __syncthreads();
    }
}

__device__ __forceinline__ int build_group_tables(const Frame& F, const Args& a, LAS int* cnt, LAS int* pt, LAS int* tile_e) {
    const unsigned* gcnt = (const unsigned*)(a.ws + WS_CTL) + CW_CNT;
    __syncthreads();
    if (F.tid < 32) cnt[F.tid] = (int)__hip_atomic_load(gcnt + F.tid, __ATOMIC_RELAXED, __HIP_MEMORY_SCOPE_AGENT);
    __syncthreads();
    if (F.tid == 0) { int s = 0; for (int e = 0; e < 32; ++e) { pt[e] = s; s += (cnt[e] + 255) >> 8; } pt[32] = s; }
    __syncthreads();
    const int MT = pt[32];
    for (int e = 0; e < 32; ++e) { const int lo = pt[e], n = pt[e + 1] - lo; for (int i = F.tid; i < n; i += NWAVES * 64) tile_e[lo + i] = e; }
    __syncthreads();
    return MT;
}

__device__ __forceinline__ void p7_combine(const Frame& F, const Args& a, const LAS int* pt, float* dst) {
    unsigned char* ws = a.ws; const bf16_t* X1 = (const bf16_t*)(ws + WS_X1); const unsigned char* YB = ws + WS_YB;
    const int* TOKE = (const int*)(ws + WS_TOKE); const int* TOKR = (const int*)(ws + WS_TOKR); const float* TOKG = (const float*)(ws + WS_TOKG);
    const int gw = F.vcu * NWAVES + F.wave, NGW = F.G * NWAVES;
    for (int m = gw; m < NTOK; m += NGW) {
        size_t pos[4]; float g[4];
#pragma unroll
        for (int k = 0; k < 4; ++k) { const int e = TOKE[m * 4 + k]; pos[k] = (size_t)(256 * pt[e] + TOKR[m * 4 + k]) * 1024; g[k] = TOKG[m * 4 + k]; }
#pragma unroll
        for (int j = 0; j < 2; ++j) { const int c0 = 512 * j + 8 * F.lane; float* dp = dst + (size_t)m * 1024 + c0;
            f32x4 o0, o1; { float xx[8]; epi::unpack8(*(const u32x4*)(X1 + (size_t)m * 1024 + c0), xx); o0 = (f32x4){xx[0], xx[1], xx[2], xx[3]}; o1 = (f32x4){xx[4], xx[5], xx[6], xx[7]}; }
#pragma unroll
            for (int k = 0; k < 4; ++k) { float y[8]; { const u32x2 w8 = *(const u32x2*)(YB + pos[k] + c0); y[0] = __builtin_amdgcn_cvt_f32_fp8((int)w8.x, 0); y[1] = __builtin_amdgcn_cvt_f32_fp8((int)w8.x, 1); y[2] = __builtin_amdgcn_cvt_f32_fp8((int)w8.x, 2); y[3] = __builtin_amdgcn_cvt_f32_fp8((int)w8.x, 3);
                  y[4] = __builtin_amdgcn_cvt_f32_fp8((int)w8.y, 0); y[5] = __builtin_amdgcn_cvt_f32_fp8((int)w8.y, 1); y[6] = __builtin_amdgcn_cvt_f32_fp8((int)w8.y, 2); y[7] = __builtin_amdgcn_cvt_f32_fp8((int)w8.y, 3); }
#pragma unroll
                for (int i = 0; i < 4; ++i) { o0[i] += g[k] * y[i]; o1[i] += g[k] * y[4 + i]; } }
            *(f32x4*)dp = o0; *(f32x4*)(dp + 4) = o1; }
    }
}

#define XB_TMO      128
#define XB_XCNT(j)  (256  + 64 * (j))
#define XB_XSUB(j)  (1280 + 64 * (j))
#define XB_XGEN(j)  (2304 + 64 * (j))
#define XB_TOP      3328
#define XB_TOPGEN   3392
#define XCD_BAR_WORDS 3456
#define XB_SPIN_CAP (1u << 20)
__device__ __forceinline__ unsigned xb_ld(unsigned* p)              { return __hip_atomic_load(p, __ATOMIC_RELAXED, __HIP_MEMORY_SCOPE_AGENT); }
__device__ __forceinline__ unsigned xb_add(unsigned* p, unsigned v) { return __hip_atomic_fetch_add(p, v, __ATOMIC_RELAXED, __HIP_MEMORY_SCOPE_AGENT); }
__device__ __forceinline__ unsigned xb_xcc_id() { return (unsigned)__builtin_amdgcn_s_getreg((3 << 11) | 20) & 0xFu; }
#define XB_SPIN(cond, bar) do { unsigned _sp = 0; while (cond) { __builtin_amdgcn_s_sleep(1); \
    if ((++_sp & 255u) == 0u) { if (xb_ld(&(bar)[XB_TMO])) break; if (_sp > XB_SPIN_CAP) { atomicAdd(&(bar)[XB_TMO], 1u); break; } } } } while (0)
struct XcdBarrier { unsigned* bar; unsigned x; volatile LAS unsigned* st; };
__device__ __forceinline__ XcdBarrier xcd_barrier_post(unsigned* bar, volatile LAS unsigned* st) {
    XcdBarrier b; b.bar = bar; b.x = xb_xcc_id(); b.st = st;
    if (threadIdx.x == 0) (void)xb_add(&bar[XB_XCNT(b.x)], 1u);
    return b;
}
__device__ __forceinline__ void xcd_barrier_complete(unsigned* bar, unsigned x, unsigned& nloc, unsigned& nx) {
    const unsigned G = gridDim.x * gridDim.y * gridDim.z;
    unsigned sum, cnt, mine, sp = 0u;
    for (;;) {
        sum = 0u; cnt = 0u; mine = 0u;
#pragma unroll
        for (unsigned j = 0; j < 16; ++j) { const unsigned c = xb_ld(&bar[XB_XCNT(j)]); sum += c; cnt += (c > 0u) ? 1u : 0u; mine = (j == x) ? c : mine; }
        if (sum == G) break;
        __builtin_amdgcn_s_sleep(1);
        if ((++sp & 255u) == 0u) { if (xb_ld(&bar[XB_TMO])) break; if (sp > XB_SPIN_CAP) { atomicAdd(&bar[XB_TMO], 1u); break; } }
    }
    nloc = mine > 0u ? mine : 1u; nx = cnt > 0u ? cnt : 1u;
}
__device__ __forceinline__ void xcd_barrier(const XcdBarrier& b) {
    asm volatile("s_waitcnt vmcnt(0)" ::: "memory");
    __syncthreads();
    if (threadIdx.x == 0) {
        unsigned* bar = b.bar;
        __builtin_amdgcn_s_waitcnt(0);
        unsigned nloc = b.st[0], nx = b.st[1];
        if (nloc == 0u) { xcd_barrier_complete(bar, b.x, nloc, nx); b.st[0] = nloc; b.st[1] = nx; }
        const unsigned old = xb_add(&bar[XB_XSUB(b.x)], 1u);
        const unsigned gen = old / nloc;
        if (old + 1u == (gen + 1u) * nloc) {
            __builtin_amdgcn_fence(__ATOMIC_RELEASE, "agent");
            asm volatile("s_waitcnt vmcnt(0)" ::: "memory");
            const unsigned og = xb_add(&bar[XB_TOP], 1u);
            const unsigned tg = og / nx;
            if (og + 1u == (tg + 1u) * nx) xb_add(&bar[XB_TOPGEN], 1u);
            else XB_SPIN(xb_ld(&bar[XB_TOPGEN]) == tg, bar);
            __builtin_amdgcn_fence(__ATOMIC_ACQUIRE, "agent");
            xb_add(&bar[XB_XGEN(b.x)], 1u);
            asm volatile("s_waitcnt vmcnt(0)" ::: "memory");
        } else {
            XB_SPIN(xb_ld(&bar[XB_XGEN(b.x)]) == gen, bar);
            __builtin_amdgcn_fence(__ATOMIC_ACQUIRE, "agent");
            asm volatile("s_waitcnt vmcnt(0)" ::: "memory");
        }
    }
    __syncthreads();
}

__global__ void __launch_bounds__(NWAVES * 64, 2) hyb_fwd(Args args) {
    extern __shared__ __attribute__((aligned(16))) unsigned char lds_raw[];
#define MKFRAME() Frame F; F.lds = (LAS unsigned char*)lds_raw; F.tid = opaque_tid(); F.lane = F.tid & 63; F.wave = __builtin_amdgcn_readfirstlane(F.tid >> 6); \
    F.G = gridDim.x; { const int bx = blockIdx.x; F.vcu = (F.G % 8 == 0) ? (bx % 8) * (F.G / 8) + bx / 8 : bx; }
    unsigned char* ws = args.ws;
    const int lo = args.ph_lo, hi = args.ph_hi;
#ifndef PHASE_MASK
#define PHASE_MASK 0x1ff
#endif
#define IN(k) (((PHASE_MASK >> (k)) & 1) && lo <= (k) && (k) < hi)
#define BOTH(k) (IN(k) && IN((k) + 1))
#ifndef REPEAT_MASK
#define REPEAT_MASK 0
#endif
#define NREP(k) (1 + ((REPEAT_MASK >> (k)) & 1))
    volatile LAS unsigned* bst = (volatile LAS unsigned*)((LAS unsigned char*)lds_raw + MISC_OFF + MISC_BAR);
    if (threadIdx.x < 4) bst[threadIdx.x] = 0u;
    __syncthreads();
    XcdBarrier xbar; xbar.bar = (unsigned*)(ws + WS_CTL) + CW_BAR; xbar.x = 0; xbar.st = bst;
    if (hi - lo > 1) xbar = xcd_barrier_post((unsigned*)(ws + WS_CTL) + CW_BAR, bst);
#define GRID_BAR() xcd_barrier(xbar)
    LAS int* t_cnt = (LAS int*)((LAS unsigned char*)lds_raw + MISC_OFF); LAS int* t_pt = t_cnt + 64; LAS int* t_tile = t_cnt + 128;
    constexpr size_t TS1024 = (size_t)256 * 1024 * 2, TS512 = (size_t)256 * 512 * 2;

    if (IN(0)) { MKFRAME(); for (int rep = 0; rep < NREP(0); ++rep) { if (rep) GRID_BAR(); p0_prologue(F, args); } if (BOTH(0)) GRID_BAR(); }
    if (IN(1)) {
        MKFRAME();
        for (int bh = blockIdx.x; bh < 32; bh += F.G) p1_cumsum(F, args, bh);
        pg8::DenseOrder S{NTOK / 256, P1_FP8 ? 7 : IN_TILES, F.G, (int)blockIdx.x, (const char*)(ws + WS_XN), (const char*)(ws + WS_WIN), TS1024};
        pg8::SplitOrder S8{NTOK / 256, 10, F.G, (int)blockIdx.x, 7, (const char*)(ws + WS_XN8), (const char*)(ws + WS_WIN8), TS512};
        epi::EpiIn E{(bf16_t*)(ws + WS_QA), (bf16_t*)(ws + WS_KA), (bf16_t*)(ws + WS_VA), (bf16_t*)(ws + WS_QF), (bf16_t*)(ws + WS_KF), (bf16_t*)(ws + WS_VF), ws + WS_GT,
                     (const int*)args.in[1], (const float*)args.in[6], (const float*)args.in[7], (const float*)args.in[9], (const float*)args.in[10], (const float*)args.in[5]};
        for (int rep = 0; rep < NREP(1); ++rep) { if (rep) GRID_BAR(); pg8::gemm_phase<epi::EpiIn, pg8::DenseOrder, false>(F.lds, 1024, S, E); if (P1_FP8) pg8::gemm_phase<epi::EpiIn, pg8::SplitOrder, false, true>(F.lds, 512, S8, E); }
        if (BOTH(1)) GRID_BAR();
    }
    if (IN(2)) { MKFRAME(); for (int rep = 0; rep < NREP(2); ++rep) { if (rep) { GRID_BAR(); if (blockIdx.x == 0 && threadIdx.x == 0) __hip_atomic_store((unsigned*)(ws + WS_CTL) + CW_QCTR, 0u, __ATOMIC_RELAXED, __HIP_MEMORY_SCOPE_AGENT); GRID_BAR(); } p2_attention(F, args, (char*)lds_raw); } if (BOTH(2)) GRID_BAR(); }
    if (IN(3)) {
        MKFRAME();
        pg8::PairOrder S{NTOK / 256, 4, F.G, (int)blockIdx.x, (const char*)(ws + WS_OA), (const char*)(ws + WS_OB), (const char*)(ws + (P3A_FP8 ? WS_WOA8 : WS_WOA)), (const char*)(ws + (P3A_FP8 ? WS_WOB8 : WS_WOB)), P3A_FP8 ? TS512 / 2 : TS512};
        epi::EpiMerge E{ws + WS_GT, (bf16_t*)(ws + WS_MG), ws + WS_MG8};
        for (int rep = 0; rep < NREP(3); ++rep) { if (rep) GRID_BAR();
            if (P3A_FP8) pg8::gemm_phase<epi::EpiMerge, pg8::PairOrder, false, true, 0x7a7a7a7au>(F.lds, 256, S, E);
            else pg8::gemm_phase<epi::EpiMerge, pg8::PairOrder, false>(F.lds, 512, S, E); }
        if (BOTH(3)) GRID_BAR();
    }
    if (IN(4)) {
        MKFRAME();
        pg8::DenseOrder S{NTOK / 256, 4, F.G, (int)blockIdx.x, (const char*)(ws + (P3B_FP8 ? WS_MG8 : WS_MG)), (const char*)(ws + (P3B_FP8 ? WS_WOUT8 : WS_WOUT)), P3B_FP8 ? TS512 : TS1024};
        bool rec;
        { const float* g1p = (const float*)args.in[2]; float mn = fminf(fabsf(g1p[F.tid]), fabsf(g1p[F.tid + 512]));
#pragma unroll
          for (int o = 1; o < 64; o <<= 1) mn = fminf(mn, __shfl_xor(mn, o));
          LAS float* red = (LAS float*)(F.lds + MISC_OFF);
          __syncthreads(); if (F.lane == 0) red[F.wave] = mn; __syncthreads();
          float all = red[0];
#pragma unroll
          for (int w = 1; w < NWAVES; ++w) all = fminf(all, red[w]);
          rec = __builtin_amdgcn_readfirstlane((int)(all >= 0.015625f)) != 0; __syncthreads(); }
        epi::EpiResid E{(const float*)args.in[0], (bf16_t*)(ws + WS_X1), (const bf16_t*)(ws + WS_XN), (const float*)(ws + WS_RMS), (const float*)args.in[2], rec};
        for (int rep = 0; rep < NREP(4); ++rep) { if (rep) GRID_BAR();
            if (P3B_FP8) pg8::gemm_phase<epi::EpiResid, pg8::DenseOrder, false, true, 0x7a7a7a7au>(F.lds, 512, S, E);
            else pg8::gemm_phase<epi::EpiResid, pg8::DenseOrder, false>(F.lds, 1024, S, E); }
        if (BOTH(4)) GRID_BAR();
    }
    if (IN(5)) { MKFRAME(); if (NREP(5) > 1) { p4_router(F, args, true); GRID_BAR(); } p4_router(F, args, false); if (BOTH(5)) GRID_BAR(); }
    if (IN(6)) {
        MKFRAME();
        const int MT = build_group_tables(F, args, t_cnt, t_pt, t_tile);
        LAS int* tokl = (LAS int*)(F.lds + MISC_OFF + MISC_TOKL);
        pg8::GroupOrder S{MT, 8, F.G, (int)blockIdx.x, t_tile, t_pt, t_cnt, (const char*)(ws + WS_XN), (const char*)(ws + WS_WGU), TS512, 2048, tokl, true};
        { const int* ROWTOK = (const int*)(ws + WS_ROWTOK);
          int tv[TOKL_UNITS];
#pragma unroll
          for (int ui = 0; ui < TOKL_UNITS; ++ui) { const long L = (long)ui * F.G + (int)blockIdx.x; tv[ui] = 0;
              if (L < (long)MT * 8 && F.tid < 256) { int pm, pn; pg8::tile_map((int)L, MT, 8, pm, pn); const int e = t_tile[pm], idx = (pm - t_pt[e]) * 256 + F.tid; if (idx < t_cnt[e]) tv[ui] = ROWTOK[(size_t)e * NTOK + idx]; } }
          if (F.tid < 256) {
#pragma unroll
              for (int ui = 0; ui < TOKL_UNITS; ++ui) tokl[ui * 256 + F.tid] = tv[ui]; }
          __syncthreads(); }
        epi::EpiSwiglu E{(const float*)args.in[18], ws + WS_ACT};
        for (int rep = 0; rep < NREP(6); ++rep) { if (rep) GRID_BAR(); pg8::gemm_phase<epi::EpiSwiglu, pg8::GroupOrder, true, true>(F.lds, 512, S, E); }
        if (BOTH(6)) GRID_BAR();
    }
    if (IN(7)) {
        MKFRAME();
        const int MT = build_group_tables(F, args, t_cnt, t_pt, t_tile);
        pg8::GroupOrder S{MT, 4, F.G, (int)blockIdx.x, t_tile, t_pt, t_cnt, (const char*)(ws + WS_ACT), (const char*)(ws + WS_WD), TS512, 1024, (const LAS int*)nullptr, false};
        epi::EpiDown E{(const float*)args.in[20], ws + WS_YB};
        for (int rep = 0; rep < NREP(7); ++rep) { if (rep) GRID_BAR(); pg8::gemm_phase<epi::EpiDown, pg8::GroupOrder, false, true>(F.lds, 512, S, E); }
        if (BOTH(7)) GRID_BAR();
    }
    if (IN(8)) { MKFRAME(); (void)build_group_tables(F, args, t_cnt, t_pt, t_tile); if (NREP(8) > 1) { p7_combine(F, args, t_pt, (float*)(ws + 896 * MiB)); GRID_BAR(); } p7_combine(F, args, t_pt, args.out); }
#undef IN
#undef BOTH
#undef GRID_BAR
#undef MKFRAME
}

extern "C" void kernel_launch(void* const* d_in, const int* in_sizes, int n_in, void* d_out, int out_size, void* d_ws, size_t ws_size, hipStream_t stream) {
    static int grid = 0;
    if (grid == 0) {
        if (n_in != 21 || in_sizes[0] != NTOK * D_MODEL || out_size != NTOK * D_MODEL || ws_size < WS_END) {
            fprintf(stderr, "kernel_launch: unexpected shapes (n_in %d, in0 %d, out %d, ws %zu); nothing launched\n", n_in, n_in > 0 ? in_sizes[0] : -1, out_size, ws_size); grid = -1; return; }
        int dev = 0, cus = 0, per_cu = 0;
        if (hipGetDevice(&dev) != hipSuccess || hipDeviceGetAttribute(&cus, hipDeviceAttributeMultiprocessorCount, dev) != hipSuccess) { fprintf(stderr, "kernel_launch: device query failed\n"); grid = -1; return; }
        if (hipFuncSetAttribute((const void*)hyb_fwd, hipFuncAttributeMaxDynamicSharedMemorySize, LDS_BYTES) != hipSuccess) { fprintf(stderr, "kernel_launch: hipFuncSetAttribute failed\n"); grid = -1; return; }
        if (hipOccupancyMaxActiveBlocksPerMultiprocessor(&per_cu, (const void*)hyb_fwd, NWAVES * 64, LDS_BYTES) != hipSuccess || per_cu < 1) { fprintf(stderr, "kernel_launch: occupancy query says %d\n", per_cu); per_cu = 1; }
        (void)hipGetLastError();
        grid = cus;
        if (grid > cus * per_cu) grid = cus * per_cu;
    }
    if (grid < 0) return;
    (void)hipMemsetAsync((char*)d_ws + WS_CTL, 0, CTL_ZERO_BYTES, stream);
    Args a{};
    for (int i = 0; i < 21; ++i) a.in[i] = d_in[i];
    a.out = (float*)d_out; a.ws = (unsigned char*)d_ws;
#if MK_N_LAUNCHES == 1
    a.ph_lo = 0; a.ph_hi = N_PHASES;
    void* kargs[] = {&a};
    hipError_t e = hipLaunchCooperativeKernel((const void*)hyb_fwd, dim3(grid), dim3(NWAVES * 64), kargs, LDS_BYTES, stream);
    if (e != hipSuccess) fprintf(stderr, "kernel_launch: cooperative launch failed: %s (grid %d)\n", hipGetErrorString(e), grid);
#else
    for (int p = 0; p < N_PHASES; ++p) { a.ph_lo = p; a.ph_hi = p + 1; hipLaunchKernelGGL(hyb_fwd, dim3(grid), dim3(NWAVES * 64), LDS_BYTES, stream, a); }
#endif
}
```

```cpp
#include <hip/hip_runtime.h>
#include <hip/hip_cooperative_groups.h>
#include <hip/hip_bf16.h>
#include <cstdio>
#include <cstdint>
namespace cg = cooperative_groups;

#ifndef XREC
#define XREC 1
#endif
#ifndef P3A_FP8
#define P3A_FP8 1
#endif
#ifndef P3B_FP8
#define P3B_FP8 1
#endif
#ifndef P1_FP8
#define P1_FP8 1
#endif
#ifndef MK_N_LAUNCHES
#define MK_N_LAUNCHES 1
#endif

#define LAS __attribute__((address_space(3)))
typedef unsigned short bf16_t;
typedef short bf16x8 __attribute__((ext_vector_type(8)));
typedef short s16x4 __attribute__((ext_vector_type(4)));
typedef float f32x2 __attribute__((ext_vector_type(2)));
typedef float f32x4 __attribute__((ext_vector_type(4)));
typedef float f32x16 __attribute__((ext_vector_type(16)));
typedef unsigned u32x2 __attribute__((ext_vector_type(2)));
typedef unsigned u32x4 __attribute__((ext_vector_type(4)));
typedef int i32x4_t __attribute__((ext_vector_type(4)));

constexpr int D_MODEL = 1024, BATCH = 4, SEQ = 8192, NTOK = BATCH * SEQ;
constexpr int HD = 64, SWA_QH = 8, SWA_KVH = 2, FOX_H = 8, N_EXP = 32, TOPK = 4, D_FF = 1024;
constexpr int IN_W = 4360, COL_FL = 2304, COL_GL = 2312;
constexpr int IN_TILES = 17;
constexpr float EPS = 1e-6f;
constexpr float LOG2E = 1.4426950408889634f;
constexpr float C2 = 0.125f * LOG2E;
constexpr int CAP_TILES = (NTOK * TOPK) / 256 + N_EXP;

__device__ __forceinline__ unsigned cvt_pk_bf16(float lo, float hi) { typedef __bf16 b2 __attribute__((ext_vector_type(2))); f32x2 v = {lo, hi}; b2 b = __builtin_convertvector(v, b2); return __builtin_bit_cast(unsigned, b); }
__device__ __forceinline__ float bf_lo(unsigned u) { return __uint_as_float(u << 16); }
__device__ __forceinline__ float bf_hi(unsigned u) { return __uint_as_float(u & 0xffff0000u); }
__device__ __forceinline__ float bf2f(short s) { return __uint_as_float(((unsigned)(unsigned short)s) << 16); }
__device__ __forceinline__ float clamp448(float x) { return __builtin_fminf(__builtin_fmaxf(x, -448.0f), 448.0f); }
__device__ __forceinline__ unsigned pk4_fp8(float a, float b, float c, float d) {
    int r = __builtin_amdgcn_cvt_pk_fp8_f32(clamp448(a), clamp448(b), 0, false); r = __builtin_amdgcn_cvt_pk_fp8_f32(clamp448(c), clamp448(d), r, true); return (unsigned)r; }
__device__ __forceinline__ unsigned pk4_fp8_nc(float a, float b, float c, float d) { int r = __builtin_amdgcn_cvt_pk_fp8_f32(a, b, 0, false); r = __builtin_amdgcn_cvt_pk_fp8_f32(c, d, r, true); return (unsigned)r; }
typedef int i32x8 __attribute__((ext_vector_type(8)));
constexpr float W8_SCALE = 32.0f;
__device__ __forceinline__ int opaque_tid() { int t = threadIdx.x; asm volatile("" : "+v"(t)); return t; }
__host__ __device__ __forceinline__ int perm32s(int p) { return 16 * ((p >> 2) & 1) + 4 * (p >> 3) + (p & 3); }

namespace pg8 {
constexpr int BM = 256, BK = 64, HALF = 128, HTB = HALF * BK * 2  , STAGE_BYTES = 8 * HTB, NXCD = 8, WGM = 4;
__host__ __device__ __forceinline__ int lds_byte(int r, int c) { const int st = (r >> 4) * 2 + (c >> 5), rr = r & 15, cc = c & 31, ob = rr * 64 + cc * 2; return st * 1024 + (ob ^ (((ob >> 9) & 1) << 5)); }
__host__ __device__ __forceinline__ void stage_rc(int b, int& R, int& C) { const int st = b / 1024, sb = b % 1024, swz = sb ^ (((sb >> 9) & 1) << 5); R = (st >> 1) * 16 + swz / 64; C = (st & 1) * 32 + (swz % 64) / 2; }

struct Unit { int pm, pn, e; const char* a; const char* b; const LAS int* gtab; int gcnt; };

__device__ __forceinline__ void tile_map(int L, int nM, int nN, int& pm, int& pn) {
    const int nwg = nM * nN; int wgid = L; { const int q = nwg / NXCD, r = nwg % NXCD, xcd = wgid % NXCD, off = wgid / NXCD; wgid = (xcd < r ? xcd * (q + 1) : r * (q + 1) + (xcd - r) * q) + off; }
    const int nig = WGM * nN, gid = wgid / nig, fm = gid * WGM, gsz = (nM - fm) < WGM ? (nM - fm) : WGM;
    pm = fm + ((wgid % nig) % gsz); pn = (wgid % nig) / gsz;
}
struct DenseOrder {
    int nM, nN, G, c; const char* A; const char* B; size_t tstep;
    __device__ __forceinline__ bool next(int i, Unit& u) const {
        const long L = (long)i * G + c; if (L >= (long)nM * nN) return false;
        tile_map((int)L, nM, nN, u.pm, u.pn); u.e = 0; u.a = A + (size_t)u.pm * tstep; u.b = B + (size_t)u.pn * tstep; u.gtab = nullptr; u.gcnt = 0; return true; }
};
struct SplitOrder {
    int nM, nN, G, c, pn0; const char* A; const char* B; size_t tstep;
    __device__ __forceinline__ bool next(int i, Unit& u) const {
        long L;
        if (G == 256 && nM * nN == 1280) { if (c < 128) { if (i >= 4) return false; L = (long)i * 128 + c; } else { if (i >= 6) return false; L = 512 + (long)i * 128 + (c - 128); } }
        else { L = (long)i * G + c; if (L >= (long)nM * nN) return false; }
        tile_map((int)L, nM, nN, u.pm, u.pn); u.e = 0; u.a = A + (size_t)u.pm * tstep; u.b = B + (size_t)u.pn * tstep; u.pn += pn0; u.gtab = nullptr; u.gcnt = 0; return true; }
};
struct PairOrder {
    int nM, nN, G, c; const char* A0; const char* A1; const char* B0; const char* B1; size_t tstep;
    __device__ __forceinline__ bool next(int i, Unit& u) const {
        const long L = (long)(i >> 1) * G + c; if (L >= (long)nM * nN) return false;
        tile_map((int)L, nM, nN, u.pm, u.pn); u.e = i & 1; u.a = ((i & 1) ? A1 : A0) + (size_t)u.pm * tstep; u.b = ((i & 1) ? B1 : B0) + (size_t)u.pn * tstep; u.gtab = nullptr; u.gcnt = 0; return true; }
};
struct GroupOrder {
    int MT, nN, G, c; const LAS int* tile_e; const LAS int* pt; const LAS int* cnt; const char* A; const char* B; size_t tstep; int brows; const LAS int* tokl; bool gather;
    __device__ __forceinline__ bool next(int i, Unit& u) const {
        const long L = (long)i * G + c; if (L >= (long)MT * nN) return false;
        tile_map((int)L, MT, nN, u.pm, u.pn); const int e = tile_e[u.pm]; u.e = e;
        u.b = B + ((size_t)e * brows + (size_t)u.pn * BM) / BM * tstep;
        if (gather) { u.a = A; u.gtab = tokl + i * BM; u.gcnt = BM; }
        else { u.a = A + (size_t)u.pm * tstep; u.gtab = nullptr; u.gcnt = 0; }
        return true; }
};

template <class Epi, class Sched, bool GATHER, bool FP8 = false, unsigned ASC = 0x7f7f7f7fu>
__device__ __forceinline__ void gemm_phase(LAS unsigned char* lds, const int K, const Sched& S, const Epi& E) {
    const int tid = opaque_tid(), wid = __builtin_amdgcn_readfirstlane(tid >> 6), lane = tid & 63, wr = wid >> 2, wc = wid & 3, fr = lane & 15, fq = lane >> 4;
    const int nt = K / BK;
    unsigned voffA[2], voffB[2]; int RA[2]; unsigned CA2[2];
#pragma unroll
    for (int i = 0; i < 2; ++i) { int R, C; stage_rc(tid * 16 + i * 8192, R, C); voffA[i] = (unsigned)(R * K + C) * 2u; voffB[i] = voffA[i]; RA[i] = R; CA2[i] = (unsigned)C * 2u; }
    const size_t kstep = (size_t)(BK * 2);
    const size_t hstep = (size_t)HALF * K * 2;
    const unsigned ldsw = (unsigned)wid * 1024u;
    const int aoff = lds_byte(wr * 64 + fr, fq * 8), boff = lds_byte(wc * 32 + fr, fq * 8);
#define PG8_SA(b, h) (((b) * 2 + (h)) * HTB)
#define PG8_SB(b, h) ((4 + (b) * 2 + (h)) * HTB)
#define PG8_STAGE(bufoff, gbase, voff) do { _Pragma("unroll") for (int _i = 0; _i < 2; ++_i) \
        __builtin_amdgcn_global_load_lds((const unsigned*)((const char*)(gbase) + (voff)[_i]), (LAS unsigned*)(lds + (bufoff) + ldsw + _i * 8192), 16, 0, 0); } while (0)
#define PG8_STAGE_A(bufoff, gbase, h, NXT) do { if constexpr (GATHER) { unsigned _v[2]; _v[0] = (NXT) ? nv[h][0] : cv[h][0]; _v[1] = (NXT) ? nv[h][1] : cv[h][1]; PG8_STAGE(bufoff, gbase, _v); } \
        else { PG8_STAGE(bufoff, (const char*)(gbase) + (h) * hstep, voffA); } } while (0)
#define PG8_LOADG(u, v) do { _Pragma("unroll") for (int _h = 0; _h < 2; ++_h) _Pragma("unroll") for (int _i = 0; _i < 2; ++_i) { const int _r = _h * HALF + RA[_i]; \
        const int _tok = (u).gtab[_r]; v[_h][_i] = (unsigned)_tok * (unsigned)(K * 2) + CA2[_i]; } } while (0)
#define PG8_LDA(dst, b, h) do { _Pragma("unroll") for (int m = 0; m < 4; ++m) _Pragma("unroll") for (int k = 0; k < 2; ++k) dst[m][k] = *(const LAS bf16x8*)(lds + PG8_SA(b, h) + aoff + m * 2048 + k * 1024); } while (0)
#define PG8_LDB(dst, b, h) do { _Pragma("unroll") for (int n = 0; n < 2; ++n) _Pragma("unroll") for (int k = 0; k < 2; ++k) dst[n][k] = *(const LAS bf16x8*)(lds + PG8_SB(b, h) + boff + n * 2048 + k * 1024); } while (0)
#define PG8_CAT(x) __builtin_shufflevector(__builtin_bit_cast(i32x4_t, x[0]), __builtin_bit_cast(i32x4_t, x[1]), 0, 1, 2, 3, 4, 5, 6, 7)
#define PG8_MMA(ai, bj, At, Bt) do { __builtin_amdgcn_s_setprio(1); if constexpr (FP8) { _Pragma("unroll") for (int m = 0; m < 4; ++m) _Pragma("unroll") for (int n = 0; n < 2; ++n) \
        asm volatile("v_mfma_scale_f32_16x16x128_f8f6f4 %0, %1, %2, %0, %3, %4 op_sel_hi:[0,0,0]" : "+v"(acc[ai][bj][m][n]) : "v"(PG8_CAT(Bt[n])), "v"(PG8_CAT(At[m])), "v"(0x7a7a7a7a), "v"(ASC)); } \
        else { _Pragma("unroll") for (int m = 0; m < 4; ++m) _Pragma("unroll") for (int n = 0; n < 2; ++n) _Pragma("unroll") for (int k = 0; k < 2; ++k) \
        acc[ai][bj][m][n] = __builtin_amdgcn_mfma_f32_16x16x32_bf16(Bt[n][k], At[m][k], acc[ai][bj][m][n], 0, 0, 0); } __builtin_amdgcn_s_setprio(0); } while (0)
#define PG8_WAIT_V(n) asm volatile("s_waitcnt vmcnt(" #n ")" ::: "memory")
#define PG8_WAIT_L(n) asm volatile("s_waitcnt lgkmcnt(" #n ")" ::: "memory")
#define PG8_BAR __builtin_amdgcn_s_barrier()
#define PG8_SCHED __builtin_amdgcn_sched_barrier(0)
    Unit cur, nxt; int ui = 0;
    if (!S.next(0, cur)) return;
    f32x4 acc[2][2][4][2];
#pragma unroll
    for (int a = 0; a < 2; ++a)
#pragma unroll
        for (int b = 0; b < 2; ++b)
#pragma unroll
            for (int m = 0; m < 4; ++m)
#pragma unroll
                for (int n = 0; n < 2; ++n) acc[a][b][m][n] = (f32x4){0.f, 0.f, 0.f, 0.f};
    bf16x8 At[4][2], B0[2][2], B1[2][2];
    unsigned cv[2][2] = {{0u, 0u}, {0u, 0u}}, nv[2][2] = {{0u, 0u}, {0u, 0u}};
    const char* cA = cur.a; const char* cB = cur.b;
    if constexpr (GATHER) { PG8_LOADG(cur, cv); }
    PG8_STAGE(PG8_SB(0, 0), cB, voffB); PG8_STAGE(PG8_SB(0, 1), cB + hstep, voffB); PG8_STAGE_A(PG8_SA(0, 0), cA, 0, false); PG8_STAGE_A(PG8_SA(0, 1), cA, 1, false);
    if (wr == 1) PG8_BAR;
    PG8_WAIT_V(2); PG8_BAR;
    PG8_STAGE(PG8_SB(1, 0), cB + kstep, voffB); PG8_STAGE_A(PG8_SA(1, 0), cA + kstep, 0, false); PG8_STAGE(PG8_SB(1, 1), cB + hstep + kstep, voffB);
    PG8_WAIT_V(6); PG8_BAR;
    for (;;) {
        const bool has_next = S.next(ui + 1, nxt);
        const char* nA = has_next ? nxt.a : cA; const char* nB = has_next ? nxt.b : cB;
        if constexpr (GATHER) {
            if (has_next) { PG8_LOADG(nxt, nv); }
            else {
#pragma unroll
                for (int h = 0; h < 2; ++h)
#pragma unroll
                    for (int i = 0; i < 2; ++i) nv[h][i] = cv[h][i]; }
        }
#pragma clang loop unroll(disable)
        for (int t = 0; t < nt; t += 2) {
            const bool last = (t == nt - 2);
            const char* a1 = cA + (size_t)(t + 1) * kstep;
            const char* a2 = last ? nA : cA + (size_t)(t + 2) * kstep; const char* b2 = last ? nB : cB + (size_t)(t + 2) * kstep;
            const char* a3 = a2 + kstep; const char* b3 = b2 + kstep;
            PG8_LDB(B0, 0, 0); PG8_LDB(B1, 0, 1); PG8_SCHED; PG8_LDA(At, 0, 0); PG8_STAGE_A(PG8_SA(1, 1), a1, 1, false);
            PG8_WAIT_V(8); PG8_WAIT_L(0); PG8_BAR; PG8_MMA(0, 0, At, B0); PG8_MMA(0, 1, At, B1); PG8_BAR; PG8_SCHED;
            PG8_LDA(At, 0, 1); PG8_STAGE(PG8_SB(0, 0), b2, voffB); PG8_STAGE(PG8_SB(0, 1), b2 + hstep, voffB); PG8_STAGE_A(PG8_SA(0, 0), a2, 0, last);
            PG8_WAIT_V(8); PG8_WAIT_L(0); PG8_BAR; PG8_MMA(1, 0, At, B0); PG8_MMA(1, 1, At, B1); PG8_BAR; PG8_SCHED;
            PG8_LDB(B0, 1, 0); PG8_LDB(B1, 1, 1); PG8_SCHED; PG8_LDA(At, 1, 0); PG8_STAGE_A(PG8_SA(0, 1), a2, 1, last);
            PG8_WAIT_V(8); PG8_WAIT_L(0); PG8_BAR; PG8_MMA(0, 0, At, B0); PG8_MMA(0, 1, At, B1); PG8_BAR; PG8_SCHED;
            PG8_LDA(At, 1, 1); PG8_STAGE(PG8_SB(1, 0), b3, voffB); PG8_STAGE(PG8_SB(1, 1), b3 + hstep, voffB); PG8_STAGE_A(PG8_SA(1, 0), a3, 0, last);
            PG8_WAIT_V(8); PG8_WAIT_L(0); PG8_BAR; PG8_MMA(1, 0, At, B0); PG8_MMA(1, 1, At, B1); PG8_BAR; PG8_SCHED;
        }
        if constexpr (FP8) asm volatile("s_nop 15\n\ts_nop 7" ::: "memory");
        if (wr == 0) PG8_BAR;
        bool keep = false;
        if constexpr (Epi::PAIR_KEEP) keep = (cur.e == 0);
        if constexpr (Epi::PAIR_KEEP) { if (keep) E.rescale(acc, cur, wr, wc, fr, fq); else E(acc, cur, wr, wc, fr, fq); } else E(acc, cur, wr, wc, fr, fq);
        if (!has_next) break;
        if (!keep) {
#pragma unroll
        for (int a = 0; a < 2; ++a)
#pragma unroll
            for (int b = 0; b < 2; ++b)
#pragma unroll
                for (int m = 0; m < 4; ++m)
#pragma unroll
                    for (int n = 0; n < 2; ++n) acc[a][b][m][n] = (f32x4){0.f, 0.f, 0.f, 0.f};
        }
        cur = nxt; cA = nA; cB = nB; ++ui;
        if constexpr (GATHER) {
#pragma unroll
            for (int h = 0; h < 2; ++h)
#pragma unroll
                for (int i = 0; i < 2; ++i) cv[h][i] = nv[h][i]; }
        if (wr == 1) PG8_BAR;
    }
    PG8_WAIT_V(0);
    PG8_BAR;
#undef PG8_SA
#undef PG8_SB
#undef PG8_STAGE
#undef PG8_STAGE_A
#undef PG8_LOADG
#undef PG8_LDA
#undef PG8_LDB
#undef PG8_MMA
#undef PG8_CAT
#undef PG8_WAIT_V
#undef PG8_WAIT_L
#undef PG8_BAR
#undef PG8_SCHED
}
}

namespace epi {
using pg8::Unit;
__device__ __forceinline__ u32x4 pack8(const f32x4& a, const f32x4& b) { u32x4 w; w.x = cvt_pk_bf16(a[0], a[1]); w.y = cvt_pk_bf16(a[2], a[3]); w.z = cvt_pk_bf16(b[0], b[1]); w.w = cvt_pk_bf16(b[2], b[3]); return w; }
__device__ __forceinline__ void unpack8(const u32x4& w, float (&f)[8]) { f[0] = bf_lo(w.x); f[1] = bf_hi(w.x); f[2] = bf_lo(w.y); f[3] = bf_hi(w.y); f[4] = bf_lo(w.z); f[5] = bf_hi(w.z); f[6] = bf_lo(w.w); f[7] = bf_hi(w.w); }
__device__ __forceinline__ float sigmoidf_(float z) { return __builtin_amdgcn_rcpf(1.0f + __expf(-z)); }

struct EpiIn {
    static constexpr bool PAIR_KEEP = false;
    bf16_t *QA, *KA, *VA, *QF, *KF, *VF; unsigned char* GT; const int* pos; const float *qn_s, *kn_s, *qn_f, *kn_f, *b_gate;
    __device__ __forceinline__ void operator()(const f32x4 (&acc)[2][2][4][2], const Unit& u, int wr, int wc, int fr, int fq) const {
        const int pn = u.pn; const int row0 = u.pm * 256 + wr * 64 + fr;
        if (pn >= 9) {
            const int col0 = (pn - 9) * 256 + wc * 64 + 16 * fq;
            f32x4 bv[2][2];
#pragma unroll
            for (int bj = 0; bj < 2; ++bj)
#pragma unroll
                for (int n = 0; n < 2; ++n) bv[bj][n] = *(const f32x4*)(b_gate + col0 + bj * 8 + 4 * n) * (-LOG2E);
#pragma unroll
            for (int ai = 0; ai < 2; ++ai)
#pragma unroll
                for (int m = 0; m < 4; ++m) { u32x4 w;
#pragma unroll
                    for (int bj = 0; bj < 2; ++bj)
#pragma unroll
                        for (int n = 0; n < 2; ++n) { const f32x4 v = acc[ai][bj][m][n]; unsigned r = 0;
#pragma unroll
                            for (int i = 0; i < 4; ++i) { const float sg = __builtin_amdgcn_rcpf(1.0f + __builtin_amdgcn_exp2f(__builtin_fmaf(v[i], -LOG2E, bv[bj][n][i])));
                                r = __builtin_amdgcn_cvt_pk_u8_f32(__builtin_fmaf(sg, 255.0f, 0.5f), i, r); }
                            w[2 * bj + n] = r; }
                    *(u32x4*)(GT + (size_t)(row0 + ai * 128 + m * 16) * 2048 + col0) = w; }
            return;
        }
        bf16_t* dst; int pitch, hcol; const float* nw; bool rope; float scale;
        if (pn < 2)       { dst = QA; pitch = 512; hcol = (4 * pn + wc) * 64; nw = qn_s; rope = true; scale = C2; }
        else if (pn == 2) { if (wc < 2) { dst = KA; pitch = 128; hcol = wc * 64; nw = kn_s; rope = true; scale = 1.f; } else { dst = VA; pitch = 128; hcol = (wc - 2) * 64; nw = nullptr; rope = false; scale = 1.f; } }
        else if (pn < 5)  { dst = QF; pitch = 512; hcol = (4 * (pn - 3) + wc) * 64; nw = qn_f; rope = false; scale = C2; }
        else if (pn < 7)  { dst = KF; pitch = 512; hcol = (4 * (pn - 5) + wc) * 64; nw = kn_f; rope = false; scale = 1.f; }
        else              { dst = VF; pitch = 512; hcol = (4 * (pn - 7) + wc) * 64; nw = nullptr; rope = false; scale = 1.f; }
        f32x4 wv[2][2]; float inv[2][4];
#pragma unroll
        for (int bj = 0; bj < 2; ++bj)
#pragma unroll
            for (int n = 0; n < 2; ++n) { wv[bj][n] = nw ? *(const f32x4*)(nw + 32 * bj + 8 * fq + 4 * n) : (f32x4){1.f, 1.f, 1.f, 1.f}; wv[bj][n] = wv[bj][n] * scale; }
#pragma unroll
        for (int n = 0; n < 2; ++n)
#pragma unroll
            for (int i = 0; i < 4; ++i) inv[n][i] = exp2f(-(float)(8 * fq + 4 * n + i) * (13.287712379549449f / 32.0f)) * 0.15915494309189535f;
        float posf[8];
#pragma unroll
        for (int g = 0; g < 8; ++g) posf[g] = rope ? (float)pos[row0 + (g >> 2) * 128 + (g & 3) * 16] : 0.f;
#pragma unroll
        for (int ai = 0; ai < 2; ++ai)
#pragma unroll
            for (int m = 0; m < 4; ++m) {
                const int row = row0 + ai * 128 + m * 16;
                f32x4 v[2][2];
#pragma unroll
                for (int bj = 0; bj < 2; ++bj)
#pragma unroll
                    for (int n = 0; n < 2; ++n) v[bj][n] = acc[ai][bj][m][n];
                if (nw) {
                    float ss = 0.f;
#pragma unroll
                    for (int bj = 0; bj < 2; ++bj)
#pragma unroll
                        for (int n = 0; n < 2; ++n) ss += (v[bj][n][0] * v[bj][n][0] + v[bj][n][1] * v[bj][n][1]) + (v[bj][n][2] * v[bj][n][2] + v[bj][n][3] * v[bj][n][3]);
                    ss += __shfl_xor(ss, 16); ss += __shfl_xor(ss, 32);
                    const float rstd = rsqrtf(ss * (1.0f / 64.0f) + EPS);
#pragma unroll
                    for (int bj = 0; bj < 2; ++bj)
#pragma unroll
                        for (int n = 0; n < 2; ++n) v[bj][n] = v[bj][n] * rstd * wv[bj][n];
                }
                if (rope) {
                    const float p = posf[ai * 4 + m];
#pragma unroll
                    for (int n = 0; n < 2; ++n)
#pragma unroll
                        for (int i = 0; i < 4; ++i) { float rev = p * inv[n][i]; rev = rev - floorf(rev); const float sn = __builtin_amdgcn_sinf(rev), cs = __builtin_amdgcn_cosf(rev);
                            const float x1 = v[0][n][i], x2 = v[1][n][i]; v[0][n][i] = x1 * cs - x2 * sn; v[1][n][i] = x2 * cs + x1 * sn; }
                }
                bf16_t* rowp = dst + (size_t)row * pitch + hcol + 8 * fq;
                *(u32x4*)(rowp) = pack8(v[0][0], v[0][1]);
                *(u32x4*)(rowp + 32) = pack8(v[1][0], v[1][1]);
            }
    }
};

struct EpiMerge {
    static constexpr bool PAIR_KEEP = (P3B_FP8 != 0);
    const unsigned char* GT; bf16_t* MG; unsigned char* MG8;
    __device__ __forceinline__ void rescale(f32x4 (&acc)[2][2][4][2], const Unit& u, int wr, int wc, int fr, int fq) const {
        const int row0 = u.pm * 256 + wr * 64 + fr, colw = u.pn * 256 + wc * 64 + 16 * fq;
#pragma unroll
        for (int hf = 0; hf < 2; ++hf) {
            u32x4 ga16[4], gb16[4];
#pragma unroll
            for (int m = 0; m < 4; ++m) { const unsigned char* p = GT + (size_t)(row0 + hf * 128 + m * 16) * 2048 + colw; ga16[m] = *(const u32x4*)p; gb16[m] = *(const u32x4*)(p + 1024); }
#pragma unroll
            for (int m = 0; m < 4; ++m)
#pragma unroll
                for (int bj = 0; bj < 2; ++bj)
#pragma unroll
                    for (int n = 0; n < 2; ++n) { const unsigned ga = ga16[m][2 * bj + n], gb = gb16[m][2 * bj + n];
#pragma unroll
                        for (int i = 0; i < 4; ++i) acc[hf][bj][m][n][i] *= (float)((ga >> (8 * i)) & 255u) * __builtin_amdgcn_rcpf(fmaxf((float)((gb >> (8 * i)) & 255u), 0.5f)); }
            __builtin_amdgcn_sched_barrier(0);
        }
    }
    __device__ __forceinline__ void operator()(const f32x4 (&acc)[2][2][4][2], const Unit& u, int wr, int wc, int fr, int fq) const {
        const int row0 = u.pm * 256 + wr * 64 + fr, col0 = u.pn * 256 + wc * 32 + 8 * fq, part = u.e;
        if constexpr (PAIR_KEEP) {
            const int colw = u.pn * 256 + wc * 64 + 16 * fq;
            u32x4 gb16[8];
#pragma unroll
            for (int g = 0; g < 8; ++g) gb16[g] = *(const u32x4*)(GT + (size_t)(row0 + (g >> 2) * 128 + (g & 3) * 16) * 2048 + 1024 + colw);
            asm volatile("" ::: "memory");
#pragma unroll
            for (int g = 0; g < 8; ++g) { float f[16];
#pragma unroll
                for (int bj = 0; bj < 2; ++bj)
#pragma unroll
                    for (int n = 0; n < 2; ++n) { const unsigned gb = gb16[g][2 * bj + n]; const f32x4 v = acc[g >> 2][bj][g & 3][n];
#pragma unroll
                        for (int i = 0; i < 4; ++i) f[8 * bj + 4 * n + i] = v[i] * (fmaxf((float)((gb >> (8 * i)) & 255u), 0.5f) * (32.0f / 255.0f)); }
                u32x4 w8; w8.x = pk4_fp8(f[0], f[1], f[2], f[3]); w8.y = pk4_fp8(f[4], f[5], f[6], f[7]); w8.z = pk4_fp8(f[8], f[9], f[10], f[11]); w8.w = pk4_fp8(f[12], f[13], f[14], f[15]);
                *(u32x4*)(MG8 + (size_t)(row0 + (g >> 2) * 128 + (g & 3) * 16) * 1024 + colw) = w8; }
            return;
        }
        u32x2 g8[8][2]; u32x4 mg[8][2];
#define EM_ROW(g) (row0 + ((g) >> 2) * 128 + ((g) & 3) * 16)
#define EM_LDMG(g) do { _Pragma("unroll") for (int bj = 0; bj < 2; ++bj) mg[g][bj] = part ? *(const u32x4*)(MG + (size_t)EM_ROW(g) * 1024 + col0 + bj * 128) : (u32x4){0u, 0u, 0u, 0u}; } while (0)
#pragma unroll
        for (int g = 0; g < 8; ++g)
#pragma unroll
            for (int bj = 0; bj < 2; ++bj) g8[g][bj] = *(const u32x2*)(GT + (size_t)EM_ROW(g) * 2048 + part * 1024 + col0 + bj * 128);
        EM_LDMG(0); EM_LDMG(1);
        asm volatile("" ::: "memory");
#pragma unroll
        for (int g = 0; g < 8; ++g) {
            u32x4 ov[2];
#pragma unroll
            for (int bj = 0; bj < 2; ++bj) { const unsigned ga = g8[g][bj].x, gb = g8[g][bj].y; float o[8]; unpack8(mg[g][bj], o);
                f32x4 v0 = acc[g >> 2][bj][g & 3][0], v1 = acc[g >> 2][bj][g & 3][1];
#pragma unroll
                for (int i = 0; i < 4; ++i) { v0[i] = v0[i] * ((float)((ga >> (8 * i)) & 255u) * (1.0f / 255.0f)) + o[i]; v1[i] = v1[i] * ((float)((gb >> (8 * i)) & 255u) * (1.0f / 255.0f)) + o[4 + i]; }
                ov[bj] = pack8(v0, v1); }
            if (g + 2 < 8) { EM_LDMG(g + 2); }
            asm volatile("" ::: "memory");
#pragma unroll
            for (int bj = 0; bj < 2; ++bj) {
                if (P3B_FP8 && part) { float f[8]; unpack8(ov[bj], f); u32x2 w8; w8.x = pk4_fp8(f[0] * 32.0f, f[1] * 32.0f, f[2] * 32.0f, f[3] * 32.0f); w8.y = pk4_fp8(f[4] * 32.0f, f[5] * 32.0f, f[6] * 32.0f, f[7] * 32.0f);
                    *(u32x2*)(MG8 + (size_t)EM_ROW(g) * 1024 + col0 + bj * 128) = w8; }
                else *(u32x4*)(MG + (size_t)EM_ROW(g) * 1024 + col0 + bj * 128) = ov[bj]; }
            asm volatile("" ::: "memory");
        }
#undef EM_ROW
#undef EM_LDMG
    }
};

struct EpiResid {
    static constexpr bool PAIR_KEEP = false;
    const float* X; bf16_t* O; const bf16_t* XN; const float* RMS; const float* G1; bool rec;
    __device__ __forceinline__ void operator()(const f32x4 (&acc)[2][2][4][2], const Unit& u, int wr, int wc, int fr, int fq) const {
        const int row0 = u.pm * 256 + wr * 64 + fr, col0 = u.pn * 256 + wc * 32 + 8 * fq;
#define ER_OFF(g) ((size_t)(row0 + ((g) >> 2) * 128 + ((g) & 3) * 16) * 1024 + col0)
        if (XREC != 0 && rec) {
            u32x4 xn[8][2]; float rm[8]; f32x4 ig[2][2];
#define XR_LD(g) do { rm[g] = RMS[row0 + ((g) >> 2) * 128 + ((g) & 3) * 16]; _Pragma("unroll") for (int bj = 0; bj < 2; ++bj) xn[g][bj] = *(const u32x4*)(XN + ER_OFF(g) + bj * 128); } while (0)
#pragma unroll
            for (int bj = 0; bj < 2; ++bj)
#pragma unroll
                for (int n = 0; n < 2; ++n) { const f32x4 gg = *(const f32x4*)(G1 + col0 + bj * 128 + 4 * n);
#pragma unroll
                    for (int i = 0; i < 4; ++i) ig[bj][n][i] = __builtin_amdgcn_rcpf(gg[i]); }
            XR_LD(0); XR_LD(1); XR_LD(2);
            asm volatile("" ::: "memory");
#pragma unroll
            for (int g = 0; g < 8; ++g) {
                u32x4 ov[2];
#pragma unroll
                for (int bj = 0; bj < 2; ++bj) { float f[8]; unpack8(xn[g][bj], f); f32x4 v0, v1;
#pragma unroll
                    for (int i = 0; i < 4; ++i) { v0[i] = __builtin_fmaf(f[i] * rm[g], ig[bj][0][i], acc[g >> 2][bj][g & 3][0][i]); v1[i] = __builtin_fmaf(f[4 + i] * rm[g], ig[bj][1][i], acc[g >> 2][bj][g & 3][1][i]); }
                    ov[bj] = pack8(v0, v1); }
                if (g + 3 < 8) { XR_LD(g + 3); }
                asm volatile("" ::: "memory");
#pragma unroll
                for (int bj = 0; bj < 2; ++bj) *(u32x4*)(O + ER_OFF(g) + bj * 128) = ov[bj];
                asm volatile("" ::: "memory");
            }
#undef XR_LD
        } else {
        f32x4 xr[8][2][2];
#define ER_LD(g) do { _Pragma("unroll") for (int bj = 0; bj < 2; ++bj) _Pragma("unroll") for (int n = 0; n < 2; ++n) xr[g][bj][n] = *(const f32x4*)(X + ER_OFF(g) + bj * 128 + n * 4); } while (0)
        ER_LD(0); ER_LD(1); ER_LD(2);
        asm volatile("" ::: "memory");
#pragma unroll
        for (int g = 0; g < 8; ++g) {
            u32x4 ov[2];
#pragma unroll
            for (int bj = 0; bj < 2; ++bj) ov[bj] = pack8(xr[g][bj][0] + acc[g >> 2][bj][g & 3][0], xr[g][bj][1] + acc[g >> 2][bj][g & 3][1]);
            if (g + 3 < 8) { ER_LD(g + 3); }
            asm volatile("" ::: "memory");
#pragma unroll
            for (int bj = 0; bj < 2; ++bj) *(u32x4*)(O + ER_OFF(g) + bj * 128) = ov[bj];
            asm volatile("" ::: "memory");
        }
#undef ER_LD
        }
#undef ER_OFF
    }
};

struct EpiSwiglu {
    static constexpr bool PAIR_KEEP = false;
    const float* bgu; unsigned char* ACT;
    __device__ __forceinline__ void operator()(const f32x4 (&acc)[2][2][4][2], const Unit& u, int wr, int wc, int fr, int fq) const {
        const int row0 = u.pm * 256 + wr * 64 + fr, f0 = u.pn * 128 + wc * 32 + 8 * fq; const float* be = bgu + (size_t)u.e * 2048;
        f32x4 bg[2], bu[2];
#pragma unroll
        for (int n = 0; n < 2; ++n) { bg[n] = *(const f32x4*)(be + f0 + 4 * n); bu[n] = *(const f32x4*)(be + 1024 + f0 + 4 * n) + 1.0f; }
#pragma unroll
        for (int ai = 0; ai < 2; ++ai)
#pragma unroll
            for (int m = 0; m < 4; ++m) { f32x4 o[2];
#pragma unroll
                for (int n = 0; n < 2; ++n) { const f32x4 g = acc[ai][0][m][n] + bg[n], uu = acc[ai][1][m][n] + bu[n];
#pragma unroll
                    for (int i = 0; i < 4; ++i) { const float gc = fminf(g[i], 7.0f), up = __builtin_amdgcn_fmed3f(uu[i], -6.0f, 8.0f);
                        o[n][i] = up * (gc * __builtin_amdgcn_rcpf(1.0f + __builtin_amdgcn_exp2f(gc * (-1.702f * LOG2E)))); } }
                u32x2 w; w.x = pk4_fp8_nc(o[0][0], o[0][1], o[0][2], o[0][3]); w.y = pk4_fp8_nc(o[1][0], o[1][1], o[1][2], o[1][3]); *(u32x2*)(ACT + (size_t)(row0 + ai * 128 + m * 16) * 1024 + f0) = w; }
    }
};

struct EpiDown {
    static constexpr bool PAIR_KEEP = false;
    const float* bd; unsigned char* YB;
    __device__ __forceinline__ void operator()(const f32x4 (&acc)[2][2][4][2], const Unit& u, int wr, int wc, int fr, int fq) const {
        const int row0 = u.pm * 256 + wr * 64 + fr, col0 = u.pn * 256 + wc * 64 + 16 * fq; const float* be = bd + (size_t)u.e * 1024;
        f32x4 bv[2][2];
#pragma unroll
        for (int bj = 0; bj < 2; ++bj)
#pragma unroll
            for (int n = 0; n < 2; ++n) bv[bj][n] = *(const f32x4*)(be + col0 + bj * 8 + 4 * n);
#pragma unroll
        for (int ai = 0; ai < 2; ++ai)
#pragma unroll
            for (int m = 0; m < 4; ++m) { u32x4 w;
                { const f32x4 v0 = acc[ai][0][m][0] + bv[0][0], v1 = acc[ai][0][m][1] + bv[0][1]; w.x = pk4_fp8(v0[0], v0[1], v0[2], v0[3]); w.y = pk4_fp8(v1[0], v1[1], v1[2], v1[3]); }
                { const f32x4 v0 = acc[ai][1][m][0] + bv[1][0], v1 = acc[ai][1][m][1] + bv[1][1]; w.z = pk4_fp8(v0[0], v0[1], v0[2], v0[3]); w.w = pk4_fp8(v1[0], v1[1], v1[2], v1[3]); }
                *(u32x4*)(YB + (size_t)(row0 + ai * 128 + m * 16) * 1024 + col0) = w; }
    }
};
}

namespace attn_body {
using bf16 = __hip_bfloat16;
constexpr int QP = 512;
constexpr int NW = 8, QBLK = 32, QB = QBLK * NW, KVBLK = 64;
constexpr float NEGV = -1.0e30f;
__device__ __forceinline__ int crow(int r, int hi) { return (r & 3) + 8 * (r >> 2) + 4 * hi; }
#define SBAR() __builtin_amdgcn_sched_barrier(0)
__device__ __forceinline__ void cmask(f32x16& p0, f32x16& p1, int jb, int qrel, int hi) {
    int d = qrel - (64 * jb + 4 * hi); asm volatile("" : "+v"(d));
#pragma unroll
    for (int r = 0; r < 16; ++r) { const int c = (r & 3) + 8 * (r >> 2); if (d < c) p0[r] = NEGV; if (d < c + 32) p1[r] = NEGV; }
}
__device__ __forceinline__ void wmask(f32x16& p0, f32x16& p1, int jb, int qrel, int hi) {
    int d = qrel - (64 * jb + 4 * hi); asm volatile("" : "+v"(d));
#pragma unroll
    for (int r = 0; r < 16; ++r) { const int c = (r & 3) + 8 * (r >> 2); if ((unsigned)(d - c) > 127u) p0[r] = NEGV; if ((unsigned)(d - c - 32) > 127u) p1[r] = NEGV; }
}
constexpr int NSLOT = 3, SLOTB = 8192;
constexpr int LDS_K = 0, LDS_V = NSLOT * SLOTB, LDS_WS = 2 * NSLOT * SLOTB, LDS_OST = LDS_WS + NW * 64 * 4, LDS_NCS = LDS_OST + NW * 4096, LDS_BYTES = LDS_NCS + SEQ * 4;
__device__ __forceinline__ void glds16(const void* gsrc, unsigned lds_dst) { unsigned keep;
    asm volatile("s_mov_b32 %0, m0\n\ts_mov_b32 m0, %2\n\ts_nop 0\n\tglobal_load_lds_dwordx4 %1, off\n\ts_mov_b32 m0, %0" : "=&s"(keep) : "v"(gsrc), "s"(lds_dst) : "memory"); }
#define WAIT_BAR(N) asm volatile("s_waitcnt vmcnt(" #N ") lgkmcnt(0)\n\ts_barrier" ::: "memory")
typedef LAS const char* lds_cptr;
typedef short v4i16_t __attribute__((ext_vector_type(4)));
__device__ __forceinline__ void kload8(bf16x8* kf, lds_cptr kp) {
    kf[0] = *(const LAS bf16x8*)(kp);        kf[1] = *(const LAS bf16x8*)(kp + 512);
    kf[2] = *(const LAS bf16x8*)(kp + 2048); kf[3] = *(const LAS bf16x8*)(kp + 2560);
    kf[4] = *(const LAS bf16x8*)(kp + 4096); kf[5] = *(const LAS bf16x8*)(kp + 4608);
    kf[6] = *(const LAS bf16x8*)(kp + 6144); kf[7] = *(const LAS bf16x8*)(kp + 6656);
}
__device__ __forceinline__ void kload2(bf16x8* kf, lds_cptr kp, int j) { kf[2 * j] = *(const LAS bf16x8*)(kp + j * 2048); kf[2 * j + 1] = *(const LAS bf16x8*)(kp + j * 2048 + 512); }
__device__ __forceinline__ s16x4 vtr(lds_cptr p) { return __builtin_bit_cast(s16x4, __builtin_amdgcn_ds_read_tr16_b64_v4i16((LAS v4i16_t*)p)); }
#define MX3(a, b, c) __builtin_fmaxf(__builtin_fmaxf((a), (b)), (c))
__device__ __forceinline__ float rowmax(const f32x16& p0, const f32x16& p1) {
    float a = MX3(p0[0], p0[1], p1[0]), b = MX3(p0[2], p0[3], p1[1]); a = MX3(a, p1[2], p1[3]);
#pragma unroll
    for (int r = 4; r < 16; r += 4) { a = MX3(a, p0[r], p0[r + 1]); b = MX3(b, p0[r + 2], p0[r + 3]); a = MX3(a, p1[r], p1[r + 1]); b = MX3(b, p1[r + 2], p1[r + 3]); }
    const float m = __builtin_fmaxf(a, b); auto rr = __builtin_amdgcn_permlane32_swap(__float_as_uint(m), __float_as_uint(m), false, false);
    return __builtin_fmaxf(__uint_as_float(rr[0]), __uint_as_float(rr[1]));
}
__device__ __forceinline__ void cinit_half(f32x16& c, float rowt, const LAS float* nc) {
#pragma unroll
    for (int g = 0; g < 4; ++g) { const f32x4 a = *(const LAS f32x4*)(nc + 8 * g);
#pragma unroll
        for (int j = 0; j < 4; ++j) c[4 * g + j] = rowt + a[j]; }
}
__device__ __forceinline__ void pv(f32x16* o, int vb, bf16x8 pa0, bf16x8 pa1, bf16x8 pa2, bf16x8 pa3) {
#pragma unroll
    for (int d0 = 0; d0 < 2; ++d0) { s16x4 lo[4], hi[4];
#pragma unroll
        for (int ks = 0; ks < 4; ++ks) {
            asm volatile("ds_read_b64_tr_b16 %0,%1 offset:%c2" : "=&v"(lo[ks]) : "v"(vb), "i"(d0 * 4096 + ks * 1024) : "memory");
            asm volatile("ds_read_b64_tr_b16 %0,%1 offset:%c2" : "=&v"(hi[ks]) : "v"(vb), "i"(d0 * 4096 + ks * 1024 + 512) : "memory"); }
        asm volatile("s_waitcnt lgkmcnt(0)" ::: "memory"); SBAR();
#define PK(k) (bf16x8){lo[k][0], lo[k][1], lo[k][2], lo[k][3], hi[k][0], hi[k][1], hi[k][2], hi[k][3]}
        o[d0] = __builtin_amdgcn_mfma_f32_32x32x16_bf16(pa0, PK(0), o[d0], 0, 0, 0);
        o[d0] = __builtin_amdgcn_mfma_f32_32x32x16_bf16(pa1, PK(1), o[d0], 0, 0, 0);
        o[d0] = __builtin_amdgcn_mfma_f32_32x32x16_bf16(pa2, PK(2), o[d0], 0, 0, 0);
        o[d0] = __builtin_amdgcn_mfma_f32_32x32x16_bf16(pa3, PK(3), o[d0], 0, 0, 0);
#undef PK
    }
}

struct NextU { const bf16* Kh; const bf16* Vh; const float* ncsg; int KP, t0, qb; };
__device__ __forceinline__ void prime_unit(const bf16* Kh, const bf16* Vh, const int KP, const int t0, const float* ncsg, const int qb, const unsigned lds0, const int lane, const int wid) {
    const bf16* ksrc = Kh + (long)(t0 * KVBLK + lane) * KP + wid * 8;
    const bf16* vsrc = Vh + (long)(t0 * KVBLK + 16 * (wid & 3) + (lane >> 2)) * KP + (wid >> 2) * 32 + (lane & 3) * 8;
    const unsigned kdst = lds0 + LDS_K + wid * 1024, vdst = lds0 + LDS_V + wid * 1024;
    glds16(ksrc, (unsigned)__builtin_amdgcn_readfirstlane(kdst)); glds16(vsrc, (unsigned)__builtin_amdgcn_readfirstlane(vdst)); glds16(ksrc + (long)KVBLK * KP, (unsigned)__builtin_amdgcn_readfirstlane(kdst + SLOTB));
    if (ncsg != nullptr) for (int i = (t0 >> 2) + wid; i <= qb; i += NW) glds16((const char*)ncsg + i * 1024 + lane * 16, (unsigned)__builtin_amdgcn_readfirstlane(lds0 + LDS_NCS + i * 1024));
}
struct P2Dec {
    const bf16 *KF, *VF, *KA, *VA; const float* NCS; const LAS int* ordl;
    static constexpr int QPOS = 2048 + 1536;
    __device__ __forceinline__ static int unit_of(int p) {
        if (p < 256) return p;
        if (p < 2048) { const int q = p - 256, g = q / 7, r = q - 7 * g; return (r == 0 || r == 2 || r == 4) ? 256 + 3 * g + (r >> 1) : -1; }
        const int q = p - 2048, pq = q / 3, pr = q - 3 * pq; return pr == 2 ? -1 : 1024 + 2 * pq + pr; }
    __device__ __forceinline__ static int chunk_of(int p) { if (p < 2048) { const int q = p - 256, g = q / 7, r = q - 7 * g; return 4 * g + (r == 6 ? 3 : (r >> 1)); } return 1024 + (p - 2048) / 3; }
    __device__ __forceinline__ NextU next(int p) const {
        NextU nx; nx.Kh = nullptr; nx.Vh = nullptr; nx.ncsg = nullptr; nx.KP = 0; nx.t0 = 0; nx.qb = 0;
        if (p >= QPOS) return nx;
        const int idx = unit_of(p);
        if (idx < 0) return nx;
        if (idx < 1024) { const int od = __builtin_amdgcn_readfirstlane(ordl[idx]), u = od & 0xffff, bh = u >> 5, b = bh >> 3, h = bh & 7;
            nx.Kh = KF + (size_t)b * SEQ * 512 + h * 64; nx.Vh = VF + (size_t)b * SEQ * 512 + h * 64; nx.ncsg = NCS + (size_t)bh * SEQ; nx.KP = 512; nx.t0 = od >> 16; nx.qb = u & 31; }
        else { const int u = idx - 1024, bk = u >> 7, qb = 127 - (u & 127), b = bk >> 1, kvh = bk & 1;
            nx.Kh = KA + (size_t)b * SEQ * 128 + kvh * 64; nx.Vh = VA + (size_t)b * SEQ * 128 + kvh * 64; nx.KP = 128; nx.t0 = qb < 2 ? 0 : qb - 2; nx.qb = qb; }
        return nx; }
};
template <int MODE, int THRL, bool TRK> __device__ __forceinline__ void attn_unit(int qb, int t0f, const bf16* Qh, const bf16* __restrict__ Kh, const bf16* __restrict__ Vh, bf16* Oh, const int KP, const float sinkl2, char* shm, const float* ncsg, const bool primed, const NextU nx1, const int pos1, const P2Dec& dec, volatile LAS int* qslot, const int qval, int& pos2, int& primed_pos) {
    const int tid = opaque_tid(), lane = tid & 63, r32 = lane & 31, hi = lane >> 5; const int wid = __builtin_amdgcn_readfirstlane(tid >> 6);
    const int q0 = MODE == 1 ? qb * 64 : qb * QB;
    const int t0 = (MODE == 1) ? (qb < 2 ? 0 : qb - 2) : t0f;
    const int NT = MODE == 1 ? 3 : (q0 + QB) / KVBLK - t0;
    const int wrow = MODE == 1 ? (wid & 1) * QBLK : wid * QBLK, wcol = MODE == 1 ? (wid >> 1) * 64 : 0;
    const int jdiag = MODE == 1 ? qb - t0 : NT - 4;
    const bf16* Qw = Qh + (long)(q0 + wrow) * QP + wcol;
    const unsigned lds0 = (unsigned)(uintptr_t)shm;
    float* wsf = (float*)(shm + LDS_WS) + wid * 64;
    const bf16* ksrc = Kh + (long)(t0 * KVBLK + lane) * KP + wid * 8;
    const bf16* vsrc = Vh + (long)(t0 * KVBLK + 16 * (wid & 3) + (lane >> 2)) * KP + (wid >> 2) * 32 + (lane & 3) * 8;
    const unsigned kdst = lds0 + LDS_K + wid * 1024, vdst = lds0 + LDS_V + wid * 1024;
    const long tstride = (long)KVBLK * KP;
#define DMA_K(t, slot) glds16(ksrc + (long)(t) * tstride, (unsigned)__builtin_amdgcn_readfirstlane(kdst + (slot)))
#define DMA_V(t, slot) glds16(vsrc + (long)(t) * tstride, (unsigned)__builtin_amdgcn_readfirstlane(vdst + (slot)))
    const int vb0 = (int)(lds0 + LDS_V) + ((lane >> 4) & 1) * 32 + (lane & 3) * 8 + (4 * hi + ((lane & 15) >> 2)) * 64;
    const char* Kbase = shm + LDS_K; bf16x8 kf[8];
    const lds_cptr shm3 = (lds_cptr)shm; const lds_cptr kp0 = shm3 + LDS_K + hi * 1024 + r32 * 16; const lds_cptr vp0 = shm3 + LDS_V + ((lane >> 4) & 1) * 32 + (lane & 3) * 8 + (4 * hi + ((lane & 15) >> 2)) * 64;
    const LAS float* ncs = (const LAS float*)(shm3 + LDS_NCS) + t0 * 64 + 4 * hi;
    if (!primed) prime_unit(Kh, Vh, KP, t0, MODE == 0 ? ncsg : nullptr, qb, lds0, lane, wid);
    bf16x8 qr[4]; float mhat;
    { bf16x8 kd[4];
#pragma unroll
      for (int d0 = 0; d0 < 4; ++d0) { qr[d0] = *reinterpret_cast<const bf16x8*>(&Qw[(long)r32 * QP + d0 * 16 + hi * 8]); kd[d0] = *reinterpret_cast<const bf16x8*>(&Kh[(long)(q0 + wrow + r32) * KP + d0 * 16 + hi * 8]); }
      float dg = 0.f;
#pragma unroll
      for (int d0 = 0; d0 < 4; ++d0)
#pragma unroll
          for (int j = 0; j < 8; ++j) dg += bf2f(qr[d0][j]) * bf2f(kd[d0][j]);
      auto rr = __builtin_amdgcn_permlane32_swap(__float_as_uint(dg), __float_as_uint(dg), false, false);
      mhat = __uint_as_float(rr[0]) + __uint_as_float(rr[1]); }
    float rowt = -mhat;
#define CI0(C, t) do { if constexpr (MODE == 0) { cinit_half(C, rowt, ncs + (t) * 64); } else { _Pragma("unroll") for (int r = 0; r < 16; ++r) C[r] = rowt; } } while (0)
#define CI1(C, t) do { if constexpr (MODE == 0) { cinit_half(C, rowt, ncs + (t) * 64 + 32); } else { _Pragma("unroll") for (int r = 0; r < 16; ++r) C[r] = rowt; } } while (0)
#define CSRC(C) (C)
#define NEWREF() do { rowt -= dl; } while (0)
    float l_reg = 0.f; f32x16 o[2]; o[0] = f32x16{}; o[1] = f32x16{};
    const int qrel = wrow + r32;
#define CMASK(P0, P1, t) do { const int jb_ = (t) - jdiag; if (MODE == 1) wmask(P0, P1, jb_, qrel, hi); else if (jb_ >= 0) cmask(P0, P1, jb_, qrel, hi); } while (0)
    bool resc = false;
#define RESC() do { if constexpr (TRK) if (resc) { asm volatile("s_waitcnt lgkmcnt(0)" ::: "memory"); \
      _Pragma("unroll") for (int d_ = 0; d_ < 2; ++d_) _Pragma("unroll") for (int r = 0; r < 16; ++r) o[d_][r] *= wsf[crow(r, hi)]; } } while (0)
    f32x16 pA0, pA1, pB0, pB1;
    int sl_prev = 0, sl_cur = 0, sl_next = SLOTB;
#define ROT() do { sl_prev = sl_cur; sl_cur = sl_next; sl_next = (sl_next == (NSLOT - 1) * SLOTB) ? 0 : sl_next + SLOTB; } while (0)
    DMA_K(2, 2 * SLOTB);
    WAIT_BAR(3);
    if constexpr (MODE == 0) rowt -= ((const LAS float*)(shm3 + LDS_NCS))[q0 + wid * QBLK + r32];
    CI0(pA0, 0); CI1(pA1, 0);
    { const char* kb = Kbase + hi * 1024 + r32 * 16;
#pragma unroll
      for (int d0 = 0; d0 < 4; ++d0) {
          const bf16x8 b0 = *reinterpret_cast<const bf16x8*>(kb + d0 * 2048);
          const bf16x8 b1 = *reinterpret_cast<const bf16x8*>(kb + d0 * 2048 + 512);
          if (d0 == 0) { pA0 = __builtin_amdgcn_mfma_f32_32x32x16_bf16(b0, qr[0], CSRC(pA0), 0, 0, 0); pA1 = __builtin_amdgcn_mfma_f32_32x32x16_bf16(b1, qr[0], CSRC(pA1), 0, 0, 0); }
          else { pA0 = __builtin_amdgcn_mfma_f32_32x32x16_bf16(b0, qr[d0], pA0, 0, 0, 0); pA1 = __builtin_amdgcn_mfma_f32_32x32x16_bf16(b1, qr[d0], pA1, 0, 0, 0); } } }
    CMASK(pA0, pA1, 0);
    if constexpr (TRK) { const float rm = rowmax(pA0, pA1);
      if (__builtin_expect(__any(rm > (float)THRL), 0)) { const float dl = __builtin_fmaxf(rm, 0.f); mhat += dl; NEWREF();
          _Pragma("unroll") for (int r = 0; r < 16; ++r) { pA0[r] -= dl; pA1[r] -= dl; } } }
    _Pragma("unroll") for (int r = 0; r < 16; ++r) pA0[r] = __builtin_amdgcn_exp2f(pA0[r]);
    _Pragma("unroll") for (int r = 0; r < 16; ++r) pA1[r] = __builtin_amdgcn_exp2f(pA1[r]);
    WAIT_BAR(0);
    if constexpr (MODE != 1) DMA_K(3, 0);
    DMA_V(1, SLOTB);
    ROT();
    kload8(kf, kp0 + sl_cur);
    WAIT_BAR(2);
    s16x4 vlo[8], vhi[8]; u32x4 pw0, pw1, pw2, pw3;
#define PKW(P, B) cvt_pk_bf16(P[B], P[B + 1])
#define PAF(k) __builtin_bit_cast(bf16x8, pw##k)
#define VFR(i) (bf16x8){vlo[i][0], vlo[i][1], vlo[i][2], vlo[i][3], vhi[i][0], vhi[i][1], vhi[i][2], vhi[i][3]}
#define PIN(x) asm volatile("" : "+v"(x))
#define GAPA(MF, A0, A1, A2, A3, W0, W1, PW) do { MF; sacc += A0; sacc += A1; sacc += A2; sacc += A3; PIN(sacc); W0; W1; PIN(PW); SBAR(); } while (0)
#define EX(v) __builtin_amdgcn_exp2f(v)
#define GAPB(MF, X, B) do { MF; X[B] = EX(X[B]); X[B + 1] = EX(X[B + 1]); X[B + 2] = EX(X[B + 2]); X[B + 3] = EX(X[B + 3]); PIN(X); SBAR(); } while (0)
#define VRD(i) do { vlo[i] = vtr(vp_ + (((i) >> 2) * 4096 + ((i) & 3) * 1024)); vhi[i] = vtr(vp_ + (((i) >> 2) * 4096 + ((i) & 3) * 1024 + 512)); } while (0)
#define KRD(G, j) do { if (G) { kload2(kf, kp0 + sl_next, j); SBAR(); } } while (0)
#define STEP(C0, C1, P0, P1, t, GK, GV, GL) do { SBAR(); \
    const lds_cptr vp_ = vp0 + sl_prev; \
    CI0(C0, t); VRD(0); SBAR(); float sacc = (P0[0] + P0[1]); \
    GAPA(C0 = __builtin_amdgcn_mfma_f32_32x32x16_bf16(kf[0], qr[0], CSRC(C0), 0, 0, 0), P0[2], P0[3], P0[4], P0[5],     pw0[0] = PKW(P0, 0), pw0[1] = PKW(P0, 2), pw0); \
    CI1(C1, t); VRD(4); SBAR(); GAPA(C1 = __builtin_amdgcn_mfma_f32_32x32x16_bf16(kf[1], qr[0], CSRC(C1), 0, 0, 0), P0[6], P0[7], P0[8], P0[9],     pw0[2] = PKW(P0, 4), pw0[3] = PKW(P0, 6), pw0); \
    VRD(1); SBAR(); GAPA(C0 = __builtin_amdgcn_mfma_f32_32x32x16_bf16(kf[2], qr[1], C0, 0, 0, 0),   P0[10], P0[11], P0[12], P0[13], pw1[0] = PKW(P0, 8), pw1[1] = PKW(P0, 10), pw1); \
    VRD(5); SBAR(); GAPA(C1 = __builtin_amdgcn_mfma_f32_32x32x16_bf16(kf[3], qr[1], C1, 0, 0, 0),   P0[14], P0[15], P1[0], P1[1],   pw1[2] = PKW(P0, 12), pw1[3] = PKW(P0, 14), pw1); \
    VRD(2); SBAR(); GAPA(C0 = __builtin_amdgcn_mfma_f32_32x32x16_bf16(kf[4], qr[2], C0, 0, 0, 0),   P1[2], P1[3], P1[4], P1[5],     pw2[0] = PKW(P1, 0), pw2[1] = PKW(P1, 2), pw2); \
    VRD(6); SBAR(); GAPA(C1 = __builtin_amdgcn_mfma_f32_32x32x16_bf16(kf[5], qr[2], C1, 0, 0, 0),   P1[6], P1[7], P1[8], P1[9],     pw2[2] = PKW(P1, 4), pw2[3] = PKW(P1, 6), pw2); \
    VRD(3); SBAR(); GAPA(C0 = __builtin_amdgcn_mfma_f32_32x32x16_bf16(kf[6], qr[3], C0, 0, 0, 0),   P1[10], P1[11], P1[12], P1[13], pw3[0] = PKW(P1, 8), pw3[1] = PKW(P1, 10), pw3); \
    VRD(7); SBAR(); GAPA(C1 = __builtin_amdgcn_mfma_f32_32x32x16_bf16(kf[7], qr[3], C1, 0, 0, 0),   P1[14], P1[15], 0.f, 0.f,       pw3[2] = PKW(P1, 12), pw3[3] = PKW(P1, 14), pw3); \
    l_reg += sacc; \
    if (GK) { DMA_K((t) + 3, sl_cur); } if (GV) { DMA_V((t) + 1, sl_next); } \
    CMASK(C0, C1, t); \
    if constexpr (TRK) { float a = MX3(C0[0], C0[1], C1[0]), b = MX3(C0[2], C0[3], C1[1]); a = MX3(a, C1[2], C1[3]); \
      _Pragma("unroll") for (int r = 4; r < 16; r += 4) { a = MX3(a, C0[r], C0[r + 1]); b = MX3(b, C0[r + 2], C0[r + 3]); a = MX3(a, C1[r], C1[r + 1]); b = MX3(b, C1[r + 2], C1[r + 3]); } \
      float rm = __builtin_fmaxf(a, b); { auto rr = __builtin_amdgcn_permlane32_swap(__float_as_uint(rm), __float_as_uint(rm), false, false); rm = __builtin_fmaxf(__uint_as_float(rr[0]), __uint_as_float(rr[1])); } \
      resc = false; \
      if (__builtin_expect(__any(rm > (float)THRL), 0)) { const float dl = __builtin_fmaxf(rm, 0.f); mhat += dl; NEWREF(); \
        _Pragma("unroll") for (int r = 0; r < 16; ++r) { C0[r] -= dl; C1[r] -= dl; } \
        const float f = __builtin_amdgcn_exp2f(-dl); l_reg *= f; if (hi == 0) wsf[r32] = f; resc = true; } } \
    SBAR(); \
    GAPB(o[0] = __builtin_amdgcn_mfma_f32_32x32x16_bf16(PAF(0), VFR(0), o[0], 0, 0, 0), C0, 0); \
    GAPB(o[1] = __builtin_amdgcn_mfma_f32_32x32x16_bf16(PAF(0), VFR(4), o[1], 0, 0, 0), C0, 4); \
    KRD(GL, 0); GAPB(o[0] = __builtin_amdgcn_mfma_f32_32x32x16_bf16(PAF(1), VFR(1), o[0], 0, 0, 0), C0, 8); \
    KRD(GL, 1); GAPB(o[1] = __builtin_amdgcn_mfma_f32_32x32x16_bf16(PAF(1), VFR(5), o[1], 0, 0, 0), C0, 12); \
    KRD(GL, 2); GAPB(o[0] = __builtin_amdgcn_mfma_f32_32x32x16_bf16(PAF(2), VFR(2), o[0], 0, 0, 0), C1, 0); \
    KRD(GL, 3); GAPB(o[1] = __builtin_amdgcn_mfma_f32_32x32x16_bf16(PAF(2), VFR(6), o[1], 0, 0, 0), C1, 4); \
    GAPB(o[0] = __builtin_amdgcn_mfma_f32_32x32x16_bf16(PAF(3), VFR(3), o[0], 0, 0, 0), C1, 8); \
    GAPB(o[1] = __builtin_amdgcn_mfma_f32_32x32x16_bf16(PAF(3), VFR(7), o[1], 0, 0, 0), C1, 12); \
    } while (0)
    int t = 1;
    if constexpr (MODE == 0) {
#undef CMASK
#define CMASK(P0, P1, t) do {} while (0)
        for (; t + 5 < NT; t += 2) {
            STEP(pB0, pB1, pA0, pA1, t, true, true, true);     WAIT_BAR(2); RESC(); ROT();
            STEP(pA0, pA1, pB0, pB1, t + 1, true, true, true); WAIT_BAR(2); RESC(); ROT();
        }
#undef CMASK
#define CMASK(P0, P1, t) do { const int jb_ = (t) - jdiag; if (MODE == 1) wmask(P0, P1, jb_, qrel, hi); else if (jb_ >= 0) cmask(P0, P1, jb_, qrel, hi); } while (0)
    }
#define ENDW(tt) do { if ((tt) + 3 < NT) { WAIT_BAR(2); } else if ((tt) + 2 < NT) { WAIT_BAR(1); } else { WAIT_BAR(0); } } while (0)
#define DRAIN(PX0, PX1) do { float sacc = PX0[0] + PX0[1]; _Pragma("unroll") for (int r = 2; r < 16; ++r) sacc += PX0[r]; _Pragma("unroll") for (int r = 0; r < 16; ++r) sacc += PX1[r]; l_reg += sacc; \
      pw0 = (u32x4){PKW(PX0, 0), PKW(PX0, 2), PKW(PX0, 4), PKW(PX0, 6)}; pw1 = (u32x4){PKW(PX0, 8), PKW(PX0, 10), PKW(PX0, 12), PKW(PX0, 14)}; pw2 = (u32x4){PKW(PX1, 0), PKW(PX1, 2), PKW(PX1, 4), PKW(PX1, 6)}; pw3 = (u32x4){PKW(PX1, 8), PKW(PX1, 10), PKW(PX1, 12), PKW(PX1, 14)}; \
      SBAR(); pv(o, vb0 + sl_cur, PAF(0), PAF(1), PAF(2), PAF(3)); } while (0)
    if constexpr (MODE == 1) {
        STEP(pB0, pB1, pA0, pA1, 1, false, true, true);   WAIT_BAR(0); RESC(); ROT();
        STEP(pA0, pA1, pB0, pB1, 2, false, false, false); RESC();
        DRAIN(pA0, pA1);
    } else {
        for (; t + 1 < NT; t += 2) {
            STEP(pB0, pB1, pA0, pA1, t, (t + 3 < NT), (t + 1 < NT), (t + 1 < NT));     ENDW(t);     RESC(); ROT();
            STEP(pA0, pA1, pB0, pB1, t + 1, (t + 4 < NT), (t + 2 < NT), (t + 2 < NT)); ENDW(t + 1); RESC(); ROT();
        }
        STEP(pB0, pB1, pA0, pA1, NT - 1, false, false, false); RESC();
        DRAIN(pB0, pB1);
    }
#undef DRAIN
    if (tid == 0) qslot[0] = qval;
    asm volatile("s_waitcnt lgkmcnt(0)\n\ts_barrier" ::: "memory");
    pos2 = __builtin_amdgcn_readfirstlane(qslot[0]);
    { NextU nx = nx1; int target = pos1;
      if (nx.Kh == nullptr) { nx = dec.next(pos2); target = pos2; }
      primed_pos = -1;
      if (nx.Kh != nullptr) { prime_unit(nx.Kh, nx.Vh, nx.KP, nx.t0, nx.ncsg, nx.qb, lds0, lane, wid); primed_pos = target; } }
#undef PKW
#undef PAF
#undef VFR
#undef PIN
#undef GAPA
#undef GAPB
#undef EX
#undef VRD
#undef KRD
#undef STEP
#undef ENDW
    { auto rr = __builtin_amdgcn_permlane32_swap(__float_as_uint(l_reg), __float_as_uint(l_reg), false, false); l_reg = __uint_as_float(rr[0]) + __uint_as_float(rr[1]); }
    if constexpr (MODE == 1) l_reg += __builtin_amdgcn_exp2f(sinkl2 - mhat);
    if (hi == 0) wsf[32 + r32] = l_reg; asm volatile("s_waitcnt lgkmcnt(0)" ::: "memory");
    float rli[16];
#pragma unroll
    for (int r = 0; r < 16; ++r) rli[r] = __builtin_amdgcn_rcpf(wsf[32 + crow(r, hi)]);
    if constexpr (P3A_FP8 != 0) {
        unsigned char* Ow8 = (unsigned char*)Oh + (long)(q0 + wrow) * 512 + wcol;
        unsigned char* stg8 = (unsigned char*)(shm + LDS_OST) + wid * 4096;
#pragma unroll
        for (int r = 0; r < 16; ++r) { const int orow = crow(r, hi); const float sc = rli[r] * 32.0f;
#pragma unroll
            for (int d0 = 0; d0 < 2; ++d0) stg8[orow * 64 + d0 * 32 + r32] = (unsigned char)(__builtin_amdgcn_cvt_pk_fp8_f32(clamp448(o[d0][r] * sc), 0.f, 0, false) & 0xff); }
        asm volatile("s_waitcnt lgkmcnt(0)" ::: "memory");
#pragma unroll
        for (int i = 0; i < 2; ++i) { const int row = i * 16 + (lane >> 2), ch = lane & 3; const u32x4 v = *(const u32x4*)(stg8 + row * 64 + ch * 16); *(u32x4*)(Ow8 + (long)row * 512 + ch * 16) = v; }
    } else {
    bf16* Ow = Oh + (long)(q0 + wrow) * QP + wcol;
    { bf16* stg = (bf16*)(shm + LDS_OST) + wid * 2048;
#pragma unroll
      for (int r = 0; r < 16; ++r) { const int orow = crow(r, hi);
#pragma unroll
          for (int d0 = 0; d0 < 2; ++d0) stg[orow * 64 + d0 * 32 + r32] = __float2bfloat16(o[d0][r] * rli[r]); }
      asm volatile("s_waitcnt lgkmcnt(0)" ::: "memory");
#pragma unroll
      for (int i = 0; i < 4; ++i) { const int row = i * 8 + (lane >> 3), ch = lane & 7; const u32x4 v = *(const u32x4*)(stg + row * 64 + ch * 8); *(u32x4*)(Ow + (long)row * QP + ch * 8) = v; } }
    }
    asm volatile("s_waitcnt lgkmcnt(0)" ::: "memory");
#undef DMA_K
#undef DMA_V
#undef CMASK
#undef RESC
#undef ROT
#undef CI0
#undef CI1
#undef CSRC
#undef NEWREF
}
#undef SBAR
#undef WAIT_BAR
#undef MX3
}

constexpr int NWAVES = 8;
constexpr int N_PHASES = 9;
constexpr size_t MiB = 1u << 20;
constexpr size_t WS_CTL = 0, CTL_ZERO_BYTES = 64 * 1024;
constexpr size_t WS_LOGF = 2 * MiB;
constexpr size_t WS_NCS = 3 * MiB;
constexpr size_t WS_TOKE = 4 * MiB, WS_TOKR = 4 * MiB + 512 * 1024, WS_TOKG = 5 * MiB;
constexpr size_t WS_TS = 6 * MiB, WS_ORDER = 6 * MiB + 64 * 1024;
constexpr size_t WS_ROWTOK = 8 * MiB;
constexpr size_t WS_WOA = 16 * MiB, WS_WOB = 17 * MiB, WS_WOUT = 18 * MiB, WS_WIN = 20 * MiB;
constexpr size_t WS_WIN8 = 29 * MiB;
constexpr size_t WS_XN8 = 560 * MiB;
constexpr size_t WS_WGU = 32 * MiB, WS_WD = 160 * MiB;
constexpr size_t WS_XN = 224 * MiB;
constexpr size_t WS_QA = 288 * MiB, WS_KA = 320 * MiB, WS_VA = 328 * MiB, WS_QF = 336 * MiB, WS_KF = 368 * MiB, WS_VF = 400 * MiB;
constexpr size_t WS_GT = 432 * MiB, WS_MG = 560 * MiB, WS_OA = 624 * MiB, WS_OB = 656 * MiB;
constexpr size_t WS_ACT = 288 * MiB;
constexpr size_t WS_YB = 560 * MiB;
constexpr size_t WS_X1 = 832 * MiB;
constexpr size_t WS_WOA8 = 12 * MiB, WS_WOB8 = 13 * MiB;
constexpr size_t WS_RMS = 6 * MiB + 256 * 1024;
constexpr size_t WS_WOUT8 = 7 * MiB;
constexpr size_t WS_MG8 = 688 * MiB;
constexpr size_t WS_END = 896 * MiB;
constexpr int CW_CNT = 64;
constexpr int CW_DONE = 128, CW_QCTR = 192;
constexpr int CW_BAR = 1024;
constexpr int MISC_BAR = 8192;
constexpr int RING_BYTES = 131072, MISC_OFF = RING_BYTES, LDS_BYTES = 163840;
constexpr int MISC_TOKL = 12544, TOKL_UNITS = 19;

struct Args { const void* in[21]; float* out; unsigned char* ws; int ph_lo, ph_hi; };

struct Frame { LAS unsigned char* lds; int tid, lane, wave, vcu, G; };

__device__ __forceinline__ float wave_sum(float v) {
#pragma unroll
    for (int o = 1; o < 64; o <<= 1) v += __shfl_xor(v, o);
    return v;
}

__device__ __forceinline__ int rowmap_in(int c) {
    int T, wc, d;
    if (c < 512) { const int hh = c >> 6; T = hh >> 2; wc = hh & 3; d = c & 63; }
    else if (c < 640) { T = 2; wc = (c - 512) >> 6; d = c & 63; }
    else if (c < 768) { T = 2; wc = 2 + ((c - 640) >> 6); d = c & 63; }
    else if (c < COL_FL) { const int cc = c - 768, sect = cc >> 9, hh = (cc & 511) >> 6; T = 3 + 2 * sect + (hh >> 2); wc = hh & 3; d = cc & 63; }
    else if (c < COL_GL) return -1;
    else { const int g = c - COL_GL, gc = g & 255; return 256 * (9 + (g >> 8)) + 128 * ((gc >> 3) & 1) + 32 * ((gc >> 6) & 3) + 16 * ((gc >> 2) & 1) + 4 * ((gc >> 4) & 3) + (gc & 3); }
    return 256 * T + 128 * (d >> 5) + 32 * wc + perm32s(d & 31);
}
__device__ __forceinline__ int rowmap_in16(int c) { const int r = rowmap_in(c); return (!P1_FP8 || r < 7 * 256) ? r : -1; }
__device__ __forceinline__ int rowmap_in8(int c) { const int r = rowmap_in(c); return r >= 7 * 256 ? r - 7 * 256 : -1; }
__device__ __forceinline__ int rowmap_perm(int c) { return (c & ~31) + perm32s(c & 31); }
__device__ __forceinline__ int rowmap_d16(int c) { return (c & ~255) + 128 * ((c >> 3) & 1) + 32 * ((c >> 6) & 3) + 16 * ((c >> 2) & 1) + 4 * ((c >> 4) & 3) + (c & 3); }
__device__ __forceinline__ int rowmap_gu(int c) { const int bj = c >> 10, f = c & 1023; return 256 * (f >> 7) + 128 * bj + 32 * ((f >> 5) & 3) + perm32s(f & 31); }
template <int MAP> __device__ __forceinline__ void transpose_item(const float* W, int K, int N, bf16_t* WT, int kb, int nb, int lane) {
    const int k0 = 64 * kb + 8 * (lane >> 3), n0 = 32 * nb + 4 * (lane & 7);
    if (n0 >= N) return;
    f32x4 v[8];
#pragma unroll
    for (int kk = 0; kk < 8; ++kk) v[kk] = *(const f32x4*)(W + (size_t)(k0 + kk) * N + n0);
#pragma unroll
    for (int j = 0; j < 4; ++j) { const int c = n0 + j; const int row = MAP == 0 ? rowmap_in16(c) : MAP == 1 ? rowmap_perm(c) : MAP == 2 ? c : rowmap_gu(c);
        if (row >= 0) { u32x4 o; o.x = cvt_pk_bf16(v[0][j], v[1][j]); o.y = cvt_pk_bf16(v[2][j], v[3][j]); o.z = cvt_pk_bf16(v[4][j], v[5][j]); o.w = cvt_pk_bf16(v[6][j], v[7][j]);
            *(u32x4*)(WT + (size_t)row * K + k0) = o; } }
}

template <int MAP> __device__ __forceinline__ bool f8_item_load(const float* W, int K, int N, int kb, int nb, int lane, f32x4 (&v)[16]) {
    const int k0 = 128 * kb + 16 * (lane >> 3), n0 = 32 * nb + 4 * (lane & 7);
    if (n0 >= N) return false;
    if (MAP == 0 && rowmap_in8(n0) < 0) return false;
#pragma unroll
    for (int kk = 0; kk < 16; ++kk) v[kk] = __builtin_nontemporal_load((const f32x4*)(W + (size_t)(k0 + kk) * N + n0));
    return true;
}
template <int MAP> __device__ __forceinline__ void f8_item_store(int K, unsigned char* WT, int kb, int nb, int lane, const f32x4 (&v)[16]) {
    const int k0 = 128 * kb + 16 * (lane >> 3), n0 = 32 * nb + 4 * (lane & 7);
#pragma unroll
    for (int j = 0; j < 4; ++j) { const int c = n0 + j; const int row = MAP == 0 ? rowmap_in8(c) : MAP == 1 ? rowmap_perm(c) : MAP == 4 ? rowmap_d16(c) : rowmap_gu(c);
        u32x4 o; o.x = pk4_fp8(v[0][j] * W8_SCALE, v[1][j] * W8_SCALE, v[2][j] * W8_SCALE, v[3][j] * W8_SCALE); o.y = pk4_fp8(v[4][j] * W8_SCALE, v[5][j] * W8_SCALE, v[6][j] * W8_SCALE, v[7][j] * W8_SCALE);
        o.z = pk4_fp8(v[8][j] * W8_SCALE, v[9][j] * W8_SCALE, v[10][j] * W8_SCALE, v[11][j] * W8_SCALE); o.w = pk4_fp8(v[12][j] * W8_SCALE, v[13][j] * W8_SCALE, v[14][j] * W8_SCALE, v[15][j] * W8_SCALE);
        *(u32x4*)(WT + (size_t)row * K + k0) = o; }
}
template <int MAP> __device__ __forceinline__ void transpose_item_f8(const float* W, int K, int N, unsigned char* WT, int kb, int nb, int lane) {
    f32x4 v[16]; if (f8_item_load<MAP>(W, K, N, kb, nb, lane, v)) f8_item_store<MAP>(K, WT, kb, nb, lane, v);
}

constexpr int MOE_ITEMS = N_EXP * (8 * 64 + 8 * 32);
__device__ __forceinline__ void moe_item_decode(const Args& a, int r, const float*& W, unsigned char*& WT, int& N, int& kb, int& nb, bool& gu) {
    unsigned char* ws = a.ws; constexpr int I_GU = 8 * 64, I_D = 8 * 32;
    if (r < N_EXP * I_GU) { const int e = r / I_GU, q = r % I_GU; W = (const float*)a.in[17] + (size_t)e * 1024 * 2048; WT = ws + WS_WGU + (size_t)e * 2048 * 1024; N = 2048; kb = q / 64; nb = q % 64; gu = true; }
    else { r -= N_EXP * I_GU; const int e = r / I_D, q = r % I_D; W = (const float*)a.in[19] + (size_t)e * 1024 * 1024; WT = ws + WS_WD + (size_t)e * 1024 * 1024; N = 1024; kb = q / 32; nb = q % 32; gu = false; }
}
__device__ __forceinline__ void moe_weight_item2(const Args& a, int r0, int r1, int lane, volatile LAS int* qslot = nullptr, int qval = 0, bool qwrite = false) {
    const float *W0, *W1; unsigned char *T0, *T1; int N0, N1, kb0, kb1, nb0, nb1; bool g0, g1;
    moe_item_decode(a, r0, W0, T0, N0, kb0, nb0, g0); moe_item_decode(a, r1, W1, T1, N1, kb1, nb1, g1);
    f32x4 v0[16], v1[16];
    (void)f8_item_load<3>(W0, 1024, N0, kb0, nb0, lane, v0); (void)f8_item_load<3>(W1, 1024, N1, kb1, nb1, lane, v1);
    asm volatile("" ::: "memory");
    if (qwrite) qslot[0] = qval;
    if (g0) f8_item_store<3>(1024, T0, kb0, nb0, lane, v0); else f8_item_store<4>(1024, T0, kb0, nb0, lane, v0);
    if (g1) f8_item_store<3>(1024, T1, kb1, nb1, lane, v1); else f8_item_store<4>(1024, T1, kb1, nb1, lane, v1);
}

__device__ __forceinline__ void p0_prologue(const Frame& F, const Args& a) {
    unsigned char* ws = a.ws;
    const float* x = (const float*)a.in[0]; const float* g1 = (const float*)a.in[2]; const float* w_in = (const float*)a.in[3]; const float* b_forget = (const float*)a.in[4];
    const int gw = F.vcu * NWAVES + F.wave, NGW = F.G * NWAVES;
    constexpr int I_IN = 16 * 137, I_IN8 = 8 * 137, I_OA = 8 * 32, I_OUT = 16 * 32, I_GU = 8 * 64, I_D = 8 * 32;
    constexpr int NITEMS = I_IN + I_IN8 + 2 * I_OA + I_OUT;
    for (int it = gw; it < NITEMS; it += NGW) {
        int r = it;
        if (r < I_IN) { transpose_item<0>(w_in, 1024, IN_W, (bf16_t*)(ws + WS_WIN), r / 137, r % 137, F.lane); continue; } r -= I_IN;
        if (r < I_IN8) { if (P1_FP8) transpose_item_f8<0>(w_in, 1024, IN_W, ws + WS_WIN8, r / 137, r % 137, F.lane); continue; } r -= I_IN8;
        if (r < I_OA) { if (P3A_FP8) { if (r < 4 * 32) transpose_item_f8<(P3B_FP8 ? 4 : 1)>((const float*)a.in[11], 512, 1024, ws + WS_WOA8, r / 32, r % 32, F.lane); }
                        else transpose_item<1>((const float*)a.in[11], 512, 1024, (bf16_t*)(ws + WS_WOA), r / 32, r % 32, F.lane); continue; } r -= I_OA;
        if (r < I_OA) { if (P3A_FP8) { if (r < 4 * 32) transpose_item_f8<(P3B_FP8 ? 4 : 1)>((const float*)a.in[12], 512, 1024, ws + WS_WOB8, r / 32, r % 32, F.lane); }
                        else transpose_item<1>((const float*)a.in[12], 512, 1024, (bf16_t*)(ws + WS_WOB), r / 32, r % 32, F.lane); continue; } r -= I_OA;
        if (P3B_FP8) { if (r < 8 * 32) transpose_item_f8<1>((const float*)a.in[13], 1024, 1024, ws + WS_WOUT8, r / 32, r % 32, F.lane); }
        else transpose_item<1>((const float*)a.in[13], 1024, 1024, (bf16_t*)(ws + WS_WOUT), r / 32, r % 32, F.lane);
    }
    LAS float* wfl = (LAS float*)F.lds;
    for (int c = F.tid; c < 1024; c += NWAVES * 64) { const f32x4 u0 = *(const f32x4*)(w_in + (size_t)c * IN_W + COL_FL), u1 = *(const f32x4*)(w_in + (size_t)c * IN_W + COL_FL + 4);
        *(LAS f32x4*)(wfl + c * 8) = u0; *(LAS f32x4*)(wfl + c * 8 + 4) = u1; }
    __syncthreads();
    f32x4 wf[16][2], gv[4];
#pragma unroll
    for (int j = 0; j < 4; ++j) { gv[j] = *(const f32x4*)(g1 + 256 * j + 4 * F.lane);
#pragma unroll
        for (int i = 0; i < 4; ++i) { const int c = 256 * j + 4 * F.lane + i; wf[4 * j + i][0] = *(const LAS f32x4*)(wfl + c * 8); wf[4 * j + i][1] = *(const LAS f32x4*)(wfl + c * 8 + 4); } }
    float bfv = 0.f; if (F.lane < 8) bfv = b_forget[F.lane];
    bf16_t* XN = (bf16_t*)(ws + WS_XN); unsigned char* XN8 = ws + WS_XN8; float* LOGF = (float*)(ws + WS_LOGF);
    f32x4 nv[4];
    if (gw < NTOK) {
#pragma unroll
        for (int j = 0; j < 4; ++j) nv[j] = ((const f32x4*)(x + (size_t)gw * 1024) + F.lane)[64 * j]; }
    for (int m = gw; m < NTOK; m += NGW) {
        f32x4 v[4]; float s = 0.f;
#pragma unroll
        for (int j = 0; j < 4; ++j) v[j] = nv[j];
        if (m + NGW < NTOK) {
#pragma unroll
            for (int j = 0; j < 4; ++j) nv[j] = ((const f32x4*)(x + (size_t)(m + NGW) * 1024) + F.lane)[64 * j]; }
#pragma unroll
        for (int j = 0; j < 4; ++j) { s += (v[j][0] * v[j][0] + v[j][1] * v[j][1]) + (v[j][2] * v[j][2] + v[j][3] * v[j][3]); }
        const float rstd = rsqrtf(wave_sum(s) * (1.0f / 1024.0f) + EPS);
        if (XREC && F.lane == 0) ((float*)(ws + WS_RMS))[m] = __builtin_amdgcn_rcpf(rstd);
        float fl[8];
#pragma unroll
        for (int h = 0; h < 8; ++h) fl[h] = 0.f;
        u32x2* o8 = (u32x2*)(XN + (size_t)m * 1024) + F.lane;
#pragma unroll
        for (int j = 0; j < 4; ++j) { v[j] = v[j] * rstd * gv[j];
            u32x2 w; w.x = cvt_pk_bf16(v[j][0], v[j][1]); w.y = cvt_pk_bf16(v[j][2], v[j][3]); o8[64 * j] = w;
            if (P1_FP8) ((unsigned*)(XN8 + (size_t)m * 1024))[64 * j + F.lane] = pk4_fp8(v[j][0], v[j][1], v[j][2], v[j][3]);
#pragma unroll
            for (int i = 0; i < 4; ++i) {
#pragma unroll
                for (int h = 0; h < 4; ++h) { fl[h] += v[j][i] * wf[4 * j + i][0][h]; fl[4 + h] += v[j][i] * wf[4 * j + i][1][h]; } } }
        float mine = 0.f;
#pragma unroll
        for (int h = 0; h < 8; ++h) { const float t = wave_sum(fl[h]); if (F.lane == h) mine = t; }
        if (F.lane < 8) { const float z = mine + bfv; LOGF[(size_t)m * 8 + F.lane] = fminf(z, 0.f) - log1pf(__expf(-fabsf(z))); }
    }
}

__device__ __forceinline__ void p1_cumsum(const Frame& F, const Args& a, int bh) {
    const float* LOGF = (const float*)(a.ws + WS_LOGF); float* NCS = (float*)(a.ws + WS_NCS);
    const int b = bh >> 3, h = bh & 7; LAS double* wtot = (LAS double*)F.lds; LAS float* ncl = (LAS float*)(F.lds + 1024); LAS float* smx = (LAS float*)(F.lds + 512);
    double v[16]; double run = 0.0;
#pragma unroll
    for (int j = 0; j < 16; ++j) { run += (double)LOGF[((size_t)b * SEQ + 16 * F.tid + j) * 8 + h]; v[j] = run; }
    double incl = run;
#pragma unroll
    for (int o = 1; o < 64; o <<= 1) { const double t = __shfl_up(incl, o); if (F.lane >= o) incl += t; }
    if (F.lane == 63) wtot[F.wave] = incl;
    if (F.wave == 0) {
        float mq = fabsf(((const float*)a.in[9])[F.lane]), mk = fabsf(((const float*)a.in[10])[F.lane]);
#pragma unroll
        for (int o = 1; o < 64; o <<= 1) { mq = fmaxf(mq, __shfl_xor(mq, o)); mk = fmaxf(mk, __shfl_xor(mk, o)); }
        if (F.lane == 0) smx[0] = 64.0f * C2 * mq * mk;
    }
    __syncthreads();
    double base = incl - run;
    for (int w = 0; w < F.wave; ++w) base += wtot[w];
    float* dst = NCS + (size_t)bh * SEQ + 16 * F.tid;
#pragma unroll
    for (int j = 0; j < 4; ++j) { f32x4 o;
#pragma unroll
        for (int i = 0; i < 4; ++i) o[i] = (float)(-(base + v[4 * j + i]) * 1.4426950408889634);
        *(f32x4*)(dst + 4 * j) = o; *(LAS f32x4*)(ncl + 16 * F.tid + 4 * j) = o; }
    __syncthreads();
    LAS float* tms = (LAS float*)(F.lds + 1024 + 32768); LAS float* FQ = tms + 128; LAS float* tops = FQ + 132;
    { const int tile = F.tid >> 2; const float top = ncl[64 * tile + 63]; float pm = 0.f;
#pragma unroll
      for (int i = 0; i < 4; ++i) { const f32x4 n4 = *(const LAS f32x4*)(ncl + 16 * F.tid + 4 * i);
          pm += (__builtin_amdgcn_exp2f(n4[0] - top) + __builtin_amdgcn_exp2f(n4[1] - top)) + (__builtin_amdgcn_exp2f(n4[2] - top) + __builtin_amdgcn_exp2f(n4[3] - top)); }
      pm += __shfl_xor(pm, 1); pm += __shfl_xor(pm, 2);
      if ((F.tid & 3) == 0) { tms[tile] = pm; tops[tile] = top; } }
    __syncthreads();
    if (F.tid <= 128) { const int j = F.tid; float fq = -INFINITY;
        if (j >= 1) { const float top = tops[j - 1]; float q = 0.f; const int i0 = j > 16 ? j - 16 : 0;
            for (int i = i0; i < j; ++i) q += tms[i] * __builtin_amdgcn_exp2f(tops[i] - top);
            if (i0 > 0) q += 64.0f * (float)i0 * __builtin_amdgcn_exp2f(tops[i0 - 1] - top);
            fq = __builtin_amdgcn_logf(q) + top; }
        FQ[j] = fq; }
    __syncthreads();
    int* TS = (int*)(a.ws + WS_TS);
    if (F.tid < 32) { const int qb = F.tid; const float thr = ncl[256 * qb] - (27.05f + 2.1f * smx[0]); int lo_ = 0, hi_ = 4 * qb;
        while (lo_ < hi_) { const int mid = (lo_ + hi_ + 1) >> 1; if (FQ[mid] < thr) lo_ = mid; else hi_ = mid - 1; }
        TS[bh * 32 + qb] = lo_ & ~1; }
    __threadfence();
    __syncthreads();
    LAS int* flag = (LAS int*)(F.lds + 768);
    if (F.tid == 0) flag[0] = (int)__hip_atomic_fetch_add((unsigned*)(a.ws + WS_CTL) + CW_DONE, 1u, __ATOMIC_RELAXED, __HIP_MEMORY_SCOPE_AGENT);
    __syncthreads();
    if (flag[0] == 31) {
        __threadfence();
        LAS int* hist = (LAS int*)(F.lds + 2048); LAS int* cst = hist + 80;
        if (F.tid < 160) hist[F.tid] = 0;
        __syncthreads();
        int c[2];
#pragma unroll
        for (int k = 0; k < 2; ++k) { const int u = F.tid + 512 * k; const int t0 = (int)__hip_atomic_load((unsigned*)TS + u, __ATOMIC_RELAXED, __HIP_MEMORY_SCOPE_AGENT); c[k] = (4 * (u & 31) + 4 - t0) >> 1; atomicAdd((int*)(hist + c[k]), 1); }
        __syncthreads();
        if (F.tid == 0) { int s0 = 0; for (int cc = 79; cc >= 0; --cc) { cst[cc] = s0; s0 += hist[cc]; } }
        __syncthreads();
        int* ORD = (int*)(a.ws + WS_ORDER);
#pragma unroll
        for (int k = 0; k < 2; ++k) { const int u = F.tid + 512 * k; const int p = atomicAdd((int*)(cst + c[k]), 1); ORD[p] = u | ((4 * (u & 31) + 4 - 2 * c[k]) << 16); }
    }
    __syncthreads();
}

__device__ __forceinline__ void p2_attention(const Frame& F, const Args& a, char* lds) {
    using attn_body::bf16;
    unsigned char* ws = a.ws; const float* sinks = (const float*)a.in[8];
    const bf16* QA = (const bf16*)(ws + WS_QA); const bf16* KA = (const bf16*)(ws + WS_KA); const bf16* VA = (const bf16*)(ws + WS_VA);
    const bf16* QF = (const bf16*)(ws + WS_QF); const bf16* KF = (const bf16*)(ws + WS_KF); const bf16* VF = (const bf16*)(ws + WS_VF);
    bf16* OA = (bf16*)(ws + WS_OA); bf16* OB = (bf16*)(ws + WS_OB);
    const float* NCS = (const float*)(ws + WS_NCS);
    constexpr int OES = P3A_FP8 ? 2 : 1;
    const int* TS = (const int*)(ws + WS_TS); const int* ORD = (const int*)(ws + WS_ORDER); unsigned* qctr = (unsigned*)(ws + WS_CTL) + CW_QCTR;
    volatile LAS int* qi = (volatile LAS int*)(F.lds + MISC_OFF + 12288);
    bool fixedref;
    { float fq_ = fabsf(((const float*)a.in[9])[F.lane]), fk_ = fabsf(((const float*)a.in[10])[F.lane]), sq_ = fabsf(((const float*)a.in[6])[F.lane]), sk_ = fabsf(((const float*)a.in[7])[F.lane]), sn_ = fabsf(sinks[F.lane & 7]);
#pragma unroll
      for (int o = 1; o < 64; o <<= 1) { fq_ = fmaxf(fq_, __shfl_xor(fq_, o)); fk_ = fmaxf(fk_, __shfl_xor(fk_, o)); sq_ = fmaxf(sq_, __shfl_xor(sq_, o)); sk_ = fmaxf(sk_, __shfl_xor(sk_, o)); sn_ = fmaxf(sn_, __shfl_xor(sn_, o)); }
      const float bound = 2.1f * 64.0f * C2 * fmaxf(fq_ * fk_, sq_ * sk_);
      fixedref = __builtin_amdgcn_readfirstlane((int)((bound <= 60.0f) && (sn_ * LOG2E + bound <= 60.0f))) != 0; }
    LAS int* ordl = (LAS int*)(F.lds + 118784);
    for (int i = F.tid; i < 1024; i += NWAVES * 64) ordl[i] = ORD[i];
    __syncthreads();
    if (F.tid == 0) { qi[0] = (int)__hip_atomic_fetch_add(qctr, 1u, __ATOMIC_RELAXED, __HIP_MEMORY_SCOPE_AGENT); qi[1] = (int)__hip_atomic_fetch_add(qctr, 1u, __ATOMIC_RELAXED, __HIP_MEMORY_SCOPE_AGENT); }
    __syncthreads();
    int pos = __builtin_amdgcn_readfirstlane(qi[0]), pos1 = __builtin_amdgcn_readfirstlane(qi[1]);
    __syncthreads();
    using attn_body::P2Dec;
    static_assert(MOE_ITEMS == 1536 * 16, "chunking of the expert weight items");
    P2Dec dec; dec.KF = KF; dec.VF = VF; dec.KA = KA; dec.VA = VA; dec.NCS = NCS; dec.ordl = ordl;
    int primed_pos = -1, it = 0;
    while (pos < P2Dec::QPOS) {
        int nxt = 0;
        if (F.tid == 0) nxt = (int)__hip_atomic_fetch_add(qctr, 1u, __ATOMIC_RELAXED, __HIP_MEMORY_SCOPE_AGENT);
        volatile LAS int* slot = qi + (it & 1);
        int pos2;
        const int idx = P2Dec::unit_of(pos);
        if (idx < 0) {
            const int chunk = P2Dec::chunk_of(pos);
            moe_weight_item2(a, chunk * 16 + F.wave, chunk * 16 + 8 + F.wave, F.lane, slot, nxt, F.tid == 0);
            __syncthreads();
            pos2 = __builtin_amdgcn_readfirstlane(slot[0]);
        } else {
            const attn_body::NextU nx1 = dec.next(pos1); const bool primed = primed_pos == pos;
            if (idx < 1024) {
                const int od = __builtin_amdgcn_readfirstlane(ordl[idx]), u = od & 0xffff, t0 = od >> 16, bh = u >> 5, qb = u & 31, b = bh >> 3, h = bh & 7;
                if (fixedref) attn_body::attn_unit<0, 8, false>(qb, t0, QF + (size_t)b * SEQ * 512 + h * 64, KF + (size_t)b * SEQ * 512 + h * 64, VF + (size_t)b * SEQ * 512 + h * 64, OB + ((size_t)b * SEQ * 512 + h * 64) / OES, 512, 0.f, lds, NCS + (size_t)bh * SEQ, primed, nx1, pos1, dec, slot, nxt, pos2, primed_pos);
                else attn_body::attn_unit<0, 8, true>(qb, t0, QF + (size_t)b * SEQ * 512 + h * 64, KF + (size_t)b * SEQ * 512 + h * 64, VF + (size_t)b * SEQ * 512 + h * 64, OB + ((size_t)b * SEQ * 512 + h * 64) / OES, 512, 0.f, lds, NCS + (size_t)bh * SEQ, primed, nx1, pos1, dec, slot, nxt, pos2, primed_pos);
            } else {
                const int u = idx - 1024, bk = u >> 7, qb = 127 - (u & 127), b = bk >> 1, kvh = bk & 1; const float snk = sinks[kvh * 4 + (F.wave >> 1)] * LOG2E;
                if (fixedref) attn_body::attn_unit<1, 8, false>(qb, 0, QA + (size_t)b * SEQ * 512 + kvh * 256, KA + (size_t)b * SEQ * 128 + kvh * 64, VA + (size_t)b * SEQ * 128 + kvh * 64, OA + ((size_t)b * SEQ * 512 + kvh * 256) / OES, 128, snk, lds, nullptr, primed, nx1, pos1, dec, slot, nxt, pos2, primed_pos);
                else attn_body::attn_unit<1, 8, true>(qb, 0, QA + (size_t)b * SEQ * 512 + kvh * 256, KA + (size_t)b * SEQ * 128 + kvh * 64, VA + (size_t)b * SEQ * 128 + kvh * 64, OA + ((size_t)b * SEQ * 512 + kvh * 256) / OES, 128, snk, lds, nullptr, primed, nx1, pos1, dec, slot, nxt, pos2, primed_pos);
            }
        }
        pos = pos1; pos1 = pos2; ++it;
    }
    __syncthreads();
}

template <int NC> __device__ __forceinline__ void top4_of(float (&cv)[NC], int (&ce)[NC], float (&tv)[4], int (&te)[4]) {
#pragma unroll
    for (int k = 0; k < 4; ++k) { float bv = -INFINITY; int be = 1 << 20;
#pragma unroll
        for (int i = 0; i < NC; ++i) { const bool t = (cv[i] > bv) | ((cv[i] == bv) & (ce[i] < be)); bv = t ? cv[i] : bv; be = t ? ce[i] : be; }
        tv[k] = bv; te[k] = be;
#pragma unroll
        for (int i = 0; i < NC; ++i) cv[i] = (ce[i] == be) ? -INFINITY : cv[i]; }
}
__device__ __forceinline__ void p4_router(const Frame& F, const Args& a, const bool dry) {
    unsigned char* ws = a.ws; const bf16_t* X1 = (const bf16_t*)(ws + WS_X1); const float* g2 = (const float*)a.in[14]; const float* wr_ = (const float*)a.in[15]; const float* br = (const float*)a.in[16];
    LAS unsigned char* WL = F.lds;
    LAS int* lcnt = (LAS int*)(F.lds + MISC_OFF); LAS int* lbase = lcnt + 32; LAS int* asg_e = lcnt + 64; LAS float* asg_g = (LAS float*)(lcnt + 64 + 512);
    for (int ci = F.tid; ci < 4096; ci += NWAVES * 64) { const int ks = ci >> 7, et = (ci >> 6) & 1, kq = (ci >> 4) & 3, er = ci & 15, e = 16 * et + er, k0 = 64 * (ks >> 1) + 16 * kq + 8 * (ks & 1);
        float w[8];
#pragma unroll
        for (int j = 0; j < 8; ++j) w[j] = g2[k0 + j] * wr_[(k0 + j) * 32 + e];
        u32x4 o; o.x = cvt_pk_bf16(w[0], w[1]); o.y = cvt_pk_bf16(w[2], w[3]); o.z = cvt_pk_bf16(w[4], w[5]); o.w = cvt_pk_bf16(w[6], w[7]);
        *(LAS u32x4*)(WL + ci * 16) = o; }
    if (F.tid < 32) lcnt[F.tid] = 0;
    __syncthreads();
    unsigned char* H2 = ws + WS_XN; unsigned* gcnt = (unsigned*)(ws + WS_CTL) + CW_CNT;
    int* TOKE = (int*)(ws + WS_TOKE); int* TOKR = (int*)(ws + WS_TOKR); float* TOKG = (float*)(ws + WS_TOKG); int* ROWTOK = (int*)(ws + WS_ROWTOK);
    const int tokl = F.lane & 15, kq = F.lane >> 4;
    for (int rb = blockIdx.x; rb < NTOK / 128; rb += F.G) {
        const int lrow = F.wave * 16 + tokl, m = rb * 128 + lrow;
        const bf16_t* xrow = X1 + (size_t)m * 1024 + 16 * kq;
        f32x4 acc0 = (f32x4){0.f, 0.f, 0.f, 0.f}, acc1 = (f32x4){0.f, 0.f, 0.f, 0.f}; float ss = 0.f;
#pragma unroll 4
        for (int ql = 0; ql < 16; ++ql) {
            const u32x4 x0 = *(const u32x4*)(xrow + 64 * ql), x1v = *(const u32x4*)(xrow + 64 * ql + 8);
#pragma unroll
            for (int d = 0; d < 4; ++d) { const float p = bf_lo(x0[d]), q = bf_hi(x0[d]), r = bf_lo(x1v[d]), t = bf_hi(x1v[d]); ss += (p * p + q * q) + (r * r + t * t); }
            const LAS unsigned char* wp = WL + ql * 4096 + F.lane * 16;
            acc0 = __builtin_amdgcn_mfma_f32_16x16x32_bf16(*(const LAS bf16x8*)(wp), __builtin_bit_cast(bf16x8, x0), acc0, 0, 0, 0);
            acc1 = __builtin_amdgcn_mfma_f32_16x16x32_bf16(*(const LAS bf16x8*)(wp + 1024), __builtin_bit_cast(bf16x8, x0), acc1, 0, 0, 0);
            acc0 = __builtin_amdgcn_mfma_f32_16x16x32_bf16(*(const LAS bf16x8*)(wp + 2048), __builtin_bit_cast(bf16x8, x1v), acc0, 0, 0, 0);
            acc1 = __builtin_amdgcn_mfma_f32_16x16x32_bf16(*(const LAS bf16x8*)(wp + 3072), __builtin_bit_cast(bf16x8, x1v), acc1, 0, 0, 0);
        }
        ss += __shfl_xor(ss, 16); ss += __shfl_xor(ss, 32);
        const float rstd = rsqrtf(ss * (1.0f / 1024.0f) + EPS);
        float cv[8]; int ce[8];
#pragma unroll
        for (int r = 0; r < 4; ++r) { ce[r] = 4 * kq + r; ce[4 + r] = 16 + 4 * kq + r; cv[r] = acc0[r] * rstd + br[4 * kq + r]; cv[4 + r] = acc1[r] * rstd + br[16 + 4 * kq + r]; }
        float tv[4]; int te[4];
        top4_of<8>(cv, ce, tv, te);
#pragma unroll
        for (int o = 16; o <= 32; o <<= 1) {
            float mv[8]; int me[8];
#pragma unroll
            for (int k = 0; k < 4; ++k) { mv[k] = tv[k]; me[k] = te[k]; mv[4 + k] = __shfl_xor(tv[k], o); me[4 + k] = __shfl_xor(te[k], o); }
            top4_of<8>(mv, me, tv, te);
        }
        if (kq == 0) {
            float ex[4], z = 0.f;
#pragma unroll
            for (int k = 0; k < 4; ++k) { ex[k] = __expf(tv[k] - tv[0]); z += ex[k]; }
#pragma unroll
            for (int k = 0; k < 4; ++k) { asg_e[lrow * 4 + k] = te[k]; asg_g[lrow * 4 + k] = ex[k] / z; }
        }
        unsigned char* hrow = H2 + (size_t)m * 1024 + 16 * kq;
#pragma unroll 4
        for (int ql = 0; ql < 16; ++ql) {
            const u32x4 x0 = *(const u32x4*)(xrow + 64 * ql), x1v = *(const u32x4*)(xrow + 64 * ql + 8);
            const f32x4 g0 = *(const f32x4*)(g2 + 64 * ql + 16 * kq), g1 = *(const f32x4*)(g2 + 64 * ql + 16 * kq + 4), g2v = *(const f32x4*)(g2 + 64 * ql + 16 * kq + 8), g3 = *(const f32x4*)(g2 + 64 * ql + 16 * kq + 12);
            u32x4 o;
            o.x = pk4_fp8(bf_lo(x0[0]) * rstd * g0[0], bf_hi(x0[0]) * rstd * g0[1], bf_lo(x0[1]) * rstd * g0[2], bf_hi(x0[1]) * rstd * g0[3]);
            o.y = pk4_fp8(bf_lo(x0[2]) * rstd * g1[0], bf_hi(x0[2]) * rstd * g1[1], bf_lo(x0[3]) * rstd * g1[2], bf_hi(x0[3]) * rstd * g1[3]);
            o.z = pk4_fp8(bf_lo(x1v[0]) * rstd * g2v[0], bf_hi(x1v[0]) * rstd * g2v[1], bf_lo(x1v[1]) * rstd * g2v[2], bf_hi(x1v[1]) * rstd * g2v[3]);
            o.w = pk4_fp8(bf_lo(x1v[2]) * rstd * g3[0], bf_hi(x1v[2]) * rstd * g3[1], bf_lo(x1v[3]) * rstd * g3[2], bf_hi(x1v[3]) * rstd * g3[3]);
            *(u32x4*)(hrow + 64 * ql) = o;
        }
        __syncthreads();
        if (dry) continue;
        const int e = asg_e[F.tid]; const int lrank = atomicAdd((int*)(lcnt + e), 1);
        __syncthreads();
        if (F.tid < 32) { const int c = lcnt[F.tid]; lbase[F.tid] = c ? (int)atomicAdd(gcnt + F.tid, (unsigned)c) : 0; }
        __syncthreads();
        const int rank = lbase[e] + lrank, tok = rb * 128 + (F.tid >> 2);
        ROWTOK[(size_t)e * NTOK + rank] = tok; TOKE[tok * 4 + (F.tid & 3)] = e; TOKR[tok * 4 + (F.tid & 3)] = rank; TOKG[tok * 4 + (F.tid & 3)] = asg_g[F.tid];
        __syncthreads();
        if (F.tid < 32) lcnt[F.tid] = 0;
        __syncthreads();
    }
}

__device__ __forceinline__ int build_group_tables(const Frame& F, const Args& a, LAS int* cnt, LAS int* pt, LAS int* tile_e) {
    const unsigned* gcnt = (const unsigned*)(a.ws + WS_CTL) + CW_CNT;
    __syncthreads();
    if (F.tid < 32) cnt[F.tid] = (int)__hip_atomic_load(gcnt + F.tid, __ATOMIC_RELAXED, __HIP_MEMORY_SCOPE_AGENT);
    __syncthreads();
    if (F.tid == 0) { int s = 0; for (int e = 0; e < 32; ++e) { pt[e] = s; s += (cnt[e] + 255) >> 8; } pt[32] = s; }
    __syncthreads();
    const int MT = pt[32];
    for (int e = 0; e < 32; ++e) { const int lo = pt[e], n = pt[e + 1] - lo; for (int i = F.tid; i < n; i += NWAVES * 64) tile_e[lo + i] = e; }
    __syncthreads();
    return MT;
}

__device__ __forceinline__ void p7_combine(const Frame& F, const Args& a, const LAS int* pt, float* dst) {
    unsigned char* ws = a.ws; const bf16_t* X1 = (const bf16_t*)(ws + WS_X1); const unsigned char* YB = ws + WS_YB;
    const int* TOKE = (const int*)(ws + WS_TOKE); const int* TOKR = (const int*)(ws + WS_TOKR); const float* TOKG = (const float*)(ws + WS_TOKG);
    const int gw = F.vcu * NWAVES + F.wave, NGW = F.G * NWAVES;
    for (int m = gw; m < NTOK; m += NGW) {
        size_t pos[4]; float g[4];
#pragma unroll
        for (int k = 0; k < 4; ++k) { const int e = TOKE[m * 4 + k]; pos[k] = (size_t)(256 * pt[e] + TOKR[m * 4 + k]) * 1024; g[k] = TOKG[m * 4 + k]; }
#pragma unroll
        for (int j = 0; j < 2; ++j) { const int c0 = 512 * j + 8 * F.lane; float* dp = dst + (size_t)m * 1024 + c0;
            f32x4 o0, o1; { float xx[8]; epi::unpack8(*(const u32x4*)(X1 + (size_t)m * 1024 + c0), xx); o0 = (f32x4){xx[0], xx[1], xx[2], xx[3]}; o1 = (f32x4){xx[4], xx[5], xx[6], xx[7]}; }
#pragma unroll
            for (int k = 0; k < 4; ++k) { float y[8]; { const u32x2 w8 = *(const u32x2*)(YB + pos[k] + c0); y[0] = __builtin_amdgcn_cvt_f32_fp8((int)w8.x, 0); y[1] = __builtin_amdgcn_cvt_f32_fp8((int)w8.x, 1); y[2] = __builtin_amdgcn_cvt_f32_fp8((int)w8.x, 2); y[3] = __builtin_amdgcn_cvt_f32_fp8((int)w8.x, 3);
                  y[4] = __builtin_amdgcn_cvt_f32_fp8((int)w8.y, 0); y[5] = __builtin_amdgcn_cvt_f32_fp8((int)w8.y, 1); y[6] = __builtin_amdgcn_cvt_f32_fp8((int)w8.y, 2); y[7] = __builtin_amdgcn_cvt_f32_fp8((int)w8.y, 3); }
#pragma unroll
                for (int i = 0; i < 4; ++i) { o0[i] += g[k] * y[i]; o1[i] += g[k] * y[4 + i]; } }
            *(f32x4*)dp = o0; *(f32x4*)(dp + 4) = o1; }
    }
}

#define XB_TMO      128
#define XB_XCNT(j)  (256  + 64 * (j))
#define XB_XSUB(j)  (1280 + 64 * (j))
#define XB_XGEN(j)  (2304 + 64 * (j))
#define XB_TOP      3328
#define XB_TOPGEN   3392
#define XCD_BAR_WORDS 3456
#define XB_SPIN_CAP (1u << 20)
__device__ __forceinline__ unsigned xb_ld(unsigned* p)              { return __hip_atomic_load(p, __ATOMIC_RELAXED, __HIP_MEMORY_SCOPE_AGENT); }
__device__ __forceinline__ unsigned xb_add(unsigned* p, unsigned v) { return __hip_atomic_fetch_add(p, v, __ATOMIC_RELAXED, __HIP_MEMORY_SCOPE_AGENT); }
__device__ __forceinline__ unsigned xb_xcc_id() { return (unsigned)__builtin_amdgcn_s_getreg((3 << 11) | 20) & 0xFu; }
#define XB_SPIN(cond, bar) do { unsigned _sp = 0; while (cond) { __builtin_amdgcn_s_sleep(1); \
    if ((++_sp & 255u) == 0u) { if (xb_ld(&(bar)[XB_TMO])) break; if (_sp > XB_SPIN_CAP) { atomicAdd(&(bar)[XB_TMO], 1u); break; } } } } while (0)
struct XcdBarrier { unsigned* bar; unsigned x; volatile LAS unsigned* st; };
__device__ __forceinline__ XcdBarrier xcd_barrier_post(unsigned* bar, volatile LAS unsigned* st) {
    XcdBarrier b; b.bar = bar; b.x = xb_xcc_id(); b.st = st;
    if (threadIdx.x == 0) (void)xb_add(&bar[XB_XCNT(b.x)], 1u);
    return b;
}
__device__ __forceinline__ void xcd_barrier_complete(unsigned* bar, unsigned x, unsigned& nloc, unsigned& nx) {
    const unsigned G = gridDim.x * gridDim.y * gridDim.z;
    unsigned sum, cnt, mine, sp = 0u;
    for (;;) {
        sum = 0u; cnt = 0u; mine = 0u;
#pragma unroll
        for (unsigned j = 0; j < 16; ++j) { const unsigned c = xb_ld(&bar[XB_XCNT(j)]); sum += c; cnt += (c > 0u) ? 1u : 0u; mine = (j == x) ? c : mine; }
        if (sum == G) break;
        __builtin_amdgcn_s_sleep(1);
        if ((++sp & 255u) == 0u) { if (xb_ld(&bar[XB_TMO])) break; if (sp > XB_SPIN_CAP) { atomicAdd(&bar[XB_TMO], 1u); break; } }
    }
    nloc = mine > 0u ? mine : 1u; nx = cnt > 0u ? cnt : 1u;
}
__device__ __forceinline__ void xcd_barrier(const XcdBarrier& b) {
    asm volatile("s_waitcnt vmcnt(0)" ::: "memory");
    __syncthreads();
    if (threadIdx.x == 0) {
        unsigned* bar = b.bar;
        __builtin_amdgcn_s_waitcnt(0);
        unsigned nloc = b.st[0], nx = b.st[1];
        if (nloc == 0u) { xcd_barrier_complete(bar, b.x, nloc, nx); b.st[0] = nloc; b.st[1] = nx; }
        const unsigned old = xb_add(&bar[XB_XSUB(b.x)], 1u);
        const unsigned gen = old / nloc;
        if (old + 1u == (gen + 1u) * nloc) {
            __builtin_amdgcn_fence(__ATOMIC_RELEASE, "agent");
            asm volatile("s_waitcnt vmcnt(0)" ::: "memory");
            const unsigned og = xb_add(&bar[XB_TOP], 1u);
            const unsigned tg = og / nx;
            if (og + 1u == (tg + 1u) * nx) xb_add(&bar[XB_TOPGEN], 1u);
            else XB_SPIN(xb_ld(&bar[XB_TOPGEN]) == tg, bar);
            __builtin_amdgcn_fence(__ATOMIC_ACQUIRE, "agent");
            xb_add(&bar[XB_XGEN(b.x)], 1u);
            asm volatile("s_waitcnt vmcnt(0)" ::: "memory");
        } else {
            XB_SPIN(xb_ld(&bar[XB_XGEN(b.x)]) == gen, bar);
            __builtin_amdgcn_fence(__ATOMIC_ACQUIRE, "agent");
            asm volatile("s_waitcnt vmcnt(0)" ::: "memory");
        }
    }
    __syncthreads();
}

__global__ void __launch_bounds__(NWAVES * 64, 2) hyb_fwd(Args args) {
    extern __shared__ __attribute__((aligned(16))) unsigned char lds_raw[];
#define MKFRAME() Frame F; F.lds = (LAS unsigned char*)lds_raw; F.tid = opaque_tid(); F.lane = F.tid & 63; F.wave = __builtin_amdgcn_readfirstlane(F.tid >> 6); \
    F.G = gridDim.x; { const int bx = blockIdx.x; F.vcu = (F.G % 8 == 0) ? (bx % 8) * (F.G / 8) + bx / 8 : bx; }
    unsigned char* ws = args.ws;
    const int lo = args.ph_lo, hi = args.ph_hi;
#ifndef PHASE_MASK
#define PHASE_MASK 0x1ff
#endif
#define IN(k) (((PHASE_MASK >> (k)) & 1) && lo <= (k) && (k) < hi)
#define BOTH(k) (IN(k) && IN((k) + 1))
#ifndef REPEAT_MASK
#define REPEAT_MASK 0
#endif
#define NREP(k) (1 + ((REPEAT_MASK >> (k)) & 1))
    volatile LAS unsigned* bst = (volatile LAS unsigned*)((LAS unsigned char*)lds_raw + MISC_OFF + MISC_BAR);
    if (threadIdx.x < 4) bst[threadIdx.x] = 0u;
    __syncthreads();
    XcdBarrier xbar; xbar.bar = (unsigned*)(ws + WS_CTL) + CW_BAR; xbar.x = 0; xbar.st = bst;
    if (hi - lo > 1) xbar = xcd_barrier_post((unsigned*)(ws + WS_CTL) + CW_BAR, bst);
#define GRID_BAR() xcd_barrier(xbar)
    LAS int* t_cnt = (LAS int*)((LAS unsigned char*)lds_raw + MISC_OFF); LAS int* t_pt = t_cnt + 64; LAS int* t_tile = t_cnt + 128;
    constexpr size_t TS1024 = (size_t)256 * 1024 * 2, TS512 = (size_t)256 * 512 * 2;

    if (IN(0)) { MKFRAME(); for (int rep = 0; rep < NREP(0); ++rep) { if (rep) GRID_BAR(); p0_prologue(F, args); } if (BOTH(0)) GRID_BAR(); }
    if (IN(1)) {
        MKFRAME();
        for (int bh = blockIdx.x; bh < 32; bh += F.G) p1_cumsum(F, args, bh);
        pg8::DenseOrder S{NTOK / 256, P1_FP8 ? 7 : IN_TILES, F.G, (int)blockIdx.x, (const char*)(ws + WS_XN), (const char*)(ws + WS_WIN), TS1024};
        pg8::SplitOrder S8{NTOK / 256, 10, F.G, (int)blockIdx.x, 7, (const char*)(ws + WS_XN8), (const char*)(ws + WS_WIN8), TS512};
        epi::EpiIn E{(bf16_t*)(ws + WS_QA), (bf16_t*)(ws + WS_KA), (bf16_t*)(ws + WS_VA), (bf16_t*)(ws + WS_QF), (bf16_t*)(ws + WS_KF), (bf16_t*)(ws + WS_VF), ws + WS_GT,
                     (const int*)args.in[1], (const float*)args.in[6], (const float*)args.in[7], (const float*)args.in[9], (const float*)args.in[10], (const float*)args.in[5]};
        for (int rep = 0; rep < NREP(1); ++rep) { if (rep) GRID_BAR(); pg8::gemm_phase<epi::EpiIn, pg8::DenseOrder, false>(F.lds, 1024, S, E); if (P1_FP8) pg8::gemm_phase<epi::EpiIn, pg8::SplitOrder, false, true>(F.lds, 512, S8, E); }
        if (BOTH(1)) GRID_BAR();
    }
    if (IN(2)) { MKFRAME(); for (int rep = 0; rep < NREP(2); ++rep) { if (rep) { GRID_BAR(); if (blockIdx.x == 0 && threadIdx.x == 0) __hip_atomic_store((unsigned*)(ws + WS_CTL) + CW_QCTR, 0u, __ATOMIC_RELAXED, __HIP_MEMORY_SCOPE_AGENT); GRID_BAR(); } p2_attention(F, args, (char*)lds_raw); } if (BOTH(2)) GRID_BAR(); }
    if (IN(3)) {
        MKFRAME();
        pg8::PairOrder S{NTOK / 256, 4, F.G, (int)blockIdx.x, (const char*)(ws + WS_OA), (const char*)(ws + WS_OB), (const char*)(ws + (P3A_FP8 ? WS_WOA8 : WS_WOA)), (const char*)(ws + (P3A_FP8 ? WS_WOB8 : WS_WOB)), P3A_FP8 ? TS512 / 2 : TS512};
        epi::EpiMerge E{ws + WS_GT, (bf16_t*)(ws + WS_MG), ws + WS_MG8};
        for (int rep = 0; rep < NREP(3); ++rep) { if (rep) GRID_BAR();
            if (P3A_FP8) pg8::gemm_phase<epi::EpiMerge, pg8::PairOrder, false, true, 0x7a7a7a7au>(F.lds, 256, S, E);
            else pg8::gemm_phase<epi::EpiMerge, pg8::PairOrder, false>(F.lds, 512, S, E); }
        if (BOTH(3)) GRID_BAR();
    }
    if (IN(4)) {
        MKFRAME();
        pg8::DenseOrder S{NTOK / 256, 4, F.G, (int)blockIdx.x, (const char*)(ws + (P3B_FP8 ? WS_MG8 : WS_MG)), (const char*)(ws + (P3B_FP8 ? WS_WOUT8 : WS_WOUT)), P3B_FP8 ? TS512 : TS1024};
        bool rec;
        { const float* g1p = (const float*)args.in[2]; float mn = fminf(fabsf(g1p[F.tid]), fabsf(g1p[F.tid + 512]));
#pragma unroll
          for (int o = 1; o < 64; o <<= 1) mn = fminf(mn, __shfl_xor(mn, o));
          LAS float* red = (LAS float*)(F.lds + MISC_OFF);
          __syncthreads(); if (F.lane == 0) red[F.wave] = mn; __syncthreads();
          float all = red[0];
#pragma unroll
          for (int w = 1; w < NWAVES; ++w) all = fminf(all, red[w]);
          rec = __builtin_amdgcn_readfirstlane((int)(all >= 0.015625f)) != 0; __syncthreads(); }
        epi::EpiResid E{(const float*)args.in[0], (bf16_t*)(ws + WS_X1), (const bf16_t*)(ws + WS_XN), (const float*)(ws + WS_RMS), (const float*)args.in[2], rec};
        for (int rep = 0; rep < NREP(4); ++rep) { if (rep) GRID_BAR();
            if (P3B_FP8) pg8::gemm_phase<epi::EpiResid, pg8::DenseOrder, false, true, 0x7a7a7a7au>(F.lds, 512, S, E);
            else pg8::gemm_phase<epi::EpiResid, pg8::DenseOrder, false>(F.lds, 1024, S, E); }
        if (BOTH(4)) GRID_BAR();
    }
    if (IN(5)) { MKFRAME(); if (NREP(5) > 1) { p4_router(F, args, true); GRID_BAR(); } p4_router(F, args, false); if (BOTH(5)) GRID_BAR(); }
    if (IN(6)) {
        MKFRAME();
        const int MT = build_group_tables(F, args, t_cnt, t_pt, t_tile);
        LAS int* tokl = (LAS int*)(F.lds + MISC_OFF + MISC_TOKL);
        pg8::GroupOrder S{MT, 8, F.G, (int)blockIdx.x, t_tile, t_pt, t_cnt, (const char*)(ws + WS_XN), (const char*)(ws + WS_WGU), TS512, 2048, tokl, true};
        { const int* ROWTOK = (const int*)(ws + WS_ROWTOK);
          int tv[TOKL_UNITS];
#pragma unroll
          for (int ui = 0; ui < TOKL_UNITS; ++ui) { const long L = (long)ui * F.G + (int)blockIdx.x; tv[ui] = 0;
              if (L < (long)MT * 8 && F.tid < 256) { int pm, pn; pg8::tile_map((int)L, MT, 8, pm, pn); const int e = t_tile[pm], idx = (pm - t_pt[e]) * 256 + F.tid; if (idx < t_cnt[e]) tv[ui] = ROWTOK[(size_t)e * NTOK + idx]; } }
          if (F.tid < 256) {
#pragma unroll
              for (int ui = 0; ui < TOKL_UNITS; ++ui) tokl[ui * 256 + F.tid] = tv[ui]; }
          __syncthreads(); }
        epi::EpiSwiglu E{(const float*)args.in[18], ws + WS_ACT};
        for (int rep = 0; rep < NREP(6); ++rep) { if (rep) GRID_BAR(); pg8::gemm_phase<epi::EpiSwiglu, pg8::GroupOrder, true, true>(F.lds, 512, S, E); }
        if (BOTH(6)) GRID_BAR();
    }
    if (IN(7)) {
        MKFRAME();
        const int MT = build_group_tables(F, args, t_cnt, t_pt, t_tile);
        pg8::GroupOrder S{MT, 4, F.G, (int)blockIdx.x, t_tile, t_pt, t_cnt, (const char*)(ws + WS_ACT), (const char*)(ws + WS_WD), TS512, 1024, (const LAS int*)nullptr, false};
        epi::EpiDown E{(const float*)args.in[20], ws + WS_YB};
        for (int rep = 0; rep < NREP(7); ++rep) { if (rep) GRID_BAR(); pg8::gemm_phase<epi::EpiDown, pg8::GroupOrder, false, true>(F.lds, 512, S, E); }
        if (BOTH(7)) GRID_BAR();
    }
    if (IN(8)) { MKFRAME(); (void)build_group_tables(F, args, t_cnt, t_pt, t_tile); if (NREP(8) > 1) { p7_combine(F, args, t_pt, (float*)(ws + 896 * MiB)); GRID_BAR(); } p7_combine(F, args, t_pt, args.out); }
#undef IN
#undef BOTH
#undef GRID_BAR
#undef MKFRAME
}

extern "C" void kernel_launch(void* const* d_in, const int* in_sizes, int n_in, void* d_out, int out_size, void* d_ws, size_t ws_size, hipStream_t stream) {
    static int grid = 0;
    if (grid == 0) {
        if (n_in != 21 || in_sizes[0] != NTOK * D_MODEL || out_size != NTOK * D_MODEL || ws_size < WS_END) {
            fprintf(stderr, "kernel_launch: unexpected shapes (n_in %d, in0 %d, out %d, ws %zu); nothing launched\n", n_in, n_in > 0 ? in_sizes[0] : -1, out_size, ws_size); grid = -1; return; }
        int dev = 0, cus = 0, per_cu = 0;
        if (hipGetDevice(&dev) != hipSuccess || hipDeviceGetAttribute(&cus, hipDeviceAttributeMultiprocessorCount, dev) != hipSuccess) { fprintf(stderr, "kernel_launch: device query failed\n"); grid = -1; return; }
        if (hipFuncSetAttribute((const void*)hyb_fwd, hipFuncAttributeMaxDynamicSharedMemorySize, LDS_BYTES) != hipSuccess) { fprintf(stderr, "kernel_launch: hipFuncSetAttribute failed\n"); grid = -1; return; }
        if (hipOccupancyMaxActiveBlocksPerMultiprocessor(&per_cu, (const void*)hyb_fwd, NWAVES * 64, LDS_BYTES) != hipSuccess || per_cu < 1) { fprintf(stderr, "kernel_launch: occupancy query says %d\n", per_cu); per_cu = 1; }
        (void)hipGetLastError();
        grid = cus;
        if (grid > cus * per_cu) grid = cus * per_cu;
    }
    if (grid < 0) return;
    (void)hipMemsetAsync((char*)d_ws + WS_CTL, 0, CTL_ZERO_BYTES, stream);
    Args a{};
    for (int i = 0; i < 21; ++i) a.in[i] = d_in[i];
    a.out = (float*)d_out; a.ws = (unsigned char*)d_ws;
#if MK_N_LAUNCHES == 1
    a.ph_lo = 0; a.ph_hi = N_PHASES;
    void* kargs[] = {&a};
    hipError_t e = hipLaunchCooperativeKernel((const void*)hyb_fwd, dim3(grid), dim3(NWAVES * 64), kargs, LDS_BYTES, stream);
    if (e != hipSuccess) fprintf(stderr, "kernel_launch: cooperative launch failed: %s (grid %d)\n", hipGetErrorString(e), grid);
#else
    for (int p = 0; p < N_PHASES; ++p) { a.ph_lo = p; a.ph_hi = p + 1; hipLaunchKernelGGL(hyb_fwd, dim3(grid), dim3(NWAVES * 64), LDS_BYTES, stream, a); }
#endif
}
```

```cpp
#include <hip/hip_runtime.h>
#include <hip/hip_cooperative_groups.h>
#include <hip/hip_bf16.h>
#include <cstdio>
#include <cstdint>
namespace cg = cooperative_groups;

#ifndef XREC
#define XREC 1
#endif
#ifndef P3A_FP8
#define P3A_FP8 1
#endif
#ifndef P3B_FP8
#define P3B_FP8 1
#endif
#ifndef P1_FS
#define P1_FS 3
#endif
#ifndef P1_FP8
#define P1_FP8 1
#endif
#ifndef MK_N_LAUNCHES
#define MK_N_LAUNCHES 1
#endif

#define LAS __attribute__((address_space(3)))
typedef unsigned short bf16_t;
typedef short bf16x8 __attribute__((ext_vector_type(8)));
typedef short s16x4 __attribute__((ext_vector_type(4)));
typedef float f32x2 __attribute__((ext_vector_type(2)));
typedef float f32x4 __attribute__((ext_vector_type(4)));
typedef float f32x16 __attribute__((ext_vector_type(16)));
typedef unsigned u32x2 __attribute__((ext_vector_type(2)));
typedef unsigned u32x4 __attribute__((ext_vector_type(4)));
typedef int i32x4_t __attribute__((ext_vector_type(4)));

constexpr int D_MODEL = 1024, BATCH = 4, SEQ = 8192, NTOK = BATCH * SEQ;
constexpr int HD = 64, SWA_QH = 8, SWA_KVH = 2, FOX_H = 8, N_EXP = 32, TOPK = 4, D_FF = 1024;
constexpr int IN_W = 4360, COL_FL = 2304, COL_GL = 2312;
constexpr int IN_TILES = 17;
constexpr float EPS = 1e-6f;
constexpr float LOG2E = 1.4426950408889634f;
constexpr float C2 = 0.125f * LOG2E;
constexpr int CAP_TILES = (NTOK * TOPK) / 256 + N_EXP;

__device__ __forceinline__ unsigned cvt_pk_bf16(float lo, float hi) { typedef __bf16 b2 __attribute__((ext_vector_type(2))); f32x2 v = {lo, hi}; b2 b = __builtin_convertvector(v, b2); return __builtin_bit_cast(unsigned, b); }
__device__ __forceinline__ float bf_lo(unsigned u) { return __uint_as_float(u << 16); }
__device__ __forceinline__ float bf_hi(unsigned u) { return __uint_as_float(u & 0xffff0000u); }
__device__ __forceinline__ float bf2f(short s) { return __uint_as_float(((unsigned)(unsigned short)s) << 16); }
__device__ __forceinline__ float clamp448(float x) { return __builtin_amdgcn_fmed3f(x, -448.0f, 448.0f); }
__device__ __forceinline__ unsigned pk4_fp8(float a, float b, float c, float d) {
    int r = __builtin_amdgcn_cvt_pk_fp8_f32(clamp448(a), clamp448(b), 0, false); r = __builtin_amdgcn_cvt_pk_fp8_f32(clamp448(c), clamp448(d), r, true); return (unsigned)r; }
__device__ __forceinline__ unsigned pk4_fp8_nc(float a, float b, float c, float d) { int r = __builtin_amdgcn_cvt_pk_fp8_f32(a, b, 0, false); r = __builtin_amdgcn_cvt_pk_fp8_f32(c, d, r, true); return (unsigned)r; }
typedef int i32x8 __attribute__((ext_vector_type(8)));
__device__ __forceinline__ f32x2 pk_add2(f32x2 a, f32x2 b) { return a + b; }
__device__ __forceinline__ f32x2 pk_fma2(f32x2 a, f32x2 b, f32x2 c) { return __builtin_elementwise_fma(a, b, c); }
__device__ __forceinline__ f32x2 splat2(float x) { f32x2 v = {x, x}; asm("" : "+v"(v)); return v; }
constexpr float SWIGLU_CG = 1.702f * 1.4426950408889634f;
constexpr float W8_SCALE = 32.0f;
__device__ __forceinline__ int opaque_tid() { int t = threadIdx.x; asm volatile("" : "+v"(t)); return t; }
__host__ __device__ __forceinline__ int perm32s(int p) { return 16 * ((p >> 2) & 1) + 4 * (p >> 3) + (p & 3); }

namespace pg8 {
constexpr int BM = 256, BK = 64, HALF = 128, HTB = HALF * BK * 2  , STAGE_BYTES = 8 * HTB, NXCD = 8, WGM = 3;
__host__ __device__ __forceinline__ int lds_byte(int r, int c) { const int st = (r >> 4) * 2 + (c >> 5), rr = r & 15, cc = c & 31, ob = rr * 64 + cc * 2; return st * 1024 + (ob ^ (((ob >> 9) & 1) << 5)); }
__host__ __device__ __forceinline__ void stage_rc(int b, int& R, int& C) { const int st = b / 1024, sb = b % 1024, swz = sb ^ (((sb >> 9) & 1) << 5); R = (st >> 1) * 16 + swz / 64; C = (st & 1) * 32 + (swz % 64) / 2; }

struct Unit { int pm, pn, e; const char* a; const char* b; const LAS int* gtab; int gcnt; };

__device__ __forceinline__ void tile_map(int L, int nM, int nN, int& pm, int& pn) {
    const int nwg = nM * nN; int wgid = L; { const int q = nwg / NXCD, r = nwg % NXCD, xcd = wgid % NXCD, off = wgid / NXCD; wgid = (xcd < r ? xcd * (q + 1) : r * (q + 1) + (xcd - r) * q) + off; }
    const int nig = WGM * nN, gid = wgid / nig, fm = gid * WGM, gsz = (nM - fm) < WGM ? (nM - fm) : WGM;
    pm = fm + ((wgid % nig) % gsz); pn = (wgid % nig) / gsz;
}
struct DenseOrder {
    int nM, nN, G, c; const char* A; const char* B; size_t tstep;
    __device__ __forceinline__ bool next(int i, Unit& u) const {
        const long L = (long)i * G + c; if (L >= (long)nM * nN) return false;
        tile_map((int)L, nM, nN, u.pm, u.pn); u.e = 0; u.a = A + (size_t)u.pm * tstep; u.b = B + (size_t)u.pn * tstep; u.gtab = nullptr; u.gcnt = 0; return true; }
};
struct SplitOrder {
    int nM, nN, G, c, pn0; const char* A; const char* B; size_t tstep;
    __device__ __forceinline__ bool next(int i, Unit& u) const {
        long L;
        if (G == 256 && nM == 128) { constexpr int NLO = (15 - P1_FS) / 2, NHI = (19 - P1_FS) / 2; if (c < 128) { if (i >= NLO) return false; L = (long)i * 128 + c; } else { if (i >= NHI) return false; L = 128 * NLO + (long)i * 128 + (c - 128); } }
        else { L = (long)i * G + c; if (L >= (long)nM * nN) return false; }
        tile_map((int)L, nM, nN, u.pm, u.pn); u.e = 0; u.a = A + (size_t)u.pm * tstep; u.b = B + (size_t)u.pn * tstep; u.pn += pn0; u.gtab = nullptr; u.gcnt = 0; return true; }
};
struct PairOrder {
    int nM, nN, G, c; const char* A0; const char* A1; const char* B0; const char* B1; size_t tstep;
    __device__ __forceinline__ bool next(int i, Unit& u) const {
        const long L = (long)(i >> 1) * G + c; if (L >= (long)nM * nN) return false;
        tile_map((int)L, nM, nN, u.pm, u.pn); u.e = i & 1; u.a = ((i & 1) ? A1 : A0) + (size_t)u.pm * tstep; u.b = ((i & 1) ? B1 : B0) + (size_t)u.pn * tstep; u.gtab = nullptr; u.gcnt = 0; return true; }
};
struct GroupOrder {
    int MT, nN, G, c; const LAS int* tile_e; const LAS int* pt; const LAS int* cnt; const char* A; const char* B; size_t tstep; int brows; const LAS int* tokl; bool gather;
    __device__ __forceinline__ bool next(int i, Unit& u) const {
        const long L = (long)i * G + c; if (L >= (long)MT * nN) return false;
        tile_map((int)L, MT, nN, u.pm, u.pn); const int e = tile_e[u.pm]; u.e = e;
        u.b = B + ((size_t)e * brows + (size_t)u.pn * BM) / BM * tstep;
        if (gather) { u.a = A; u.gtab = tokl + i * BM; u.gcnt = BM; }
        else { u.a = A + (size_t)u.pm * tstep; u.gtab = nullptr; u.gcnt = 0; }
        return true; }
};

template <class Epi, class Sched, bool GATHER, bool FP8 = false, unsigned ASC = 0x7f7f7f7fu>
__device__ __forceinline__ void gemm_phase(LAS unsigned char* lds, const int K, const Sched& S, const Epi& E) {
    const int tid = opaque_tid(), wid = __builtin_amdgcn_readfirstlane(tid >> 6), lane = tid & 63, wr = wid >> 2, wc = wid & 3, fr = lane & 15, fq = lane >> 4;
    const int nt = K / BK;
    unsigned voffA[2], voffB[2]; int RA[2]; unsigned CA2[2];
#pragma unroll
    for (int i = 0; i < 2; ++i) { int R, C; stage_rc(tid * 16 + i * 8192, R, C); voffA[i] = (unsigned)(R * K + C) * 2u; voffB[i] = voffA[i]; RA[i] = R; CA2[i] = (unsigned)C * 2u; }
    const size_t kstep = (size_t)(BK * 2);
    const size_t hstep = (size_t)HALF * K * 2;
    const unsigned ldsw = (unsigned)wid * 1024u;
    const int aoff = lds_byte(wr * 64 + fr, fq * 8), boff = lds_byte(wc * 32 + fr, fq * 8);
#define PG8_SA(b, h) (((b) * 2 + (h)) * HTB)
#define PG8_SB(b, h) ((4 + (b) * 2 + (h)) * HTB)
#define PG8_STAGE(bufoff, gbase, voff) do { _Pragma("unroll") for (int _i = 0; _i < 2; ++_i) \
        __builtin_amdgcn_global_load_lds((const unsigned*)((const char*)(gbase) + (voff)[_i]), (LAS unsigned*)(lds + (bufoff) + ldsw + _i * 8192), 16, 0, 0); } while (0)
#define PG8_STAGE_A(bufoff, gbase, h, NXT) do { if constexpr (GATHER) { unsigned _v[2]; _v[0] = (NXT) ? nv[h][0] : cv[h][0]; _v[1] = (NXT) ? nv[h][1] : cv[h][1]; PG8_STAGE(bufoff, gbase, _v); } \
        else { PG8_STAGE(bufoff, (const char*)(gbase) + (h) * hstep, voffA); } } while (0)
#define PG8_LOADG(u, v) do { _Pragma("unroll") for (int _h = 0; _h < 2; ++_h) _Pragma("unroll") for (int _i = 0; _i < 2; ++_i) { const int _r = _h * HALF + RA[_i]; \
        const int _tok = (u).gtab[_r]; v[_h][_i] = (unsigned)_tok * (unsigned)(K * 2) + CA2[_i]; } } while (0)
#define PG8_LDA(dst, b, h) do { _Pragma("unroll") for (int m = 0; m < 4; ++m) _Pragma("unroll") for (int k = 0; k < 2; ++k) dst[m][k] = *(const LAS bf16x8*)(lds + PG8_SA(b, h) + aoff + m * 2048 + k * 1024); } while (0)
#define PG8_LDB(dst, b, h) do { _Pragma("unroll") for (int n = 0; n < 2; ++n) _Pragma("unroll") for (int k = 0; k < 2; ++k) dst[n][k] = *(const LAS bf16x8*)(lds + PG8_SB(b, h) + boff + n * 2048 + k * 1024); } while (0)
#define PG8_CAT(x) __builtin_shufflevector(__builtin_bit_cast(i32x4_t, x[0]), __builtin_bit_cast(i32x4_t, x[1]), 0, 1, 2, 3, 4, 5, 6, 7)
#define PG8_MMA(ai, bj, At, Bt) do { __builtin_amdgcn_s_setprio(1); if constexpr (FP8) { _Pragma("unroll") for (int m = 0; m < 4; ++m) _Pragma("unroll") for (int n = 0; n < 2; ++n) \
        asm volatile("v_mfma_scale_f32_16x16x128_f8f6f4 %0, %1, %2, %0, %3, %4 op_sel_hi:[0,0,0]" : "+v"(acc[ai][bj][m][n]) : "v"(PG8_CAT(Bt[n])), "v"(PG8_CAT(At[m])), "v"(0x7a7a7a7a), "v"(ASC)); } \
        else { _Pragma("unroll") for (int m = 0; m < 4; ++m) _Pragma("unroll") for (int n = 0; n < 2; ++n) _Pragma("unroll") for (int k = 0; k < 2; ++k) \
        acc[ai][bj][m][n] = __builtin_amdgcn_mfma_f32_16x16x32_bf16(Bt[n][k], At[m][k], acc[ai][bj][m][n], 0, 0, 0); } __builtin_amdgcn_s_setprio(0); } while (0)
#define PG8_WAIT_V(n) asm volatile("s_waitcnt vmcnt(" #n ")" ::: "memory")
#define PG8_WAIT_L(n) asm volatile("s_waitcnt lgkmcnt(" #n ")" ::: "memory")
#define PG8_BAR __builtin_amdgcn_s_barrier()
#define PG8_SCHED __builtin_amdgcn_sched_barrier(0)
    Unit cur, nxt; int ui = 0;
    if (!S.next(0, cur)) return;
    f32x4 acc[2][2][4][2];
    typename Epi::Nxt nx;
    bf16x8 At[4][2], B0[2][2], B1[2][2];
    unsigned cv[2][2] = {{0u, 0u}, {0u, 0u}}, nv[2][2] = {{0u, 0u}, {0u, 0u}};
    const char* cA = cur.a; const char* cB = cur.b;
    if constexpr (GATHER) { PG8_LOADG(cur, cv); }
    PG8_STAGE(PG8_SB(0, 0), cB, voffB); PG8_STAGE(PG8_SB(0, 1), cB + hstep, voffB); PG8_STAGE_A(PG8_SA(0, 0), cA, 0, false); PG8_STAGE_A(PG8_SA(0, 1), cA, 1, false);
    E.fetch(cur, wr, wc, fr, fq, nx);
    E.init(acc, nx);
    if (wr == 1) PG8_BAR;
    PG8_WAIT_V(2); PG8_BAR;
    PG8_STAGE(PG8_SB(1, 0), cB + kstep, voffB); PG8_STAGE_A(PG8_SA(1, 0), cA + kstep, 0, false); PG8_STAGE(PG8_SB(1, 1), cB + hstep + kstep, voffB);
    PG8_WAIT_V(6); PG8_BAR;
    for (;;) {
        const bool has_next = S.next(ui + 1, nxt);
        const char* nA = has_next ? nxt.a : cA; const char* nB = has_next ? nxt.b : cB;
        if constexpr (GATHER) {
            if (has_next) { PG8_LOADG(nxt, nv); }
            else {
#pragma unroll
                for (int h = 0; h < 2; ++h)
#pragma unroll
                    for (int i = 0; i < 2; ++i) nv[h][i] = cv[h][i]; }
        }
#pragma clang loop unroll(disable)
        for (int t = 0; t < nt; t += 2) {
            const bool last = (t == nt - 2);
            const char* a1 = cA + (size_t)(t + 1) * kstep;
            const char* a2 = last ? nA : cA + (size_t)(t + 2) * kstep; const char* b2 = last ? nB : cB + (size_t)(t + 2) * kstep;
            const char* a3 = a2 + kstep; const char* b3 = b2 + kstep;
            PG8_LDB(B0, 0, 0); PG8_LDB(B1, 0, 1); PG8_SCHED; PG8_LDA(At, 0, 0); PG8_STAGE_A(PG8_SA(1, 1), a1, 1, false);
            PG8_WAIT_V(8); PG8_WAIT_L(0); PG8_BAR; PG8_MMA(0, 0, At, B0); PG8_MMA(0, 1, At, B1); PG8_BAR; PG8_SCHED;
            PG8_LDA(At, 0, 1); PG8_STAGE(PG8_SB(0, 0), b2, voffB); PG8_STAGE(PG8_SB(0, 1), b2 + hstep, voffB); PG8_STAGE_A(PG8_SA(0, 0), a2, 0, last);
            PG8_WAIT_V(8); PG8_WAIT_L(0); PG8_BAR; PG8_MMA(1, 0, At, B0); PG8_MMA(1, 1, At, B1); PG8_BAR; PG8_SCHED;
            PG8_LDB(B0, 1, 0); PG8_LDB(B1, 1, 1); PG8_SCHED; PG8_LDA(At, 1, 0); PG8_STAGE_A(PG8_SA(0, 1), a2, 1, last);
            PG8_WAIT_V(8); PG8_WAIT_L(0); PG8_BAR; PG8_MMA(0, 0, At, B0); PG8_MMA(0, 1, At, B1); PG8_BAR; PG8_SCHED;
            PG8_LDA(At, 1, 1); PG8_STAGE(PG8_SB(1, 0), b3, voffB); PG8_STAGE(PG8_SB(1, 1), b3 + hstep, voffB); PG8_STAGE_A(PG8_SA(1, 0), a3, 0, last);
            PG8_WAIT_V(8); PG8_WAIT_L(0); PG8_BAR; PG8_MMA(1, 0, At, B0); PG8_MMA(1, 1, At, B1); PG8_BAR; PG8_SCHED;
        }
        if constexpr (FP8) asm volatile("s_nop 15\n\ts_nop 7" ::: "memory");
        if (wr == 0) PG8_BAR;
        bool keep = false;
        if constexpr (Epi::PAIR_KEEP) keep = (cur.e == 0);
        if constexpr (!Epi::FETCH_LATE) E.fetch(has_next ? nxt : cur, wr, wc, fr, fq, nx);
        if constexpr (Epi::PAIR_KEEP) { if (keep) E.rescale(acc, cur, wr, wc, fr, fq); else E(acc, cur, wr, wc, fr, fq); } else E(acc, cur, wr, wc, fr, fq);
        if (!has_next) break;
        if constexpr (Epi::FETCH_LATE) E.fetch(nxt, wr, wc, fr, fq, nx);
        if (!keep) E.init(acc, nx);
        cur = nxt; cA = nA; cB = nB; ++ui;
        if constexpr (GATHER) {
#pragma unroll
            for (int h = 0; h < 2; ++h)
#pragma unroll
                for (int i = 0; i < 2; ++i) cv[h][i] = nv[h][i]; }
        if (wr == 1) PG8_BAR;
    }
    PG8_WAIT_V(0);
    PG8_BAR;
#undef PG8_SA
#undef PG8_SB
#undef PG8_STAGE
#undef PG8_STAGE_A
#undef PG8_LOADG
#undef PG8_LDA
#undef PG8_LDB
#undef PG8_MMA
#undef PG8_CAT
#undef PG8_WAIT_V
#undef PG8_WAIT_L
#undef PG8_BAR
#undef PG8_SCHED
}
}

namespace epi {
using pg8::Unit;
__device__ __forceinline__ u32x4 pack8(const f32x4& a, const f32x4& b) { u32x4 w; w.x = cvt_pk_bf16(a[0], a[1]); w.y = cvt_pk_bf16(a[2], a[3]); w.z = cvt_pk_bf16(b[0], b[1]); w.w = cvt_pk_bf16(b[2], b[3]); return w; }
__device__ __forceinline__ void unpack8(const u32x4& w, float (&f)[8]) { f[0] = bf_lo(w.x); f[1] = bf_hi(w.x); f[2] = bf_lo(w.y); f[3] = bf_hi(w.y); f[4] = bf_lo(w.z); f[5] = bf_hi(w.z); f[6] = bf_lo(w.w); f[7] = bf_hi(w.w); }
__device__ __forceinline__ float sigmoidf_(float z) { return __builtin_amdgcn_rcpf(1.0f + __expf(-z)); }

struct EpiIn {
    static constexpr bool PAIR_KEEP = false; static constexpr bool FETCH_LATE = false;
    struct Nxt {}; __device__ __forceinline__ void fetch(const Unit&, int, int, int, int, Nxt&) const {}
    __device__ __forceinline__ void init(f32x4 (&acc)[2][2][4][2], const Nxt&) const {
#pragma unroll
        for (int a = 0; a < 2; ++a)
#pragma unroll
            for (int b = 0; b < 2; ++b)
#pragma unroll
                for (int m = 0; m < 4; ++m)
#pragma unroll
                    for (int n = 0; n < 2; ++n) acc[a][b][m][n] = (f32x4){0.f, 0.f, 0.f, 0.f}; }
    bf16_t *QA, *KA, *VA, *QF, *KF, *VF; unsigned char* GT; const int* pos; const float *qn_s, *kn_s, *qn_f, *kn_f, *b_gate;
    __device__ __forceinline__ void operator()(const f32x4 (&acc)[2][2][4][2], const Unit& u, int wr, int wc, int fr, int fq) const {
        const int pn = u.pn; const int row0 = u.pm * 256 + wr * 64 + fr;
        if (pn >= 9) {
            const int col0 = (pn - 9) * 256 + wc * 64 + 16 * fq;
            f32x4 bv[2][2];
#pragma unroll
            for (int bj = 0; bj < 2; ++bj)
#pragma unroll
                for (int n = 0; n < 2; ++n) bv[bj][n] = *(const f32x4*)(b_gate + col0 + bj * 8 + 4 * n) * (-LOG2E);
            const f32x2 nl2e2 = splat2(-LOG2E), one2 = splat2(1.0f), c255 = splat2(255.0f), half2 = splat2(0.5f);
#pragma unroll
            for (int ai = 0; ai < 2; ++ai)
#pragma unroll
                for (int m = 0; m < 4; ++m) { u32x4 w;
#pragma unroll
                    for (int bj = 0; bj < 2; ++bj)
#pragma unroll
                        for (int n = 0; n < 2; ++n) { const f32x4 v = acc[ai][bj][m][n]; unsigned r = 0;
#pragma unroll
                            for (int hh = 0; hh < 2; ++hh) {
                                const f32x2 t = pk_fma2((f32x2){v[2 * hh], v[2 * hh + 1]}, nl2e2, (f32x2){bv[bj][n][2 * hh], bv[bj][n][2 * hh + 1]});
                                const f32x2 d = pk_add2((f32x2){__builtin_amdgcn_exp2f(t[0]), __builtin_amdgcn_exp2f(t[1])}, one2);
                                const f32x2 q = pk_fma2((f32x2){__builtin_amdgcn_rcpf(d[0]), __builtin_amdgcn_rcpf(d[1])}, c255, half2);
                                r = __builtin_amdgcn_cvt_pk_u8_f32(q[0], 2 * hh, r); r = __builtin_amdgcn_cvt_pk_u8_f32(q[1], 2 * hh + 1, r); }
                            w[2 * bj + n] = r; }
                    *(u32x4*)(GT + (size_t)(row0 + ai * 128 + m * 16) * 2048 + col0) = w; }
            return;
        }
        bf16_t* dst; int pitch, hcol; const float* nw; bool rope; float scale;
        if (pn < 2)       { dst = QA; pitch = 512; hcol = (4 * pn + wc) * 64; nw = qn_s; rope = true; scale = C2; }
        else if (pn == 2) { if (wc < 2) { dst = KA; pitch = 128; hcol = wc * 64; nw = kn_s; rope = true; scale = 1.f; } else { dst = VA; pitch = 128; hcol = (wc - 2) * 64; nw = nullptr; rope = false; scale = 1.f; } }
        else if (pn < 5)  { dst = QF; pitch = 512; hcol = (4 * (pn - 3) + wc) * 64; nw = qn_f; rope = false; scale = C2; }
        else if (pn < 7)  { dst = KF; pitch = 512; hcol = (4 * (pn - 5) + wc) * 64; nw = kn_f; rope = false; scale = 1.f; }
        else              { dst = VF; pitch = 512; hcol = (4 * (pn - 7) + wc) * 64; nw = nullptr; rope = false; scale = 1.f; }
        f32x4 wv[2][2]; float inv[2][4];
#pragma unroll
        for (int bj = 0; bj < 2; ++bj)
#pragma unroll
            for (int n = 0; n < 2; ++n) { wv[bj][n] = nw ? *(const f32x4*)(nw + 32 * bj + 8 * fq + 4 * n) : (f32x4){1.f, 1.f, 1.f, 1.f}; wv[bj][n] = wv[bj][n] * scale; }
#pragma unroll
        for (int n = 0; n < 2; ++n)
#pragma unroll
            for (int i = 0; i < 4; ++i) inv[n][i] = exp2f(-(float)(8 * fq + 4 * n + i) * (13.287712379549449f / 32.0f)) * 0.15915494309189535f;
        float posf[8];
#pragma unroll
        for (int g = 0; g < 8; ++g) posf[g] = rope ? (float)pos[row0 + (g >> 2) * 128 + (g & 3) * 16] : 0.f;
#pragma unroll
        for (int ai = 0; ai < 2; ++ai)
#pragma unroll
            for (int m = 0; m < 4; ++m) {
                const int row = row0 + ai * 128 + m * 16;
                f32x4 v[2][2];
#pragma unroll
                for (int bj = 0; bj < 2; ++bj)
#pragma unroll
                    for (int n = 0; n < 2; ++n) v[bj][n] = acc[ai][bj][m][n];
                if (nw) {
                    float ss = 0.f;
#pragma unroll
                    for (int bj = 0; bj < 2; ++bj)
#pragma unroll
                        for (int n = 0; n < 2; ++n) ss += (v[bj][n][0] * v[bj][n][0] + v[bj][n][1] * v[bj][n][1]) + (v[bj][n][2] * v[bj][n][2] + v[bj][n][3] * v[bj][n][3]);
                    ss += __shfl_xor(ss, 16); ss += __shfl_xor(ss, 32);
                    const float rstd = rsqrtf(ss * (1.0f / 64.0f) + EPS);
#pragma unroll
                    for (int bj = 0; bj < 2; ++bj)
#pragma unroll
                        for (int n = 0; n < 2; ++n) v[bj][n] = v[bj][n] * rstd * wv[bj][n];
                }
                if (rope) {
                    const float p = posf[ai * 4 + m];
#pragma unroll
                    for (int n = 0; n < 2; ++n)
#pragma unroll
                        for (int i = 0; i < 4; ++i) { float rev = p * inv[n][i]; rev = rev - floorf(rev); const float sn = __builtin_amdgcn_sinf(rev), cs = __builtin_amdgcn_cosf(rev);
                            const float x1 = v[0][n][i], x2 = v[1][n][i]; v[0][n][i] = x1 * cs - x2 * sn; v[1][n][i] = x2 * cs + x1 * sn; }
                }
                bf16_t* rowp = dst + (size_t)row * pitch + hcol + 8 * fq;
                *(u32x4*)(rowp) = pack8(v[0][0], v[0][1]);
                *(u32x4*)(rowp + 32) = pack8(v[1][0], v[1][1]);
            }
    }
};

struct EpiMerge {
    static constexpr bool FETCH_LATE = false;
    struct Nxt {}; __device__ __forceinline__ void fetch(const Unit&, int, int, int, int, Nxt&) const {}
    __device__ __forceinline__ void init(f32x4 (&acc)[2][2][4][2], const Nxt&) const {
#pragma unroll
        for (int a = 0; a < 2; ++a)
#pragma unroll
            for (int b = 0; b < 2; ++b)
#pragma unroll
                for (int m = 0; m < 4; ++m)
#pragma unroll
                    for (int n = 0; n < 2; ++n) acc[a][b][m][n] = (f32x4){0.f, 0.f, 0.f, 0.f}; }
    static constexpr bool PAIR_KEEP = (P3B_FP8 != 0);
    const unsigned char* GT; bf16_t* MG; unsigned char* MG8;
    __device__ __forceinline__ void rescale(f32x4 (&acc)[2][2][4][2], const Unit& u, int wr, int wc, int fr, int fq) const {
        const int row0 = u.pm * 256 + wr * 64 + fr, colw = u.pn * 256 + wc * 64 + 16 * fq;
#pragma unroll
        for (int hf = 0; hf < 2; ++hf) {
            u32x4 ga16[4], gb16[4];
#pragma unroll
            for (int m = 0; m < 4; ++m) { const unsigned char* p = GT + (size_t)(row0 + hf * 128 + m * 16) * 2048 + colw; ga16[m] = *(const u32x4*)p; gb16[m] = *(const u32x4*)(p + 1024); }
#pragma unroll
            for (int m = 0; m < 4; ++m)
#pragma unroll
                for (int bj = 0; bj < 2; ++bj)
#pragma unroll
                    for (int n = 0; n < 2; ++n) { const unsigned ga = ga16[m][2 * bj + n], gb = gb16[m][2 * bj + n];
#pragma unroll
                        for (int i = 0; i < 4; ++i) acc[hf][bj][m][n][i] *= (float)((ga >> (8 * i)) & 255u) * __builtin_amdgcn_rcpf(fmaxf((float)((gb >> (8 * i)) & 255u), 0.5f)); }
            __builtin_amdgcn_sched_barrier(0);
        }
    }
    __device__ __forceinline__ void operator()(const f32x4 (&acc)[2][2][4][2], const Unit& u, int wr, int wc, int fr, int fq) const {
        const int row0 = u.pm * 256 + wr * 64 + fr, col0 = u.pn * 256 + wc * 32 + 8 * fq, part = u.e;
        if constexpr (PAIR_KEEP) {
            const int colw = u.pn * 256 + wc * 64 + 16 * fq;
            u32x4 gb16[8];
#pragma unroll
            for (int g = 0; g < 8; ++g) gb16[g] = *(const u32x4*)(GT + (size_t)(row0 + (g >> 2) * 128 + (g & 3) * 16) * 2048 + 1024 + colw);
            asm volatile("" ::: "memory");
#pragma unroll
            for (int g = 0; g < 8; ++g) { float f[16];
#pragma unroll
                for (int bj = 0; bj < 2; ++bj)
#pragma unroll
                    for (int n = 0; n < 2; ++n) { const unsigned gb = gb16[g][2 * bj + n]; const f32x4 v = acc[g >> 2][bj][g & 3][n];
#pragma unroll
                        for (int i = 0; i < 4; ++i) f[8 * bj + 4 * n + i] = v[i] * (fmaxf((float)((gb >> (8 * i)) & 255u), 0.5f) * (32.0f / 255.0f)); }
                u32x4 w8; w8.x = pk4_fp8(f[0], f[1], f[2], f[3]); w8.y = pk4_fp8(f[4], f[5], f[6], f[7]); w8.z = pk4_fp8(f[8], f[9], f[10], f[11]); w8.w = pk4_fp8(f[12], f[13], f[14], f[15]);
                *(u32x4*)(MG8 + (size_t)(row0 + (g >> 2) * 128 + (g & 3) * 16) * 1024 + colw) = w8; }
            return;
        }
        u32x2 g8[8][2]; u32x4 mg[8][2];
#define EM_ROW(g) (row0 + ((g) >> 2) * 128 + ((g) & 3) * 16)
#define EM_LDMG(g) do { _Pragma("unroll") for (int bj = 0; bj < 2; ++bj) mg[g][bj] = part ? *(const u32x4*)(MG + (size_t)EM_ROW(g) * 1024 + col0 + bj * 128) : (u32x4){0u, 0u, 0u, 0u}; } while (0)
#pragma unroll
        for (int g = 0; g < 8; ++g)
#pragma unroll
            for (int bj = 0; bj < 2; ++bj) g8[g][bj] = *(const u32x2*)(GT + (size_t)EM_ROW(g) * 2048 + part * 1024 + col0 + bj * 128);
        EM_LDMG(0); EM_LDMG(1);
        asm volatile("" ::: "memory");
#pragma unroll
        for (int g = 0; g < 8; ++g) {
            u32x4 ov[2];
#pragma unroll
            for (int bj = 0; bj < 2; ++bj) { const unsigned ga = g8[g][bj].x, gb = g8[g][bj].y; float o[8]; unpack8(mg[g][bj], o);
                f32x4 v0 = acc[g >> 2][bj][g & 3][0], v1 = acc[g >> 2][bj][g & 3][1];
#pragma unroll
                for (int i = 0; i < 4; ++i) { v0[i] = v0[i] * ((float)((ga >> (8 * i)) & 255u) * (1.0f / 255.0f)) + o[i]; v1[i] = v1[i] * ((float)((gb >> (8 * i)) & 255u) * (1.0f / 255.0f)) + o[4 + i]; }
                ov[bj] = pack8(v0, v1); }
            if (g + 2 < 8) { EM_LDMG(g + 2); }
            asm volatile("" ::: "memory");
#pragma unroll
            for (int bj = 0; bj < 2; ++bj) {
                if (P3B_FP8 && part) { float f[8]; unpack8(ov[bj], f); u32x2 w8; w8.x = pk4_fp8(f[0] * 32.0f, f[1] * 32.0f, f[2] * 32.0f, f[3] * 32.0f); w8.y = pk4_fp8(f[4] * 32.0f, f[5] * 32.0f, f[6] * 32.0f, f[7] * 32.0f);
                    *(u32x2*)(MG8 + (size_t)EM_ROW(g) * 1024 + col0 + bj * 128) = w8; }
                else *(u32x4*)(MG + (size_t)EM_ROW(g) * 1024 + col0 + bj * 128) = ov[bj]; }
            asm volatile("" ::: "memory");
        }
#undef EM_ROW
#undef EM_LDMG
    }
};

struct EpiResid {
    static constexpr bool PAIR_KEEP = false; static constexpr bool FETCH_LATE = true;
    struct Nxt { u32x4 xn[8][2]; float rm[8]; f32x4 ig[2][2]; };
    const float* X; bf16_t* O; const bf16_t* XN; const float* RMS; const float* G1; bool rec;
    __device__ __forceinline__ void fetch(const Unit& u, int wr, int wc, int fr, int fq, Nxt& p) const {
        const int row0 = u.pm * 256 + wr * 64 + fr, col0 = u.pn * 256 + wc * 32 + 8 * fq;
#pragma unroll
        for (int g = 0; g < 8; ++g) { const int row = row0 + (g >> 2) * 128 + (g & 3) * 16; p.rm[g] = RMS[row];
#pragma unroll
            for (int bj = 0; bj < 2; ++bj) p.xn[g][bj] = *(const u32x4*)(XN + (size_t)row * 1024 + col0 + bj * 128); }
#pragma unroll
        for (int bj = 0; bj < 2; ++bj)
#pragma unroll
            for (int n = 0; n < 2; ++n) p.ig[bj][n] = *(const f32x4*)(G1 + col0 + bj * 128 + 4 * n); }
    __device__ __forceinline__ void init(f32x4 (&acc)[2][2][4][2], const Nxt& p) const {
        if (XREC != 0 && rec) {
            f32x4 ig[2][2];
#pragma unroll
            for (int bj = 0; bj < 2; ++bj)
#pragma unroll
                for (int n = 0; n < 2; ++n)
#pragma unroll
                    for (int i = 0; i < 4; ++i) ig[bj][n][i] = __builtin_amdgcn_rcpf(p.ig[bj][n][i]);
#pragma unroll
            for (int g = 0; g < 8; ++g)
#pragma unroll
                for (int bj = 0; bj < 2; ++bj) { float f[8]; unpack8(p.xn[g][bj], f);
#pragma unroll
                    for (int i = 0; i < 4; ++i) { acc[g >> 2][bj][g & 3][0][i] = f[i] * p.rm[g] * ig[bj][0][i]; acc[g >> 2][bj][g & 3][1][i] = f[4 + i] * p.rm[g] * ig[bj][1][i]; } }
        } else {
#pragma unroll
            for (int a = 0; a < 2; ++a)
#pragma unroll
                for (int b = 0; b < 2; ++b)
#pragma unroll
                    for (int m = 0; m < 4; ++m)
#pragma unroll
                        for (int n = 0; n < 2; ++n) acc[a][b][m][n] = (f32x4){0.f, 0.f, 0.f, 0.f}; } }
    __device__ __forceinline__ void operator()(const f32x4 (&acc)[2][2][4][2], const Unit& u, int wr, int wc, int fr, int fq) const {
        const int row0 = u.pm * 256 + wr * 64 + fr, col0 = u.pn * 256 + wc * 32 + 8 * fq;
#define ER_OFF(g) ((size_t)(row0 + ((g) >> 2) * 128 + ((g) & 3) * 16) * 1024 + col0)
        if (XREC != 0 && rec) {
#pragma unroll
            for (int g = 0; g < 8; ++g)
#pragma unroll
                for (int bj = 0; bj < 2; ++bj) { *(u32x4*)(O + ER_OFF(g) + bj * 128) = pack8(acc[g >> 2][bj][g & 3][0], acc[g >> 2][bj][g & 3][1]); __builtin_amdgcn_sched_barrier(0); }
        } else {
        f32x4 xr[8][2][2];
#define ER_LD(g) do { _Pragma("unroll") for (int bj = 0; bj < 2; ++bj) _Pragma("unroll") for (int n = 0; n < 2; ++n) xr[g][bj][n] = *(const f32x4*)(X + ER_OFF(g) + bj * 128 + n * 4); } while (0)
        ER_LD(0); ER_LD(1); ER_LD(2);
        asm volatile("" ::: "memory");
#pragma unroll
        for (int g = 0; g < 8; ++g) {
            u32x4 ov[2];
#pragma unroll
            for (int bj = 0; bj < 2; ++bj) ov[bj] = pack8(xr[g][bj][0] + acc[g >> 2][bj][g & 3][0], xr[g][bj][1] + acc[g >> 2][bj][g & 3][1]);
            if (g + 3 < 8) { ER_LD(g + 3); }
            asm volatile("" ::: "memory");
#pragma unroll
            for (int bj = 0; bj < 2; ++bj) *(u32x4*)(O + ER_OFF(g) + bj * 128) = ov[bj];
            asm volatile("" ::: "memory");
        }
#undef ER_LD
        }
#undef ER_OFF
    }
};

struct EpiSwiglu {
    static constexpr bool PAIR_KEEP = false; static constexpr bool FETCH_LATE = false;
    const float* bgu; unsigned char* ACT;
    struct Nxt { f32x4 bg[2], bu[2]; };
    __device__ __forceinline__ void fetch(const Unit& u, int wr, int wc, int fr, int fq, Nxt& p) const {
        const int f0 = u.pn * 128 + wc * 32 + 8 * fq; const float* be = bgu + (size_t)u.e * 2048;
#pragma unroll
        for (int n = 0; n < 2; ++n) { p.bg[n] = *(const f32x4*)(be + f0 + 4 * n); p.bu[n] = *(const f32x4*)(be + 1024 + f0 + 4 * n); } }
    __device__ __forceinline__ void init(f32x4 (&acc)[2][2][4][2], const Nxt& p) const {
#pragma unroll
        for (int a = 0; a < 2; ++a)
#pragma unroll
            for (int m = 0; m < 4; ++m)
#pragma unroll
                for (int n = 0; n < 2; ++n) { acc[a][0][m][n] = p.bg[n] * SWIGLU_CG; acc[a][1][m][n] = p.bu[n] + 1.0f; } }
    __device__ __forceinline__ void operator()(const f32x4 (&acc)[2][2][4][2], const Unit& u, int wr, int wc, int fr, int fq) const {
        const int row0 = u.pm * 256 + wr * 64 + fr, f0 = u.pn * 128 + wc * 32 + 8 * fq; const float* be = bgu + (size_t)u.e * 2048;
        const bool oddq = (fq & 1) != 0; const f32x2 one2 = splat2(1.0f);
#pragma unroll
        for (int ai = 0; ai < 2; ++ai)
#pragma unroll
            for (int mp = 0; mp < 2; ++mp) { u32x2 w[2];
#pragma unroll
                for (int mm = 0; mm < 2; ++mm) { const int m = 2 * mp + mm; f32x4 o[2];
#pragma unroll
                    for (int n = 0; n < 2; ++n) { const f32x4 g = acc[ai][0][m][n], uu = acc[ai][1][m][n];
                        f32x4 gc, up, e;
#pragma unroll
                        for (int i = 0; i < 4; ++i) { gc[i] = __builtin_amdgcn_fmed3f(g[i], -3.0e38f, 7.0f * SWIGLU_CG); up[i] = __builtin_amdgcn_fmed3f(uu[i], -6.0f, 8.0f); e[i] = __builtin_amdgcn_exp2f(-gc[i]); }
                        const f32x2 d0 = pk_add2((f32x2){e[0], e[1]}, one2), d1 = pk_add2((f32x2){e[2], e[3]}, one2);
                        const f32x4 r = {__builtin_amdgcn_rcpf(d0[0]), __builtin_amdgcn_rcpf(d0[1]), __builtin_amdgcn_rcpf(d1[0]), __builtin_amdgcn_rcpf(d1[1])};
                        o[n] = (gc * r) * up; }
                    w[mm].x = pk4_fp8_nc(o[0][0], o[0][1], o[0][2], o[0][3]); w[mm].y = pk4_fp8_nc(o[1][0], o[1][1], o[1][2], o[1][3]); }
                const auto sx = __builtin_amdgcn_permlane16_swap(w[0].x, w[1].x, false, false), sy = __builtin_amdgcn_permlane16_swap(w[0].y, w[1].y, false, false);
                u32x4 v; v.x = sx[0]; v.y = sy[0]; v.z = sx[1]; v.w = sy[1];
                const int row = row0 + ai * 128 + (2 * mp + (oddq ? 1 : 0)) * 16, fc = oddq ? f0 - 8 : f0;
                *(u32x4*)(ACT + (size_t)row * 1024 + fc) = v; }
    }
};

struct EpiDown {
    static constexpr bool PAIR_KEEP = false; static constexpr bool FETCH_LATE = false;
    const float* bd; unsigned char* YB;
    struct Nxt { f32x4 bv[2][2]; };
    __device__ __forceinline__ void fetch(const Unit& u, int wr, int wc, int fr, int fq, Nxt& p) const {
        const int col0 = u.pn * 256 + wc * 64 + 16 * fq; const float* be = bd + (size_t)u.e * 1024;
#pragma unroll
        for (int bj = 0; bj < 2; ++bj)
#pragma unroll
            for (int n = 0; n < 2; ++n) p.bv[bj][n] = *(const f32x4*)(be + col0 + bj * 8 + 4 * n); }
    __device__ __forceinline__ void init(f32x4 (&acc)[2][2][4][2], const Nxt& p) const {
#pragma unroll
        for (int a = 0; a < 2; ++a)
#pragma unroll
            for (int b = 0; b < 2; ++b)
#pragma unroll
                for (int m = 0; m < 4; ++m)
#pragma unroll
                    for (int n = 0; n < 2; ++n) acc[a][b][m][n] = p.bv[b][n]; }
    __device__ __forceinline__ void operator()(const f32x4 (&acc)[2][2][4][2], const Unit& u, int wr, int wc, int fr, int fq) const {
        const int row0 = u.pm * 256 + wr * 64 + fr, col0 = u.pn * 256 + wc * 64 + 16 * fq; const float* be = bd + (size_t)u.e * 1024;
#pragma unroll
        for (int ai = 0; ai < 2; ++ai)
#pragma unroll
            for (int m = 0; m < 4; ++m) { u32x4 w;
                { const f32x4 v0 = acc[ai][0][m][0], v1 = acc[ai][0][m][1]; w.x = pk4_fp8(v0[0], v0[1], v0[2], v0[3]); w.y = pk4_fp8(v1[0], v1[1], v1[2], v1[3]); }
                { const f32x4 v0 = acc[ai][1][m][0], v1 = acc[ai][1][m][1]; w.z = pk4_fp8(v0[0], v0[1], v0[2], v0[3]); w.w = pk4_fp8(v1[0], v1[1], v1[2], v1[3]); }
                *(u32x4*)(YB + (size_t)(row0 + ai * 128 + m * 16) * 1024 + col0) = w; }
    }
};
}

namespace attn_body {
using bf16 = __hip_bfloat16;
constexpr int QP = 512;
constexpr int NW = 8, QBLK = 32, QB = QBLK * NW, KVBLK = 64;
constexpr float NEGV = -1.0e30f;
__device__ __forceinline__ int crow(int r, int hi) { return (r & 3) + 8 * (r >> 2) + 4 * hi; }
#define SBAR() __builtin_amdgcn_sched_barrier(0)
__device__ __forceinline__ void cmask(f32x16& p0, f32x16& p1, int jb, int qrel, int hi) {
    int d = qrel - (64 * jb + 4 * hi); asm volatile("" : "+v"(d));
#pragma unroll
    for (int r = 0; r < 16; ++r) { const int c = (r & 3) + 8 * (r >> 2); if (d < c) p0[r] = NEGV; if (d < c + 32) p1[r] = NEGV; }
}
__device__ __forceinline__ void wmask(f32x16& p0, f32x16& p1, int jb, int qrel, int hi) {
    int d = qrel - (64 * jb + 4 * hi); asm volatile("" : "+v"(d));
#pragma unroll
    for (int r = 0; r < 16; ++r) { const int c = (r & 3) + 8 * (r >> 2); if ((unsigned)(d - c) > 127u) p0[r] = NEGV; if ((unsigned)(d - c - 32) > 127u) p1[r] = NEGV; }
}
constexpr int NSLOT = 3, SLOTB = 8192;
constexpr int LDS_K = 0, LDS_V = NSLOT * SLOTB, LDS_WS = 2 * NSLOT * SLOTB, LDS_OST = LDS_WS + NW * 64 * 4, LDS_NCS = LDS_OST + NW * 4096, LDS_BYTES = LDS_NCS + SEQ * 4;
__device__ __forceinline__ void glds16(const void* gsrc, unsigned lds_dst) { unsigned keep;
    asm volatile("s_mov_b32 %0, m0\n\ts_mov_b32 m0, %2\n\ts_nop 0\n\tglobal_load_lds_dwordx4 %1, off\n\ts_mov_b32 m0, %0" : "=&s"(keep) : "v"(gsrc), "s"(lds_dst) : "memory"); }
#define WAIT_BAR(N) asm volatile("s_waitcnt vmcnt(" #N ") lgkmcnt(0)\n\ts_barrier" ::: "memory")
typedef LAS const char* lds_cptr;
typedef short v4i16_t __attribute__((ext_vector_type(4)));
__device__ __forceinline__ void kload8(bf16x8* kf, lds_cptr kp) {
    kf[0] = *(const LAS bf16x8*)(kp);        kf[1] = *(const LAS bf16x8*)(kp + 512);
    kf[2] = *(const LAS bf16x8*)(kp + 2048); kf[3] = *(const LAS bf16x8*)(kp + 2560);
    kf[4] = *(const LAS bf16x8*)(kp + 4096); kf[5] = *(const LAS bf16x8*)(kp + 4608);
    kf[6] = *(const LAS bf16x8*)(kp + 6144); kf[7] = *(const LAS bf16x8*)(kp + 6656);
}
__device__ __forceinline__ void kload2(bf16x8* kf, lds_cptr kp, int j) { kf[2 * j] = *(const LAS bf16x8*)(kp + j * 2048); kf[2 * j + 1] = *(const LAS bf16x8*)(kp + j * 2048 + 512); }
__device__ __forceinline__ s16x4 vtr(lds_cptr p) { return __builtin_bit_cast(s16x4, __builtin_amdgcn_ds_read_tr16_b64_v4i16((LAS v4i16_t*)p)); }
#define MX3(a, b, c) __builtin_fmaxf(__builtin_fmaxf((a), (b)), (c))
__device__ __forceinline__ float rowmax(const f32x16& p0, const f32x16& p1) {
    float a = MX3(p0[0], p0[1], p1[0]), b = MX3(p0[2], p0[3], p1[1]); a = MX3(a, p1[2], p1[3]);
#pragma unroll
    for (int r = 4; r < 16; r += 4) { a = MX3(a, p0[r], p0[r + 1]); b = MX3(b, p0[r + 2], p0[r + 3]); a = MX3(a, p1[r], p1[r + 1]); b = MX3(b, p1[r + 2], p1[r + 3]); }
    const float m = __builtin_fmaxf(a, b); auto rr = __builtin_amdgcn_permlane32_swap(__float_as_uint(m), __float_as_uint(m), false, false);
    return __builtin_fmaxf(__uint_as_float(rr[0]), __uint_as_float(rr[1]));
}
__device__ __forceinline__ void cinit_half(f32x16& c, float rowt, const LAS float* nc) {
#pragma unroll
    for (int g = 0; g < 4; ++g) { const f32x4 a = *(const LAS f32x4*)(nc + 8 * g);
#pragma unroll
        for (int j = 0; j < 4; ++j) c[4 * g + j] = rowt + a[j]; }
}
__device__ __forceinline__ void pv(f32x16* o, int vb, bf16x8 pa0, bf16x8 pa1, bf16x8 pa2, bf16x8 pa3) {
#pragma unroll
    for (int d0 = 0; d0 < 2; ++d0) { s16x4 lo[4], hi[4];
#pragma unroll
        for (int ks = 0; ks < 4; ++ks) {
            asm volatile("ds_read_b64_tr_b16 %0,%1 offset:%c2" : "=&v"(lo[ks]) : "v"(vb), "i"(d0 * 4096 + ks * 1024) : "memory");
            asm volatile("ds_read_b64_tr_b16 %0,%1 offset:%c2" : "=&v"(hi[ks]) : "v"(vb), "i"(d0 * 4096 + ks * 1024 + 512) : "memory"); }
        asm volatile("s_waitcnt lgkmcnt(0)" ::: "memory"); SBAR();
#define PK(k) (bf16x8){lo[k][0], lo[k][1], lo[k][2], lo[k][3], hi[k][0], hi[k][1], hi[k][2], hi[k][3]}
        o[d0] = __builtin_amdgcn_mfma_f32_32x32x16_bf16(pa0, PK(0), o[d0], 0, 0, 0);
        o[d0] = __builtin_amdgcn_mfma_f32_32x32x16_bf16(pa1, PK(1), o[d0], 0, 0, 0);
        o[d0] = __builtin_amdgcn_mfma_f32_32x32x16_bf16(pa2, PK(2), o[d0], 0, 0, 0);
        o[d0] = __builtin_amdgcn_mfma_f32_32x32x16_bf16(pa3, PK(3), o[d0], 0, 0, 0);
#undef PK
    }
}

struct NextU { const bf16* Kh; const bf16* Vh; const float* ncsg; int KP, t0, qb; };
__device__ __forceinline__ void prime_unit(const bf16* Kh, const bf16* Vh, const int KP, const int t0, const float* ncsg, const int qb, const unsigned lds0, const int lane, const int wid) {
    const bf16* ksrc = Kh + (long)(t0 * KVBLK + lane) * KP + wid * 8;
    const bf16* vsrc = Vh + (long)(t0 * KVBLK + 16 * (wid & 3) + (lane >> 2)) * KP + (wid >> 2) * 32 + (lane & 3) * 8;
    const unsigned kdst = lds0 + LDS_K + wid * 1024, vdst = lds0 + LDS_V + wid * 1024;
    glds16(ksrc, (unsigned)__builtin_amdgcn_readfirstlane(kdst)); glds16(vsrc, (unsigned)__builtin_amdgcn_readfirstlane(vdst)); glds16(ksrc + (long)KVBLK * KP, (unsigned)__builtin_amdgcn_readfirstlane(kdst + SLOTB));
    if (ncsg != nullptr) for (int i = (t0 >> 2) + wid; i <= qb; i += NW) glds16((const char*)ncsg + i * 1024 + lane * 16, (unsigned)__builtin_amdgcn_readfirstlane(lds0 + LDS_NCS + i * 1024));
}
struct P2Dec {
    const bf16 *KF, *VF, *KA, *VA; const float* NCS; const LAS int* ordl;
    static constexpr int QPOS = 2048 + 1536;
    __device__ __forceinline__ static int unit_of(int p) {
        if (p < 256) return p;
        if (p < 2048) { const int q = p - 256, g = q / 7, r = q - 7 * g; return (r == 0 || r == 2 || r == 4) ? 256 + 3 * g + (r >> 1) : -1; }
        const int q = p - 2048, pq = q / 3, pr = q - 3 * pq; return pr == 2 ? -1 : 1024 + 2 * pq + pr; }
    __device__ __forceinline__ static int chunk_of(int p) { if (p < 2048) { const int q = p - 256, g = q / 7, r = q - 7 * g; return 4 * g + (r == 6 ? 3 : (r >> 1)); } return 1024 + (p - 2048) / 3; }
    __device__ __forceinline__ NextU next(int p) const {
        NextU nx; nx.Kh = nullptr; nx.Vh = nullptr; nx.ncsg = nullptr; nx.KP = 0; nx.t0 = 0; nx.qb = 0;
        if (p >= QPOS) return nx;
        const int idx = unit_of(p);
        if (idx < 0) return nx;
        if (idx < 1024) { const int od = __builtin_amdgcn_readfirstlane(ordl[idx]), u = od & 0xffff, bh = u >> 5, b = bh >> 3, h = bh & 7;
            nx.Kh = KF + (size_t)b * SEQ * 512 + h * 64; nx.Vh = VF + (size_t)b * SEQ * 512 + h * 64; nx.ncsg = NCS + (size_t)bh * SEQ; nx.KP = 512; nx.t0 = od >> 16; nx.qb = u & 31; }
        else { const int u = idx - 1024, bk = u >> 7, qb = 127 - (u & 127), b = bk >> 1, kvh = bk & 1;
            nx.Kh = KA + (size_t)b * SEQ * 128 + kvh * 64; nx.Vh = VA + (size_t)b * SEQ * 128 + kvh * 64; nx.KP = 128; nx.t0 = qb < 2 ? 0 : qb - 2; nx.qb = qb; }
        return nx; }
};
template <int MODE, int THRL, bool TRK> __device__ __forceinline__ void attn_unit(int qb, int t0f, const bf16* Qh, const bf16* __restrict__ Kh, const bf16* __restrict__ Vh, bf16* Oh, const int KP, const float sinkl2, char* shm, const float* ncsg, const bool primed, const NextU nx1, const int pos1, const P2Dec& dec, volatile LAS int* qslot, const int qval, int& pos2, int& primed_pos) {
    const int tid = opaque_tid(), lane = tid & 63, r32 = lane & 31, hi = lane >> 5; const int wid = __builtin_amdgcn_readfirstlane(tid >> 6);
    const int q0 = MODE == 1 ? qb * 64 : qb * QB;
    const int t0 = (MODE == 1) ? (qb < 2 ? 0 : qb - 2) : t0f;
    const int NT = MODE == 1 ? 3 : (q0 + QB) / KVBLK - t0;
    const int wrow = MODE == 1 ? (wid & 1) * QBLK : wid * QBLK, wcol = MODE == 1 ? (wid >> 1) * 64 : 0;
    const int jdiag = MODE == 1 ? qb - t0 : NT - 4;
    const bf16* Qw = Qh + (long)(q0 + wrow) * QP + wcol;
    const unsigned lds0 = (unsigned)(uintptr_t)shm;
    float* wsf = (float*)(shm + LDS_WS) + wid * 64;
    const bf16* ksrc = Kh + (long)(t0 * KVBLK + lane) * KP + wid * 8;
    const bf16* vsrc = Vh + (long)(t0 * KVBLK + 16 * (wid & 3) + (lane >> 2)) * KP + (wid >> 2) * 32 + (lane & 3) * 8;
    const unsigned kdst = lds0 + LDS_K + wid * 1024, vdst = lds0 + LDS_V + wid * 1024;
    const long tstride = (long)KVBLK * KP;
#define DMA_K(t, slot) glds16(ksrc + (long)(t) * tstride, (unsigned)__builtin_amdgcn_readfirstlane(kdst + (slot)))
#define DMA_V(t, slot) glds16(vsrc + (long)(t) * tstride, (unsigned)__builtin_amdgcn_readfirstlane(vdst + (slot)))
    const int vb0 = (int)(lds0 + LDS_V) + ((lane >> 4) & 1) * 32 + (lane & 3) * 8 + (4 * hi + ((lane & 15) >> 2)) * 64;
    const char* Kbase = shm + LDS_K; bf16x8 kf[8];
    const lds_cptr shm3 = (lds_cptr)shm; const lds_cptr kp0 = shm3 + LDS_K + hi * 1024 + r32 * 16; const lds_cptr vp0 = shm3 + LDS_V + ((lane >> 4) & 1) * 32 + (lane & 3) * 8 + (4 * hi + ((lane & 15) >> 2)) * 64;
    const LAS float* ncs = (const LAS float*)(shm3 + LDS_NCS) + t0 * 64 + 4 * hi;
    if (!primed) prime_unit(Kh, Vh, KP, t0, MODE == 0 ? ncsg : nullptr, qb, lds0, lane, wid);
    bf16x8 qr[4]; float mhat;
    { bf16x8 kd[4];
#pragma unroll
      for (int d0 = 0; d0 < 4; ++d0) { qr[d0] = *reinterpret_cast<const bf16x8*>(&Qw[(long)r32 * QP + d0 * 16 + hi * 8]); kd[d0] = *reinterpret_cast<const bf16x8*>(&Kh[(long)(q0 + wrow + r32) * KP + d0 * 16 + hi * 8]); }
      float dg = 0.f;
#pragma unroll
      for (int d0 = 0; d0 < 4; ++d0)
#pragma unroll
          for (int j = 0; j < 8; ++j) dg += bf2f(qr[d0][j]) * bf2f(kd[d0][j]);
      auto rr = __builtin_amdgcn_permlane32_swap(__float_as_uint(dg), __float_as_uint(dg), false, false);
      mhat = __uint_as_float(rr[0]) + __uint_as_float(rr[1]); }
    float rowt = -mhat;
#define CI0(C, t) do { if constexpr (MODE == 0) { cinit_half(C, rowt, ncs + (t) * 64); } else { _Pragma("unroll") for (int r = 0; r < 16; ++r) C[r] = rowt; } } while (0)
#define CI1(C, t) do { if constexpr (MODE == 0) { cinit_half(C, rowt, ncs + (t) * 64 + 32); } else { _Pragma("unroll") for (int r = 0; r < 16; ++r) C[r] = rowt; } } while (0)
#define CSRC(C) (C)
#define NEWREF() do { rowt -= dl; } while (0)
    float l_reg = 0.f; f32x16 o[2]; o[0] = f32x16{}; o[1] = f32x16{};
    const int qrel = wrow + r32;
#define CMASK(P0, P1, t) do { const int jb_ = (t) - jdiag; if (MODE == 1) wmask(P0, P1, jb_, qrel, hi); else if (jb_ >= 0) cmask(P0, P1, jb_, qrel, hi); } while (0)
    bool resc = false;
#define RESC() do { if constexpr (TRK) if (resc) { asm volatile("s_waitcnt lgkmcnt(0)" ::: "memory"); \
      _Pragma("unroll") for (int d_ = 0; d_ < 2; ++d_) _Pragma("unroll") for (int r = 0; r < 16; ++r) o[d_][r] *= wsf[crow(r, hi)]; } } while (0)
    f32x16 pA0, pA1, pB0, pB1;
    int sl_prev = 0, sl_cur = 0, sl_next = SLOTB;
#define ROT() do { sl_prev = sl_cur; sl_cur = sl_next; sl_next = (sl_next == (NSLOT - 1) * SLOTB) ? 0 : sl_next + SLOTB; } while (0)
    DMA_K(2, 2 * SLOTB);
    WAIT_BAR(3);
    if constexpr (MODE == 0) rowt -= ((const LAS float*)(shm3 + LDS_NCS))[q0 + wid * QBLK + r32];
    CI0(pA0, 0); CI1(pA1, 0);
    { const char* kb = Kbase + hi * 1024 + r32 * 16;
#pragma unroll
      for (int d0 = 0; d0 < 4; ++d0) {
          const bf16x8 b0 = *reinterpret_cast<const bf16x8*>(kb + d0 * 2048);
          const bf16x8 b1 = *reinterpret_cast<const bf16x8*>(kb + d0 * 2048 + 512);
          if (d0 == 0) { pA0 = __builtin_amdgcn_mfma_f32_32x32x16_bf16(b0, qr[0], CSRC(pA0), 0, 0, 0); pA1 = __builtin_amdgcn_mfma_f32_32x32x16_bf16(b1, qr[0], CSRC(pA1), 0, 0, 0); }
          else { pA0 = __builtin_amdgcn_mfma_f32_32x32x16_bf16(b0, qr[d0], pA0, 0, 0, 0); pA1 = __builtin_amdgcn_mfma_f32_32x32x16_bf16(b1, qr[d0], pA1, 0, 0, 0); } } }
    CMASK(pA0, pA1, 0);
    if constexpr (TRK) { const float rm = rowmax(pA0, pA1);
      if (__builtin_expect(__any(rm > (float)THRL), 0)) { const float dl = __builtin_fmaxf(rm, 0.f); mhat += dl; NEWREF();
          _Pragma("unroll") for (int r = 0; r < 16; ++r) { pA0[r] -= dl; pA1[r] -= dl; } } }
    _Pragma("unroll") for (int r = 0; r < 16; ++r) pA0[r] = __builtin_amdgcn_exp2f(pA0[r]);
    _Pragma("unroll") for (int r = 0; r < 16; ++r) pA1[r] = __builtin_amdgcn_exp2f(pA1[r]);
    WAIT_BAR(0);
    if constexpr (MODE != 1) DMA_K(3, 0);
    DMA_V(1, SLOTB);
    ROT();
    kload8(kf, kp0 + sl_cur);
    WAIT_BAR(2);
    s16x4 vlo[8], vhi[8]; u32x4 pw0, pw1, pw2, pw3;
#define PKW(P, B) cvt_pk_bf16(P[B], P[B + 1])
#define PAF(k) __builtin_bit_cast(bf16x8, pw##k)
#define VFR(i) (bf16x8){vlo[i][0], vlo[i][1], vlo[i][2], vlo[i][3], vhi[i][0], vhi[i][1], vhi[i][2], vhi[i][3]}
#define PIN(x) asm volatile("" : "+v"(x))
#define GAPA(MF, A0, A1, A2, A3, W0, W1, PW) do { MF; sacc += A0; sacc += A1; sacc += A2; sacc += A3; PIN(sacc); W0; W1; PIN(PW); SBAR(); } while (0)
#define EX(v) __builtin_amdgcn_exp2f(v)
#define GAPB(MF, X, B) do { MF; X[B] = EX(X[B]); X[B + 1] = EX(X[B + 1]); X[B + 2] = EX(X[B + 2]); X[B + 3] = EX(X[B + 3]); PIN(X); SBAR(); } while (0)
#define VRD(i) do { vlo[i] = vtr(vp_ + (((i) >> 2) * 4096 + ((i) & 3) * 1024)); vhi[i] = vtr(vp_ + (((i) >> 2) * 4096 + ((i) & 3) * 1024 + 512)); } while (0)
#define KRD(G, j) do { if (G) { kload2(kf, kp0 + sl_next, j); SBAR(); } } while (0)
#define STEP(C0, C1, P0, P1, t, GK, GV, GL) do { SBAR(); \
    const lds_cptr vp_ = vp0 + sl_prev; \
    CI0(C0, t); VRD(0); SBAR(); float sacc = (P0[0] + P0[1]); \
    GAPA(C0 = __builtin_amdgcn_mfma_f32_32x32x16_bf16(kf[0], qr[0], CSRC(C0), 0, 0, 0), P0[2], P0[3], P0[4], P0[5],     pw0[0] = PKW(P0, 0), pw0[1] = PKW(P0, 2), pw0); \
    CI1(C1, t); VRD(4); SBAR(); GAPA(C1 = __builtin_amdgcn_mfma_f32_32x32x16_bf16(kf[1], qr[0], CSRC(C1), 0, 0, 0), P0[6], P0[7], P0[8], P0[9],     pw0[2] = PKW(P0, 4), pw0[3] = PKW(P0, 6), pw0); \
    VRD(1); SBAR(); GAPA(C0 = __builtin_amdgcn_mfma_f32_32x32x16_bf16(kf[2], qr[1], C0, 0, 0, 0),   P0[10], P0[11], P0[12], P0[13], pw1[0] = PKW(P0, 8), pw1[1] = PKW(P0, 10), pw1); \
    VRD(5); SBAR(); GAPA(C1 = __builtin_amdgcn_mfma_f32_32x32x16_bf16(kf[3], qr[1], C1, 0, 0, 0),   P0[14], P0[15], P1[0], P1[1],   pw1[2] = PKW(P0, 12), pw1[3] = PKW(P0, 14), pw1); \
    VRD(2); SBAR(); GAPA(C0 = __builtin_amdgcn_mfma_f32_32x32x16_bf16(kf[4], qr[2], C0, 0, 0, 0),   P1[2], P1[3], P1[4], P1[5],     pw2[0] = PKW(P1, 0), pw2[1] = PKW(P1, 2), pw2); \
    VRD(6); SBAR(); GAPA(C1 = __builtin_amdgcn_mfma_f32_32x32x16_bf16(kf[5], qr[2], C1, 0, 0, 0),   P1[6], P1[7], P1[8], P1[9],     pw2[2] = PKW(P1, 4), pw2[3] = PKW(P1, 6), pw2); \
    VRD(3); SBAR(); GAPA(C0 = __builtin_amdgcn_mfma_f32_32x32x16_bf16(kf[6], qr[3], C0, 0, 0, 0),   P1[10], P1[11], P1[12], P1[13], pw3[0] = PKW(P1, 8), pw3[1] = PKW(P1, 10), pw3); \
    VRD(7); SBAR(); GAPA(C1 = __builtin_amdgcn_mfma_f32_32x32x16_bf16(kf[7], qr[3], C1, 0, 0, 0),   P1[14], P1[15], 0.f, 0.f,       pw3[2] = PKW(P1, 12), pw3[3] = PKW(P1, 14), pw3); \
    l_reg += sacc; \
    if (GK) { DMA_K((t) + 3, sl_cur); } if (GV) { DMA_V((t) + 1, sl_next); } \
    CMASK(C0, C1, t); \
    if constexpr (TRK) { float a = MX3(C0[0], C0[1], C1[0]), b = MX3(C0[2], C0[3], C1[1]); a = MX3(a, C1[2], C1[3]); \
      _Pragma("unroll") for (int r = 4; r < 16; r += 4) { a = MX3(a, C0[r], C0[r + 1]); b = MX3(b, C0[r + 2], C0[r + 3]); a = MX3(a, C1[r], C1[r + 1]); b = MX3(b, C1[r + 2], C1[r + 3]); } \
      float rm = __builtin_fmaxf(a, b); { auto rr = __builtin_amdgcn_permlane32_swap(__float_as_uint(rm), __float_as_uint(rm), false, false); rm = __builtin_fmaxf(__uint_as_float(rr[0]), __uint_as_float(rr[1])); } \
      resc = false; \
      if (__builtin_expect(__any(rm > (float)THRL), 0)) { const float dl = __builtin_fmaxf(rm, 0.f); mhat += dl; NEWREF(); \
        _Pragma("unroll") for (int r = 0; r < 16; ++r) { C0[r] -= dl; C1[r] -= dl; } \
        const float f = __builtin_amdgcn_exp2f(-dl); l_reg *= f; if (hi == 0) wsf[r32] = f; resc = true; } } \
    SBAR(); \
    GAPB(o[0] = __builtin_amdgcn_mfma_f32_32x32x16_bf16(PAF(0), VFR(0), o[0], 0, 0, 0), C0, 0); \
    GAPB(o[1] = __builtin_amdgcn_mfma_f32_32x32x16_bf16(PAF(0), VFR(4), o[1], 0, 0, 0), C0, 4); \
    KRD(GL, 0); GAPB(o[0] = __builtin_amdgcn_mfma_f32_32x32x16_bf16(PAF(1), VFR(1), o[0], 0, 0, 0), C0, 8); \
    KRD(GL, 1); GAPB(o[1] = __builtin_amdgcn_mfma_f32_32x32x16_bf16(PAF(1), VFR(5), o[1], 0, 0, 0), C0, 12); \
    KRD(GL, 2); GAPB(o[0] = __builtin_amdgcn_mfma_f32_32x32x16_bf16(PAF(2), VFR(2), o[0], 0, 0, 0), C1, 0); \
    KRD(GL, 3); GAPB(o[1] = __builtin_amdgcn_mfma_f32_32x32x16_bf16(PAF(2), VFR(6), o[1], 0, 0, 0), C1, 4); \
    GAPB(o[0] = __builtin_amdgcn_mfma_f32_32x32x16_bf16(PAF(3), VFR(3), o[0], 0, 0, 0), C1, 8); \
    GAPB(o[1] = __builtin_amdgcn_mfma_f32_32x32x16_bf16(PAF(3), VFR(7), o[1], 0, 0, 0), C1, 12); \
    } while (0)
    int t = 1;
    if constexpr (MODE == 0) {
#undef CMASK
#define CMASK(P0, P1, t) do {} while (0)
        for (; t + 5 < NT; t += 2) {
            STEP(pB0, pB1, pA0, pA1, t, true, true, true);     WAIT_BAR(2); RESC(); ROT();
            STEP(pA0, pA1, pB0, pB1, t + 1, true, true, true); WAIT_BAR(2); RESC(); ROT();
        }
#undef CMASK
#define CMASK(P0, P1, t) do { const int jb_ = (t) - jdiag; if (MODE == 1) wmask(P0, P1, jb_, qrel, hi); else if (jb_ >= 0) cmask(P0, P1, jb_, qrel, hi); } while (0)
    }
#define ENDW(tt) do { if ((tt) + 3 < NT) { WAIT_BAR(2); } else if ((tt) + 2 < NT) { WAIT_BAR(1); } else { WAIT_BAR(0); } } while (0)
#define DRAIN(PX0, PX1) do { float sacc = PX0[0] + PX0[1]; _Pragma("unroll") for (int r = 2; r < 16; ++r) sacc += PX0[r]; _Pragma("unroll") for (int r = 0; r < 16; ++r) sacc += PX1[r]; l_reg += sacc; \
      pw0 = (u32x4){PKW(PX0, 0), PKW(PX0, 2), PKW(PX0, 4), PKW(PX0, 6)}; pw1 = (u32x4){PKW(PX0, 8), PKW(PX0, 10), PKW(PX0, 12), PKW(PX0, 14)}; pw2 = (u32x4){PKW(PX1, 0), PKW(PX1, 2), PKW(PX1, 4), PKW(PX1, 6)}; pw3 = (u32x4){PKW(PX1, 8), PKW(PX1, 10), PKW(PX1, 12), PKW(PX1, 14)}; \
      SBAR(); pv(o, vb0 + sl_cur, PAF(0), PAF(1), PAF(2), PAF(3)); } while (0)
    if constexpr (MODE == 1) {
        STEP(pB0, pB1, pA0, pA1, 1, false, true, true);   WAIT_BAR(0); RESC(); ROT();
        STEP(pA0, pA1, pB0, pB1, 2, false, false, false); RESC();
        DRAIN(pA0, pA1);
    } else {
        for (; t + 1 < NT; t += 2) {
            STEP(pB0, pB1, pA0, pA1, t, (t + 3 < NT), (t + 1 < NT), (t + 1 < NT));     ENDW(t);     RESC(); ROT();
            STEP(pA0, pA1, pB0, pB1, t + 1, (t + 4 < NT), (t + 2 < NT), (t + 2 < NT)); ENDW(t + 1); RESC(); ROT();
        }
        STEP(pB0, pB1, pA0, pA1, NT - 1, false, false, false); RESC();
        DRAIN(pB0, pB1);
    }
#undef DRAIN
    if (tid == 0) qslot[0] = qval;
    asm volatile("s_waitcnt lgkmcnt(0)\n\ts_barrier" ::: "memory");
    pos2 = __builtin_amdgcn_readfirstlane(qslot[0]);
    { NextU nx = nx1; int target = pos1;
      if (nx.Kh == nullptr) { nx = dec.next(pos2); target = pos2; }
      primed_pos = -1;
      if (nx.Kh != nullptr) { prime_unit(nx.Kh, nx.Vh, nx.KP, nx.t0, nx.ncsg, nx.qb, lds0, lane, wid); primed_pos = target; } }
#undef PKW
#undef PAF
#undef VFR
#undef PIN
#undef GAPA
#undef GAPB
#undef EX
#undef VRD
#undef KRD
#undef STEP
#undef ENDW
    { auto rr = __builtin_amdgcn_permlane32_swap(__float_as_uint(l_reg), __float_as_uint(l_reg), false, false); l_reg = __uint_as_float(rr[0]) + __uint_as_float(rr[1]); }
    if constexpr (MODE == 1) l_reg += __builtin_amdgcn_exp2f(sinkl2 - mhat);
    if (hi == 0) wsf[32 + r32] = l_reg; asm volatile("s_waitcnt lgkmcnt(0)" ::: "memory");
    float rli[16];
#pragma unroll
    for (int r = 0; r < 16; ++r) rli[r] = __builtin_amdgcn_rcpf(wsf[32 + crow(r, hi)]);
    if constexpr (P3A_FP8 != 0) {
        unsigned char* Ow8 = (unsigned char*)Oh + (long)(q0 + wrow) * 512 + wcol;
        unsigned char* stg8 = (unsigned char*)(shm + LDS_OST) + wid * 4096;
#pragma unroll
        for (int r = 0; r < 16; ++r) { const int orow = crow(r, hi); const float sc = rli[r] * 32.0f;
#pragma unroll
            for (int d0 = 0; d0 < 2; ++d0) stg8[orow * 64 + d0 * 32 + r32] = (unsigned char)(__builtin_amdgcn_cvt_pk_fp8_f32(clamp448(o[d0][r] * sc), 0.f, 0, false) & 0xff); }
        asm volatile("s_waitcnt lgkmcnt(0)" ::: "memory");
#pragma unroll
        for (int i = 0; i < 2; ++i) { const int row = i * 16 + (lane >> 2), ch = lane & 3; const u32x4 v = *(const u32x4*)(stg8 + row * 64 + ch * 16); *(u32x4*)(Ow8 + (long)row * 512 + ch * 16) = v; }
    } else {
    bf16* Ow = Oh + (long)(q0 + wrow) * QP + wcol;
    { bf16* stg = (bf16*)(shm + LDS_OST) + wid * 2048;
#pragma unroll
      for (int r = 0; r < 16; ++r) { const int orow = crow(r, hi);
#pragma unroll
          for (int d0 = 0; d0 < 2; ++d0) stg[orow * 64 + d0 * 32 + r32] = __float2bfloat16(o[d0][r] * rli[r]); }
      asm volatile("s_waitcnt lgkmcnt(0)" ::: "memory");
#pragma unroll
      for (int i = 0; i < 4; ++i) { const int row = i * 8 + (lane >> 3), ch = lane & 7; const u32x4 v = *(const u32x4*)(stg + row * 64 + ch * 8); *(u32x4*)(Ow + (long)row * QP + ch * 8) = v; } }
    }
    asm volatile("s_waitcnt lgkmcnt(0)" ::: "memory");
#undef DMA_K
#undef DMA_V
#undef CMASK
#undef RESC
#undef ROT
#undef CI0
#undef CI1
#undef CSRC
#undef NEWREF
}
#undef SBAR
#undef WAIT_BAR
#undef MX3
}

constexpr int NWAVES = 8;
constexpr int N_PHASES = 9;
constexpr size_t MiB = 1u << 20;
constexpr size_t WS_CTL = 0, CTL_ZERO_BYTES = 64 * 1024;
constexpr size_t WS_LOGF = 2 * MiB;
constexpr size_t WS_NCS = 3 * MiB;
constexpr size_t WS_TOKE = 4 * MiB, WS_TOKR = 4 * MiB + 512 * 1024, WS_TOKG = 5 * MiB;
constexpr size_t WS_TS = 6 * MiB, WS_ORDER = 6 * MiB + 64 * 1024;
constexpr size_t WS_ROWTOK = 8 * MiB;
constexpr size_t WS_WOA = 16 * MiB, WS_WOB = 17 * MiB, WS_WOUT = 18 * MiB, WS_WIN = 20 * MiB;
constexpr size_t WS_WIN8 = 24 * MiB;
constexpr size_t WS_XN8 = 560 * MiB;
constexpr size_t WS_WGU = 32 * MiB, WS_WD = 160 * MiB;
constexpr size_t WS_XN = 224 * MiB;
constexpr size_t WS_QA = 288 * MiB, WS_KA = 320 * MiB, WS_VA = 328 * MiB, WS_QF = 336 * MiB, WS_KF = 368 * MiB, WS_VF = 400 * MiB;
constexpr size_t WS_GT = 432 * MiB, WS_MG = 560 * MiB, WS_OA = 624 * MiB, WS_OB = 656 * MiB;
constexpr size_t WS_ACT = 288 * MiB;
constexpr size_t WS_YB = 560 * MiB;
constexpr size_t WS_X1 = 832 * MiB;
constexpr size_t WS_WOA8 = 12 * MiB, WS_WOB8 = 13 * MiB;
constexpr size_t WS_RMS = 6 * MiB + 256 * 1024;
constexpr size_t WS_WRT = 6 * MiB + 512 * 1024;
constexpr size_t WS_WOUT8 = 7 * MiB;
constexpr size_t WS_MG8 = 688 * MiB;
constexpr size_t WS_END = 896 * MiB;
constexpr int CW_CNT = 64;
constexpr int CW_DONE = 128, CW_QCTR = 192;
constexpr int CW_BAR = 1024;
constexpr int MISC_BAR = 8192;
constexpr int RING_BYTES = 131072, MISC_OFF = RING_BYTES, LDS_BYTES = 163840;
constexpr int MISC_TOKL = 12544, TOKL_UNITS = 19;

struct Args { const void* in[21]; float* out; unsigned char* ws; int ph_lo, ph_hi; };

struct Frame { LAS unsigned char* lds; int tid, lane, wave, vcu, G; };

__device__ __forceinline__ float wave_sum(float v) {
#pragma unroll
    for (int o = 1; o < 64; o <<= 1) v += __shfl_xor(v, o);
    return v;
}

__device__ __forceinline__ int rowmap_in(int c) {
    int T, wc, d;
    if (c < 512) { const int hh = c >> 6; T = hh >> 2; wc = hh & 3; d = c & 63; }
    else if (c < 640) { T = 2; wc = (c - 512) >> 6; d = c & 63; }
    else if (c < 768) { T = 2; wc = 2 + ((c - 640) >> 6); d = c & 63; }
    else if (c < COL_FL) { const int cc = c - 768, sect = cc >> 9, hh = (cc & 511) >> 6; T = 3 + 2 * sect + (hh >> 2); wc = hh & 3; d = cc & 63; }
    else if (c < COL_GL) return -1;
    else { const int g = c - COL_GL, gc = g & 255; return 256 * (9 + (g >> 8)) + 128 * ((gc >> 3) & 1) + 32 * ((gc >> 6) & 3) + 16 * ((gc >> 2) & 1) + 4 * ((gc >> 4) & 3) + (gc & 3); }
    return 256 * T + 128 * (d >> 5) + 32 * wc + perm32s(d & 31);
}
__device__ __forceinline__ int rowmap_in16(int c) { const int r = rowmap_in(c); return (!P1_FP8 || r < P1_FS * 256) ? r : -1; }
__device__ __forceinline__ int rowmap_in8(int c) { const int r = rowmap_in(c); return r >= P1_FS * 256 ? r - P1_FS * 256 : -1; }
__device__ __forceinline__ int rowmap_perm(int c) { return (c & ~31) + perm32s(c & 31); }
__device__ __forceinline__ int rowmap_d16(int c) { return (c & ~255) + 128 * ((c >> 3) & 1) + 32 * ((c >> 6) & 3) + 16 * ((c >> 2) & 1) + 4 * ((c >> 4) & 3) + (c & 3); }
__device__ __forceinline__ int rowmap_gu(int c) { const int bj = c >> 10, f = c & 1023; return 256 * (f >> 7) + 128 * bj + 32 * ((f >> 5) & 3) + perm32s(f & 31); }
template <int MAP> __device__ __forceinline__ void transpose_item(const float* W, int K, int N, bf16_t* WT, int kb, int nb, int lane) {
    const int k0 = 64 * kb + 8 * (lane >> 3), n0 = 32 * nb + 4 * (lane & 7);
    if (n0 >= N) return;
    f32x4 v[8];
#pragma unroll
    for (int kk = 0; kk < 8; ++kk) v[kk] = *(const f32x4*)(W + (size_t)(k0 + kk) * N + n0);
#pragma unroll
    for (int j = 0; j < 4; ++j) { const int c = n0 + j; const int row = MAP == 0 ? rowmap_in16(c) : MAP == 1 ? rowmap_perm(c) : MAP == 2 ? c : rowmap_gu(c);
        if (row >= 0) { u32x4 o; o.x = cvt_pk_bf16(v[0][j], v[1][j]); o.y = cvt_pk_bf16(v[2][j], v[3][j]); o.z = cvt_pk_bf16(v[4][j], v[5][j]); o.w = cvt_pk_bf16(v[6][j], v[7][j]);
            *(u32x4*)(WT + (size_t)row * K + k0) = o; } }
}

template <int MAP> __device__ __forceinline__ bool f8_item_load(const float* W, int K, int N, int kb, int nb, int lane, f32x4 (&v)[16]) {
    const int k0 = 128 * kb + 16 * (lane >> 3), n0 = 32 * nb + 4 * (lane & 7);
    if (n0 >= N) return false;
    if (MAP == 0 && rowmap_in8(n0) < 0) return false;
#pragma unroll
    for (int kk = 0; kk < 16; ++kk) v[kk] = __builtin_nontemporal_load((const f32x4*)(W + (size_t)(k0 + kk) * N + n0));
    return true;
}
template <int MAP> __device__ __forceinline__ void f8_item_store(int K, unsigned char* WT, int kb, int nb, int lane, const f32x4 (&v)[16], const float W8S = W8_SCALE) {
    const int k0 = 128 * kb + 16 * (lane >> 3), n0 = 32 * nb + 4 * (lane & 7);
#pragma unroll
    for (int j = 0; j < 4; ++j) { const int c = n0 + j; const int row = MAP == 0 ? rowmap_in8(c) : MAP == 1 ? rowmap_perm(c) : MAP == 4 ? rowmap_d16(c) : rowmap_gu(c);
        u32x4 o; o.x = pk4_fp8(v[0][j] * W8S, v[1][j] * W8S, v[2][j] * W8S, v[3][j] * W8S); o.y = pk4_fp8(v[4][j] * W8S, v[5][j] * W8S, v[6][j] * W8S, v[7][j] * W8S);
        o.z = pk4_fp8(v[8][j] * W8S, v[9][j] * W8S, v[10][j] * W8S, v[11][j] * W8S); o.w = pk4_fp8(v[12][j] * W8S, v[13][j] * W8S, v[14][j] * W8S, v[15][j] * W8S);
        __builtin_nontemporal_store(o, (u32x4*)(WT + (size_t)row * K + k0)); }
}
template <int MAP> __device__ __forceinline__ void transpose_item_f8(const float* W, int K, int N, unsigned char* WT, int kb, int nb, int lane) {
    f32x4 v[16]; if (f8_item_load<MAP>(W, K, N, kb, nb, lane, v)) f8_item_store<MAP>(K, WT, kb, nb, lane, v);
}

constexpr int MOE_ITEMS = N_EXP * (8 * 64 + 8 * 32);
__device__ __forceinline__ void moe_item_decode(const Args& a, int r, const float*& W, unsigned char*& WT, int& N, int& kb, int& nb, bool& gu) {
    unsigned char* ws = a.ws; constexpr int I_GU = 8 * 64, I_D = 8 * 32;
    if (r < N_EXP * I_GU) { const int e = r / I_GU, q = r % I_GU; W = (const float*)a.in[17] + (size_t)e * 1024 * 2048; WT = ws + WS_WGU + (size_t)e * 2048 * 1024; N = 2048; kb = q / 64; nb = q % 64; gu = true; }
    else { r -= N_EXP * I_GU; const int e = r / I_D, q = r % I_D; W = (const float*)a.in[19] + (size_t)e * 1024 * 1024; WT = ws + WS_WD + (size_t)e * 1024 * 1024; N = 1024; kb = q / 32; nb = q % 32; gu = false; }
}
__device__ __forceinline__ void moe_weight_item2(const Args& a, int r0, int r1, int lane, volatile LAS int* qslot = nullptr, int qval = 0, bool qwrite = false) {
    const float *W0, *W1; unsigned char *T0, *T1; int N0, N1, kb0, kb1, nb0, nb1; bool g0, g1;
    moe_item_decode(a, r0, W0, T0, N0, kb0, nb0, g0); moe_item_decode(a, r1, W1, T1, N1, kb1, nb1, g1);
    f32x4 v0[16], v1[16];
    (void)f8_item_load<3>(W0, 1024, N0, kb0, nb0, lane, v0); (void)f8_item_load<3>(W1, 1024, N1, kb1, nb1, lane, v1);
    asm volatile("" ::: "memory");
    if (qwrite) qslot[0] = qval;
    if (g0) f8_item_store<3>(1024, T0, kb0, nb0, lane, v0, nb0 < 32 ? W8_SCALE * SWIGLU_CG : W8_SCALE); else f8_item_store<4>(1024, T0, kb0, nb0, lane, v0, W8_SCALE / SWIGLU_CG);
    if (g1) f8_item_store<3>(1024, T1, kb1, nb1, lane, v1, nb1 < 32 ? W8_SCALE * SWIGLU_CG : W8_SCALE); else f8_item_store<4>(1024, T1, kb1, nb1, lane, v1, W8_SCALE / SWIGLU_CG);
}

__device__ __forceinline__ void p0_prologue(const Frame& F, const Args& a) {
    unsigned char* ws = a.ws;
    const float* x = (const float*)a.in[0]; const float* g1 = (const float*)a.in[2]; const float* w_in = (const float*)a.in[3]; const float* b_forget = (const float*)a.in[4];
    const int gw = F.vcu * NWAVES + F.wave, NGW = F.G * NWAVES;
    f32x4 nv[4];
    if (gw < NTOK) {
#pragma unroll
        for (int j = 0; j < 4; ++j) nv[j] = __builtin_nontemporal_load((const f32x4*)(x + (size_t)gw * 1024) + F.lane + 64 * j); }
    constexpr int I_IN = 16 * 137, I_IN8 = 8 * 137, I_OA = 8 * 32, I_OUT = 16 * 32, I_GU = 8 * 64, I_D = 8 * 32;
    constexpr int NITEMS = I_IN + I_IN8 + 2 * I_OA + I_OUT;
    for (int it = gw; it < NITEMS; it += NGW) {
        int r = it;
        if (r < I_IN) { transpose_item<0>(w_in, 1024, IN_W, (bf16_t*)(ws + WS_WIN), r / 137, r % 137, F.lane); continue; } r -= I_IN;
        if (r < I_IN8) { if (P1_FP8) transpose_item_f8<0>(w_in, 1024, IN_W, ws + WS_WIN8, r / 137, r % 137, F.lane); continue; } r -= I_IN8;
        if (r < I_OA) { if (P3A_FP8) { if (r < 4 * 32) transpose_item_f8<(P3B_FP8 ? 4 : 1)>((const float*)a.in[11], 512, 1024, ws + WS_WOA8, r / 32, r % 32, F.lane); }
                        else transpose_item<1>((const float*)a.in[11], 512, 1024, (bf16_t*)(ws + WS_WOA), r / 32, r % 32, F.lane); continue; } r -= I_OA;
        if (r < I_OA) { if (P3A_FP8) { if (r < 4 * 32) transpose_item_f8<(P3B_FP8 ? 4 : 1)>((const float*)a.in[12], 512, 1024, ws + WS_WOB8, r / 32, r % 32, F.lane); }
                        else transpose_item<1>((const float*)a.in[12], 512, 1024, (bf16_t*)(ws + WS_WOB), r / 32, r % 32, F.lane); continue; } r -= I_OA;
        if (P3B_FP8) { if (r < 8 * 32) transpose_item_f8<1>((const float*)a.in[13], 1024, 1024, ws + WS_WOUT8, r / 32, r % 32, F.lane); }
        else transpose_item<1>((const float*)a.in[13], 1024, 1024, (bf16_t*)(ws + WS_WOUT), r / 32, r % 32, F.lane);
    }
    { const int ci = (int)blockIdx.x * (NWAVES * 64) + F.tid;
      if (ci < 4096) { const float* g2 = (const float*)a.in[14]; const float* wr_ = (const float*)a.in[15];
          const int ks = ci >> 7, et = (ci >> 6) & 1, kq = (ci >> 4) & 3, er = ci & 15, e = 16 * et + er, k0 = 64 * (ks >> 1) + 16 * kq + 8 * (ks & 1);
          float w[8];
#pragma unroll
          for (int j = 0; j < 8; ++j) w[j] = g2[k0 + j] * wr_[(k0 + j) * 32 + e];
          u32x4 o; o.x = cvt_pk_bf16(w[0], w[1]); o.y = cvt_pk_bf16(w[2], w[3]); o.z = cvt_pk_bf16(w[4], w[5]); o.w = cvt_pk_bf16(w[6], w[7]);
          *(u32x4*)(ws + WS_WRT + (size_t)ci * 16) = o; } }
    LAS float* wfl = (LAS float*)F.lds;
    for (int c = F.tid; c < 1024; c += NWAVES * 64) { const f32x4 u0 = *(const f32x4*)(w_in + (size_t)c * IN_W + COL_FL), u1 = *(const f32x4*)(w_in + (size_t)c * IN_W + COL_FL + 4);
        *(LAS f32x4*)(wfl + c * 8) = u0; *(LAS f32x4*)(wfl + c * 8 + 4) = u1; }
    __syncthreads();
    f32x4 wf[16][2], gv[4];
#pragma unroll
    for (int j = 0; j < 4; ++j) { gv[j] = *(const f32x4*)(g1 + 256 * j + 4 * F.lane);
#pragma unroll
        for (int i = 0; i < 4; ++i) { const int c = 256 * j + 4 * F.lane + i; wf[4 * j + i][0] = *(const LAS f32x4*)(wfl + c * 8); wf[4 * j + i][1] = *(const LAS f32x4*)(wfl + c * 8 + 4); } }
    float bfv = 0.f; if (F.lane < 8) bfv = b_forget[F.lane];
    bf16_t* XN = (bf16_t*)(ws + WS_XN); unsigned char* XN8 = ws + WS_XN8; float* LOGF = (float*)(ws + WS_LOGF);
    f32x4 nv2[4];
    if (gw + NGW < NTOK) {
#pragma unroll
        for (int j = 0; j < 4; ++j) nv2[j] = __builtin_nontemporal_load((const f32x4*)(x + (size_t)(gw + NGW) * 1024) + F.lane + 64 * j); }
    for (int m = gw; m < NTOK; m += NGW) {
        f32x4 v[4]; float s = 0.f;
#pragma unroll
        for (int j = 0; j < 4; ++j) { v[j] = nv[j]; nv[j] = nv2[j]; }
        if (m + 2 * NGW < NTOK) {
#pragma unroll
            for (int j = 0; j < 4; ++j) nv2[j] = __builtin_nontemporal_load((const f32x4*)(x + (size_t)(m + 2 * NGW) * 1024) + F.lane + 64 * j); }
#pragma unroll
        for (int j = 0; j < 4; ++j) { s += (v[j][0] * v[j][0] + v[j][1] * v[j][1]) + (v[j][2] * v[j][2] + v[j][3] * v[j][3]); }
        const float rstd = rsqrtf(wave_sum(s) * (1.0f / 1024.0f) + EPS);
        if (XREC && F.lane == 0) ((float*)(ws + WS_RMS))[m] = __builtin_amdgcn_rcpf(rstd);
        float fl[8];
#pragma unroll
        for (int h = 0; h < 8; ++h) fl[h] = 0.f;
        u32x2* o8 = (u32x2*)(XN + (size_t)m * 1024) + F.lane;
#pragma unroll
        for (int j = 0; j < 4; ++j) { v[j] = v[j] * rstd * gv[j];
            u32x2 w; w.x = cvt_pk_bf16(v[j][0], v[j][1]); w.y = cvt_pk_bf16(v[j][2], v[j][3]); o8[64 * j] = w;
            if (P1_FP8) ((unsigned*)(XN8 + (size_t)m * 1024))[64 * j + F.lane] = pk4_fp8(v[j][0], v[j][1], v[j][2], v[j][3]);
#pragma unroll
            for (int i = 0; i < 4; ++i) {
#pragma unroll
                for (int h = 0; h < 4; ++h) { fl[h] += v[j][i] * wf[4 * j + i][0][h]; fl[4 + h] += v[j][i] * wf[4 * j + i][1][h]; } } }
        float mine = 0.f;
#pragma unroll
        for (int h = 0; h < 8; ++h) { const float t = wave_sum(fl[h]); if (F.lane == h) mine = t; }
        if (F.lane < 8) { const float z = mine + bfv; LOGF[(size_t)m * 8 + F.lane] = fminf(z, 0.f) - log1pf(__expf(-fabsf(z))); }
    }
}

__device__ __forceinline__ void p1_cumsum(const Frame& F, const Args& a, int bh) {
    const float* LOGF = (const float*)(a.ws + WS_LOGF); float* NCS = (float*)(a.ws + WS_NCS);
    const int b = bh >> 3, h = bh & 7; LAS double* wtot = (LAS double*)F.lds; LAS float* ncl = (LAS float*)(F.lds + 1024); LAS float* smx = (LAS float*)(F.lds + 512);
    double v[16]; double run = 0.0;
#pragma unroll
    for (int j = 0; j < 16; ++j) { run += (double)LOGF[((size_t)b * SEQ + 16 * F.tid + j) * 8 + h]; v[j] = run; }
    double incl = run;
#pragma unroll
    for (int o = 1; o < 64; o <<= 1) { const double t = __shfl_up(incl, o); if (F.lane >= o) incl += t; }
    if (F.lane == 63) wtot[F.wave] = incl;
    if (F.wave == 0) {
        float mq = fabsf(((const float*)a.in[9])[F.lane]), mk = fabsf(((const float*)a.in[10])[F.lane]);
#pragma unroll
        for (int o = 1; o < 64; o <<= 1) { mq = fmaxf(mq, __shfl_xor(mq, o)); mk = fmaxf(mk, __shfl_xor(mk, o)); }
        if (F.lane == 0) smx[0] = 64.0f * C2 * mq * mk;
    }
    __syncthreads();
    double base = incl - run;
    for (int w = 0; w < F.wave; ++w) base += wtot[w];
    float* dst = NCS + (size_t)bh * SEQ + 16 * F.tid;
#pragma unroll
    for (int j = 0; j < 4; ++j) { f32x4 o;
#pragma unroll
        for (int i = 0; i < 4; ++i) o[i] = (float)(-(base + v[4 * j + i]) * 1.4426950408889634);
        *(f32x4*)(dst + 4 * j) = o; *(LAS f32x4*)(ncl + 16 * F.tid + 4 * j) = o; }
    __syncthreads();
    LAS float* tms = (LAS float*)(F.lds + 1024 + 32768); LAS float* FQ = tms + 128; LAS float* tops = FQ + 132;
    { const int tile = F.tid >> 2; const float top = ncl[64 * tile + 63]; float pm = 0.f;
#pragma unroll
      for (int i = 0; i < 4; ++i) { const f32x4 n4 = *(const LAS f32x4*)(ncl + 16 * F.tid + 4 * i);
          pm += (__builtin_amdgcn_exp2f(n4[0] - top) + __builtin_amdgcn_exp2f(n4[1] - top)) + (__builtin_amdgcn_exp2f(n4[2] - top) + __builtin_amdgcn_exp2f(n4[3] - top)); }
      pm += __shfl_xor(pm, 1); pm += __shfl_xor(pm, 2);
      if ((F.tid & 3) == 0) { tms[tile] = pm; tops[tile] = top; } }
    __syncthreads();
    if (F.tid <= 128) { const int j = F.tid; float fq = -INFINITY;
        if (j >= 1) { const float top = tops[j - 1]; float q = 0.f; const int i0 = j > 16 ? j - 16 : 0;
            for (int i = i0; i < j; ++i) q += tms[i] * __builtin_amdgcn_exp2f(tops[i] - top);
            if (i0 > 0) q += 64.0f * (float)i0 * __builtin_amdgcn_exp2f(tops[i0 - 1] - top);
            fq = __builtin_amdgcn_logf(q) + top; }
        FQ[j] = fq; }
    __syncthreads();
    int* TS = (int*)(a.ws + WS_TS);
    if (F.tid < 32) { const int qb = F.tid; const float thr = ncl[256 * qb] - (27.05f + 2.1f * smx[0]); int lo_ = 0, hi_ = 4 * qb;
        while (lo_ < hi_) { const int mid = (lo_ + hi_ + 1) >> 1; if (FQ[mid] < thr) lo_ = mid; else hi_ = mid - 1; }
        TS[bh * 32 + qb] = lo_ & ~1; }
    __threadfence();
    __syncthreads();
    LAS int* flag = (LAS int*)(F.lds + 768);
    if (F.tid == 0) flag[0] = (int)__hip_atomic_fetch_add((unsigned*)(a.ws + WS_CTL) + CW_DONE, 1u, __ATOMIC_RELAXED, __HIP_MEMORY_SCOPE_AGENT);
    __syncthreads();
    if (flag[0] == 31) {
        __threadfence();
        LAS int* hist = (LAS int*)(F.lds + 2048); LAS int* cst = hist + 80;
        if (F.tid < 160) hist[F.tid] = 0;
        __syncthreads();
        int c[2];
#pragma unroll
        for (int k = 0; k < 2; ++k) { const int u = F.tid + 512 * k; const int t0 = (int)__hip_atomic_load((unsigned*)TS + u, __ATOMIC_RELAXED, __HIP_MEMORY_SCOPE_AGENT); c[k] = (4 * (u & 31) + 4 - t0) >> 1; atomicAdd((int*)(hist + c[k]), 1); }
        __syncthreads();
        if (F.wave == 0) {
            const int v0 = hist[79 - F.lane], v1 = F.lane < 16 ? hist[15 - F.lane] : 0; int i0 = v0, i1 = v1;
#pragma unroll
            for (int o = 1; o < 64; o <<= 1) { const int a0_ = __shfl_up(i0, o), a1_ = __shfl_up(i1, o); if (F.lane >= o) { i0 += a0_; i1 += a1_; } }
            const int tot0 = __shfl(i0, 63);
            cst[79 - F.lane] = i0 - v0; if (F.lane < 16) cst[15 - F.lane] = tot0 + i1 - v1; }
        __syncthreads();
        int* ORD = (int*)(a.ws + WS_ORDER);
#pragma unroll
        for (int k = 0; k < 2; ++k) { const int u = F.tid + 512 * k; const int p = atomicAdd((int*)(cst + c[k]), 1); ORD[p] = u | ((4 * (u & 31) + 4 - 2 * c[k]) << 16); }
    }
    __syncthreads();
}

__device__ __forceinline__ void p2_attention(const Frame& F, const Args& a, char* lds) {
    using attn_body::bf16;
    unsigned char* ws = a.ws; const float* sinks = (const float*)a.in[8];
    const bf16* QA = (const bf16*)(ws + WS_QA); const bf16* KA = (const bf16*)(ws + WS_KA); const bf16* VA = (const bf16*)(ws + WS_VA);
    const bf16* QF = (const bf16*)(ws + WS_QF); const bf16* KF = (const bf16*)(ws + WS_KF); const bf16* VF = (const bf16*)(ws + WS_VF);
    bf16* OA = (bf16*)(ws + WS_OA); bf16* OB = (bf16*)(ws + WS_OB);
    const float* NCS = (const float*)(ws + WS_NCS);
    constexpr int OES = P3A_FP8 ? 2 : 1;
    const int* TS = (const int*)(ws + WS_TS); const int* ORD = (const int*)(ws + WS_ORDER); unsigned* qctr = (unsigned*)(ws + WS_CTL) + CW_QCTR;
    volatile LAS int* qi = (volatile LAS int*)(F.lds + MISC_OFF + 12288);
    int qa0 = 0, qa1 = 0;
    if (F.tid == 0) { qa0 = (int)__hip_atomic_fetch_add(qctr, 1u, __ATOMIC_RELAXED, __HIP_MEMORY_SCOPE_AGENT); qa1 = (int)__hip_atomic_fetch_add(qctr, 1u, __ATOMIC_RELAXED, __HIP_MEMORY_SCOPE_AGENT); }
    bool fixedref;
    { float fq_ = fabsf(((const float*)a.in[9])[F.lane]), fk_ = fabsf(((const float*)a.in[10])[F.lane]), sq_ = fabsf(((const float*)a.in[6])[F.lane]), sk_ = fabsf(((const float*)a.in[7])[F.lane]), sn_ = fabsf(sinks[F.lane & 7]);
#pragma unroll
      for (int o = 1; o < 64; o <<= 1) { fq_ = fmaxf(fq_, __shfl_xor(fq_, o)); fk_ = fmaxf(fk_, __shfl_xor(fk_, o)); sq_ = fmaxf(sq_, __shfl_xor(sq_, o)); sk_ = fmaxf(sk_, __shfl_xor(sk_, o)); sn_ = fmaxf(sn_, __shfl_xor(sn_, o)); }
      const float bound = 2.1f * 64.0f * C2 * fmaxf(fq_ * fk_, sq_ * sk_);
      fixedref = __builtin_amdgcn_readfirstlane((int)((bound <= 60.0f) && (sn_ * LOG2E + bound <= 60.0f))) != 0; }
    LAS int* ordl = (LAS int*)(F.lds + 118784);
    for (int i = F.tid; i < 1024; i += NWAVES * 64) ordl[i] = ORD[i];
    if (F.tid == 0) { qi[0] = qa0; qi[1] = qa1; }
    __syncthreads();
    int pos = __builtin_amdgcn_readfirstlane(qi[0]), pos1 = __builtin_amdgcn_readfirstlane(qi[1]);
    __syncthreads();
    using attn_body::P2Dec;
    static_assert(MOE_ITEMS == 1536 * 16, "chunking of the expert weight items");
    P2Dec dec; dec.KF = KF; dec.VF = VF; dec.KA = KA; dec.VA = VA; dec.NCS = NCS; dec.ordl = ordl;
    int primed_pos = -1, it = 0;
    while (pos < P2Dec::QPOS) {
        int nxt = 0;
        if (F.tid == 0) nxt = (int)__hip_atomic_fetch_add(qctr, 1u, __ATOMIC_RELAXED, __HIP_MEMORY_SCOPE_AGENT);
        volatile LAS int* slot = qi + (it & 1);
        int pos2;
        const int idx = P2Dec::unit_of(pos);
        if (idx < 0) {
            const int chunk = P2Dec::chunk_of(pos);
            moe_weight_item2(a, chunk * 16 + F.wave, chunk * 16 + 8 + F.wave, F.lane, slot, nxt, F.tid == 0);
            __syncthreads();
            pos2 = __builtin_amdgcn_readfirstlane(slot[0]);
        } else {
            const attn_body::NextU nx1 = dec.next(pos1); const bool primed = primed_pos == pos;
            if (idx < 1024) {
                const int od = __builtin_amdgcn_readfirstlane(ordl[idx]), u = od & 0xffff, t0 = od >> 16, bh = u >> 5, qb = u & 31, b = bh >> 3, h = bh & 7;
                if (fixedref) attn_body::attn_unit<0, 8, false>(qb, t0, QF + (size_t)b * SEQ * 512 + h * 64, KF + (size_t)b * SEQ * 512 + h * 64, VF + (size_t)b * SEQ * 512 + h * 64, OB + ((size_t)b * SEQ * 512 + h * 64) / OES, 512, 0.f, lds, NCS + (size_t)bh * SEQ, primed, nx1, pos1, dec, slot, nxt, pos2, primed_pos);
                else attn_body::attn_unit<0, 8, true>(qb, t0, QF + (size_t)b * SEQ * 512 + h * 64, KF + (size_t)b * SEQ * 512 + h * 64, VF + (size_t)b * SEQ * 512 + h * 64, OB + ((size_t)b * SEQ * 512 + h * 64) / OES, 512, 0.f, lds, NCS + (size_t)bh * SEQ, primed, nx1, pos1, dec, slot, nxt, pos2, primed_pos);
            } else {
                const int u = idx - 1024, bk = u >> 7, qb = 127 - (u & 127), b = bk >> 1, kvh = bk & 1; const float snk = sinks[kvh * 4 + (F.wave >> 1)] * LOG2E;
                if (fixedref) attn_body::attn_unit<1, 8, false>(qb, 0, QA + (size_t)b * SEQ * 512 + kvh * 256, KA + (size_t)b * SEQ * 128 + kvh * 64, VA + (size_t)b * SEQ * 128 + kvh * 64, OA + ((size_t)b * SEQ * 512 + kvh * 256) / OES, 128, snk, lds, nullptr, primed, nx1, pos1, dec, slot, nxt, pos2, primed_pos);
                else attn_body::attn_unit<1, 8, true>(qb, 0, QA + (size_t)b * SEQ * 512 + kvh * 256, KA + (size_t)b * SEQ * 128 + kvh * 64, VA + (size_t)b * SEQ * 128 + kvh * 64, OA + ((size_t)b * SEQ * 512 + kvh * 256) / OES, 128, snk, lds, nullptr, primed, nx1, pos1, dec, slot, nxt, pos2, primed_pos);
            }
        }
        pos = pos1; pos1 = pos2; ++it;
    }
    __syncthreads();
}

template <int NC> __device__ __forceinline__ void top4_of(float (&cv)[NC], int (&ce)[NC], float (&tv)[4], int (&te)[4]) {
#pragma unroll
    for (int k = 0; k < 4; ++k) { float bv = -INFINITY; int be = 1 << 20;
#pragma unroll
        for (int i = 0; i < NC; ++i) { const bool t = (cv[i] > bv) | ((cv[i] == bv) & (ce[i] < be)); bv = t ? cv[i] : bv; be = t ? ce[i] : be; }
        tv[k] = bv; te[k] = be;
#pragma unroll
        for (int i = 0; i < NC; ++i) cv[i] = (ce[i] == be) ? -INFINITY : cv[i]; }
}
__device__ __forceinline__ void p4_router(const Frame& F, const Args& a, const bool dry) {
    unsigned char* ws = a.ws; const bf16_t* X1 = (const bf16_t*)(ws + WS_X1); const float* g2 = (const float*)a.in[14]; const float* wr_ = (const float*)a.in[15]; const float* br = (const float*)a.in[16];
    LAS unsigned char* WL = F.lds;
    LAS int* lcnt = (LAS int*)(F.lds + MISC_OFF); LAS int* lbase = lcnt + 32; LAS int* asg_e = lcnt + 64; LAS float* asg_g = (LAS float*)(lcnt + 64 + 512);
    { u32x4 wv_[8];
#pragma unroll
      for (int j = 0; j < 8; ++j) wv_[j] = *(const u32x4*)(ws + WS_WRT + (size_t)(F.tid + j * NWAVES * 64) * 16);
#pragma unroll
      for (int j = 0; j < 8; ++j) *(LAS u32x4*)(WL + (F.tid + j * NWAVES * 64) * 16) = wv_[j]; }
    if (F.tid < 32) lcnt[F.tid] = 0;
    __syncthreads();
    unsigned char* H2 = ws + WS_XN; unsigned* gcnt = (unsigned*)(ws + WS_CTL) + CW_CNT;
    int* TOKE = (int*)(ws + WS_TOKE); int* TOKR = (int*)(ws + WS_TOKR); float* TOKG = (float*)(ws + WS_TOKG); int* ROWTOK = (int*)(ws + WS_ROWTOK);
    const int tokl = F.lane & 15, kq = F.lane >> 4;
    for (int rb = blockIdx.x; rb < NTOK / 128; rb += F.G) {
        const int lrow = F.wave * 16 + tokl, m = rb * 128 + lrow;
        const bf16_t* xrow = X1 + (size_t)m * 1024 + 16 * kq;
        f32x4 acc0 = (f32x4){0.f, 0.f, 0.f, 0.f}, acc1 = (f32x4){0.f, 0.f, 0.f, 0.f}; float ss = 0.f;
#pragma unroll 4
        for (int ql = 0; ql < 16; ++ql) {
            const u32x4 x0 = *(const u32x4*)(xrow + 64 * ql), x1v = *(const u32x4*)(xrow + 64 * ql + 8);
#pragma unroll
            for (int d = 0; d < 4; ++d) { const float p = bf_lo(x0[d]), q = bf_hi(x0[d]), r = bf_lo(x1v[d]), t = bf_hi(x1v[d]); ss += (p * p + q * q) + (r * r + t * t); }
            const LAS unsigned char* wp = WL + ql * 4096 + F.lane * 16;
            acc0 = __builtin_amdgcn_mfma_f32_16x16x32_bf16(*(const LAS bf16x8*)(wp), __builtin_bit_cast(bf16x8, x0), acc0, 0, 0, 0);
            acc1 = __builtin_amdgcn_mfma_f32_16x16x32_bf16(*(const LAS bf16x8*)(wp + 1024), __builtin_bit_cast(bf16x8, x0), acc1, 0, 0, 0);
            acc0 = __builtin_amdgcn_mfma_f32_16x16x32_bf16(*(const LAS bf16x8*)(wp + 2048), __builtin_bit_cast(bf16x8, x1v), acc0, 0, 0, 0);
            acc1 = __builtin_amdgcn_mfma_f32_16x16x32_bf16(*(const LAS bf16x8*)(wp + 3072), __builtin_bit_cast(bf16x8, x1v), acc1, 0, 0, 0);
        }
        ss += __shfl_xor(ss, 16); ss += __shfl_xor(ss, 32);
        const float rstd = rsqrtf(ss * (1.0f / 1024.0f) + EPS);
        float cv[8]; int ce[8];
#pragma unroll
        for (int r = 0; r < 4; ++r) { ce[r] = 4 * kq + r; ce[4 + r] = 16 + 4 * kq + r; cv[r] = acc0[r] * rstd + br[4 * kq + r]; cv[4 + r] = acc1[r] * rstd + br[16 + 4 * kq + r]; }
        float tv[4]; int te[4];
        top4_of<8>(cv, ce, tv, te);
#pragma unroll
        for (int o = 16; o <= 32; o <<= 1) {
            float mv[8]; int me[8];
#pragma unroll
            for (int k = 0; k < 4; ++k) { mv[k] = tv[k]; me[k] = te[k]; mv[4 + k] = __shfl_xor(tv[k], o); me[4 + k] = __shfl_xor(te[k], o); }
            top4_of<8>(mv, me, tv, te);
        }
        if (kq == 0) {
            float ex[4], z = 0.f;
#pragma unroll
            for (int k = 0; k < 4; ++k) { ex[k] = __expf(tv[k] - tv[0]); z += ex[k]; }
#pragma unroll
            for (int k = 0; k < 4; ++k) { asg_e[lrow * 4 + k] = te[k]; asg_g[lrow * 4 + k] = ex[k] / z; }
        }
        unsigned char* hrow = H2 + (size_t)m * 1024 + 16 * kq;
#pragma unroll 4
        for (int ql = 0; ql < 16; ++ql) {
            const u32x4 x0 = *(const u32x4*)(xrow + 64 * ql), x1v = *(const u32x4*)(xrow + 64 * ql + 8);
            const f32x4 g0 = *(const f32x4*)(g2 + 64 * ql + 16 * kq), g1 = *(const f32x4*)(g2 + 64 * ql + 16 * kq + 4), g2v = *(const f32x4*)(g2 + 64 * ql + 16 * kq + 8), g3 = *(const f32x4*)(g2 + 64 * ql + 16 * kq + 12);
            u32x4 o;
            o.x = pk4_fp8(bf_lo(x0[0]) * rstd * g0[0], bf_hi(x0[0]) * rstd * g0[1], bf_lo(x0[1]) * rstd * g0[2], bf_hi(x0[1]) * rstd * g0[3]);
            o.y = pk4_fp8(bf_lo(x0[2]) * rstd * g1[0], bf_hi(x0[2]) * rstd * g1[1], bf_lo(x0[3]) * rstd * g1[2], bf_hi(x0[3]) * rstd * g1[3]);
            o.z = pk4_fp8(bf_lo(x1v[0]) * rstd * g2v[0], bf_hi(x1v[0]) * rstd * g2v[1], bf_lo(x1v[1]) * rstd * g2v[2], bf_hi(x1v[1]) * rstd * g2v[3]);
            o.w = pk4_fp8(bf_lo(x1v[2]) * rstd * g3[0], bf_hi(x1v[2]) * rstd * g3[1], bf_lo(x1v[3]) * rstd * g3[2], bf_hi(x1v[3]) * rstd * g3[3]);
            *(u32x4*)(hrow + 64 * ql) = o;
        }
        __syncthreads();
        if (dry) continue;
        const int e = asg_e[F.tid]; const int lrank = atomicAdd((int*)(lcnt + e), 1);
        __syncthreads();
        if (F.tid < 32) { const int c = lcnt[F.tid]; lbase[F.tid] = c ? (int)atomicAdd(gcnt + F.tid, (unsigned)c) : 0; }
        __syncthreads();
        const int rank = lbase[e] + lrank, tok = rb * 128 + (F.tid >> 2);
        ROWTOK[(size_t)e * NTOK + rank] = tok; TOKE[tok * 4 + (F.tid & 3)] = e; TOKR[tok * 4 + (F.tid & 3)] = rank; TOKG[tok * 4 + (F.tid & 3)] = asg_g[F.tid];
        __syncthreads();
        if (F.tid < 32) lcnt[F.tid] = 0;
        __syncthreads();
    }
}

__device__ __forceinline__ int build_group_tables(const Frame& F, const Args& a, LAS int* cnt, LAS int* pt, LAS int* tile_e) {
    const unsigned* gcnt = (const unsigned*)(a.ws + WS_CTL) + CW_CNT;
    __syncthreads();
    if (F.wave == 0) {
        const int c = F.lane < 32 ? (int)__hip_atomic_load(gcnt + (F.lane & 31), __ATOMIC_RELAXED, __HIP_MEMORY_SCOPE_AGENT) : 0;
        const int t = (c + 255) >> 8; int incl = t;
#pragma unroll
        for (int o = 1; o < 32; o <<= 1) { const int v = __shfl_up(incl, o); if (F.lane >= o) incl += v; }
        if (F.lane < 32) { cnt[F.lane] = c; pt[F.lane] = incl - t; }
        if (F.lane == 31) pt[32] = incl;
    }
    __syncthreads();
    const int MT = pt[32];
    for (int i = F.tid; i < MT; i += NWAVES * 64) {
        int lo = 0, hi = 31;
        while (lo < hi) { const int mid = (lo + hi + 1) >> 1; if (pt[mid] <= i) lo = mid; else hi = mid - 1; }
        tile_e[i] = lo; }
    __syncthreads();
    return MT;
}

__device__ __forceinline__ void p7_combine(const Frame& F, const Args& a, const LAS int* pt, float* dst) {
    unsigned char* ws = a.ws; const bf16_t* X1 = (const bf16_t*)(ws + WS_X1); const unsigned char* YB = ws + WS_YB;
    const int* TOKE = (const int*)(ws + WS_TOKE); const int* TOKR = (const int*)(ws + WS_TOKR); const float* TOKG = (const float*)(ws + WS_TOKG);
    const int gw = F.vcu * NWAVES + F.wave, NGW = F.G * NWAVES;
    for (int m = gw; m < NTOK; m += NGW) {
        size_t pos[4]; float g[4];
#pragma unroll
        for (int k = 0; k < 4; ++k) { const int e = TOKE[m * 4 + k]; pos[k] = (size_t)(256 * pt[e] + TOKR[m * 4 + k]) * 1024; g[k] = TOKG[m * 4 + k]; }
#pragma unroll
        for (int j = 0; j < 2; ++j) { const int c0 = 512 * j + 8 * F.lane; float* dp = dst + (size_t)m * 1024 + c0;
            f32x4 o0, o1; { float xx[8]; epi::unpack8(*(const u32x4*)(X1 + (size_t)m * 1024 + c0), xx); o0 = (f32x4){xx[0], xx[1], xx[2], xx[3]}; o1 = (f32x4){xx[4], xx[5], xx[6], xx[7]}; }
#pragma unroll
            for (int k = 0; k < 4; ++k) { float y[8]; { const u32x2 w8 = *(const u32x2*)(YB + pos[k] + c0); y[0] = __builtin_amdgcn_cvt_f32_fp8((int)w8.x, 0); y[1] = __builtin_amdgcn_cvt_f32_fp8((int)w8.x, 1); y[2] = __builtin_amdgcn_cvt_f32_fp8((int)w8.x, 2); y[3] = __builtin_amdgcn_cvt_f32_fp8((int)w8.x, 3);
                  y[4] = __builtin_amdgcn_cvt_f32_fp8((int)w8.y, 0); y[5] = __builtin_amdgcn_cvt_f32_fp8((int)w8.y, 1); y[6] = __builtin_amdgcn_cvt_f32_fp8((int)w8.y, 2); y[7] = __builtin_amdgcn_cvt_f32_fp8((int)w8.y, 3); }
#pragma unroll
                for (int i = 0; i < 4; ++i) { o0[i] += g[k] * y[i]; o1[i] += g[k] * y[4 + i]; } }
            *(f32x4*)dp = o0; *(f32x4*)(dp + 4) = o1; }
    }
}

#define XB_TMO      128
#define XB_XCNT(j)  (256  + 64 * (j))
#define XB_XSUB(j)  (1280 + 64 * (j))
#define XB_XGEN(j)  (2304 + 64 * (j))
#define XB_TOP      3328
#define XB_TOPGEN   3392
#define XCD_BAR_WORDS 3456
#define XB_SPIN_CAP (1u << 20)
__device__ __forceinline__ unsigned xb_ld(unsigned* p)              { return __hip_atomic_load(p, __ATOMIC_RELAXED, __HIP_MEMORY_SCOPE_AGENT); }
__device__ __forceinline__ unsigned xb_add(unsigned* p, unsigned v) { return __hip_atomic_fetch_add(p, v, __ATOMIC_RELAXED, __HIP_MEMORY_SCOPE_AGENT); }
__device__ __forceinline__ unsigned xb_xcc_id() { return (unsigned)__builtin_amdgcn_s_getreg((3 << 11) | 20) & 0xFu; }
#define XB_SPIN(cond, bar) do { unsigned _sp = 0; while (cond) { __builtin_amdgcn_s_sleep(1); \
    if ((++_sp & 255u) == 0u) { if (xb_ld(&(bar)[XB_TMO])) break; if (_sp > XB_SPIN_CAP) { atomicAdd(&(bar)[XB_TMO], 1u); break; } } } } while (0)
struct XcdBarrier { unsigned* bar; unsigned x; volatile LAS unsigned* st; };
__device__ __forceinline__ XcdBarrier xcd_barrier_post(unsigned* bar, volatile LAS unsigned* st) {
    XcdBarrier b; b.bar = bar; b.x = xb_xcc_id(); b.st = st;
    if (threadIdx.x == 0) (void)xb_add(&bar[XB_XCNT(b.x)], 1u);
    return b;
}
__device__ __forceinline__ void xcd_barrier_complete(unsigned* bar, unsigned x, unsigned& nloc, unsigned& nx) {
    const unsigned G = gridDim.x * gridDim.y * gridDim.z;
    unsigned sum, cnt, mine, sp = 0u;
    for (;;) {
        sum = 0u; cnt = 0u; mine = 0u;
#pragma unroll
        for (unsigned j = 0; j < 16; ++j) { const unsigned c = xb_ld(&bar[XB_XCNT(j)]); sum += c; cnt += (c > 0u) ? 1u : 0u; mine = (j == x) ? c : mine; }
        if (sum == G) break;
        __builtin_amdgcn_s_sleep(1);
        if ((++sp & 255u) == 0u) { if (xb_ld(&bar[XB_TMO])) break; if (sp > XB_SPIN_CAP) { atomicAdd(&bar[XB_TMO], 1u); break; } }
    }
    nloc = mine > 0u ? mine : 1u; nx = cnt > 0u ? cnt : 1u;
}
__device__ __forceinline__ void xcd_barrier(const XcdBarrier& b) {
    asm volatile("s_waitcnt vmcnt(0)" ::: "memory");
    __syncthreads();
    if (threadIdx.x == 0) {
        unsigned* bar = b.bar;
        __builtin_amdgcn_s_waitcnt(0);
        unsigned nloc = b.st[0], nx = b.st[1];
        if (nloc == 0u) { xcd_barrier_complete(bar, b.x, nloc, nx); b.st[0] = nloc; b.st[1] = nx; }
        const unsigned old = xb_add(&bar[XB_XSUB(b.x)], 1u);
        const unsigned gen = old / nloc;
        if (old + 1u == (gen + 1u) * nloc) {
            __builtin_amdgcn_fence(__ATOMIC_RELEASE, "agent");
            asm volatile("s_waitcnt vmcnt(0)" ::: "memory");
            const unsigned og = xb_add(&bar[XB_TOP], 1u);
            const unsigned tg = og / nx;
            if (og + 1u == (tg + 1u) * nx) xb_add(&bar[XB_TOPGEN], 1u);
            else XB_SPIN(xb_ld(&bar[XB_TOPGEN]) == tg, bar);
            __builtin_amdgcn_fence(__ATOMIC_ACQUIRE, "agent");
            xb_add(&bar[XB_XGEN(b.x)], 1u);
            asm volatile("s_waitcnt vmcnt(0)" ::: "memory");
        } else {
            XB_SPIN(xb_ld(&bar[XB_XGEN(b.x)]) == gen, bar);
            __builtin_amdgcn_fence(__ATOMIC_ACQUIRE, "agent");
            asm volatile("s_waitcnt vmcnt(0)" ::: "memory");
        }
    }
    __syncthreads();
}

__global__ void __launch_bounds__(NWAVES * 64, 2) hyb_fwd(Args args) {
    extern __shared__ __attribute__((aligned(16))) unsigned char lds_raw[];
#define MKFRAME() Frame F; F.lds = (LAS unsigned char*)lds_raw; F.tid = opaque_tid(); F.lane = F.tid & 63; F.wave = __builtin_amdgcn_readfirstlane(F.tid >> 6); \
    F.G = gridDim.x; { const int bx = blockIdx.x; F.vcu = (F.G % 8 == 0) ? (bx % 8) * (F.G / 8) + bx / 8 : bx; }
    unsigned char* ws = args.ws;
    const int lo = args.ph_lo, hi = args.ph_hi;
#ifndef PHASE_MASK
#define PHASE_MASK 0x1ff
#endif
#define IN(k) (((PHASE_MASK >> (k)) & 1) && lo <= (k) && (k) < hi)
#define BOTH(k) (IN(k) && IN((k) + 1))
#ifndef REPEAT_MASK
#define REPEAT_MASK 0
#endif
#define NREP(k) (1 + ((REPEAT_MASK >> (k)) & 1))
    volatile LAS unsigned* bst = (volatile LAS unsigned*)((LAS unsigned char*)lds_raw + MISC_OFF + MISC_BAR);
    if (threadIdx.x < 4) bst[threadIdx.x] = 0u;
    __syncthreads();
    XcdBarrier xbar; xbar.bar = (unsigned*)(ws + WS_CTL) + CW_BAR; xbar.x = 0; xbar.st = bst;
    if (hi - lo > 1) xbar = xcd_barrier_post((unsigned*)(ws + WS_CTL) + CW_BAR, bst);
#define GRID_BAR() xcd_barrier(xbar)
    LAS int* t_cnt = (LAS int*)((LAS unsigned char*)lds_raw + MISC_OFF); LAS int* t_pt = t_cnt + 64; LAS int* t_tile = t_cnt + 128;
    constexpr size_t TS1024 = (size_t)256 * 1024 * 2, TS512 = (size_t)256 * 512 * 2;

    if (IN(0)) { MKFRAME(); for (int rep = 0; rep < NREP(0); ++rep) { if (rep) GRID_BAR(); p0_prologue(F, args); } if (BOTH(0)) GRID_BAR(); }
    if (IN(1)) {
        MKFRAME();
        for (int bh = blockIdx.x; bh < 32; bh += F.G) p1_cumsum(F, args, bh);
        pg8::DenseOrder S{NTOK / 256, P1_FP8 ? P1_FS : IN_TILES, F.G, (int)blockIdx.x, (const char*)(ws + WS_XN), (const char*)(ws + WS_WIN), TS1024};
        pg8::SplitOrder S8{NTOK / 256, IN_TILES - P1_FS, F.G, (int)blockIdx.x, P1_FS, (const char*)(ws + WS_XN8), (const char*)(ws + WS_WIN8), TS512};
        epi::EpiIn E{(bf16_t*)(ws + WS_QA), (bf16_t*)(ws + WS_KA), (bf16_t*)(ws + WS_VA), (bf16_t*)(ws + WS_QF), (bf16_t*)(ws + WS_KF), (bf16_t*)(ws + WS_VF), ws + WS_GT,
                     (const int*)args.in[1], (const float*)args.in[6], (const float*)args.in[7], (const float*)args.in[9], (const float*)args.in[10], (const float*)args.in[5]};
        for (int rep = 0; rep < NREP(1); ++rep) { if (rep) GRID_BAR(); pg8::gemm_phase<epi::EpiIn, pg8::DenseOrder, false>(F.lds, 1024, S, E); if (P1_FP8) pg8::gemm_phase<epi::EpiIn, pg8::SplitOrder, false, true>(F.lds, 512, S8, E); }
        if (BOTH(1)) GRID_BAR();
    }
    if (IN(2)) { MKFRAME(); for (int rep = 0; rep < NREP(2); ++rep) { if (rep) { GRID_BAR(); if (blockIdx.x == 0 && threadIdx.x == 0) __hip_atomic_store((unsigned*)(ws + WS_CTL) + CW_QCTR, 0u, __ATOMIC_RELAXED, __HIP_MEMORY_SCOPE_AGENT); GRID_BAR(); } p2_attention(F, args, (char*)lds_raw); } if (BOTH(2)) GRID_BAR(); }
    if (IN(3)) {
        MKFRAME();
        pg8::PairOrder S{NTOK / 256, 4, F.G, (int)blockIdx.x, (const char*)(ws + WS_OA), (const char*)(ws + WS_OB), (const char*)(ws + (P3A_FP8 ? WS_WOA8 : WS_WOA)), (const char*)(ws + (P3A_FP8 ? WS_WOB8 : WS_WOB)), P3A_FP8 ? TS512 / 2 : TS512};
        epi::EpiMerge E{ws + WS_GT, (bf16_t*)(ws + WS_MG), ws + WS_MG8};
        for (int rep = 0; rep < NREP(3); ++rep) { if (rep) GRID_BAR();
            if (P3A_FP8) pg8::gemm_phase<epi::EpiMerge, pg8::PairOrder, false, true, 0x7a7a7a7au>(F.lds, 256, S, E);
            else pg8::gemm_phase<epi::EpiMerge, pg8::PairOrder, false>(F.lds, 512, S, E); }
        if (BOTH(3)) GRID_BAR();
    }
    if (IN(4)) {
        MKFRAME();
        pg8::DenseOrder S{NTOK / 256, 4, F.G, (int)blockIdx.x, (const char*)(ws + (P3B_FP8 ? WS_MG8 : WS_MG)), (const char*)(ws + (P3B_FP8 ? WS_WOUT8 : WS_WOUT)), P3B_FP8 ? TS512 : TS1024};
        bool rec;
        { const float* g1p = (const float*)args.in[2]; float mn = fminf(fabsf(g1p[F.tid]), fabsf(g1p[F.tid + 512]));
#pragma unroll
          for (int o = 1; o < 64; o <<= 1) mn = fminf(mn, __shfl_xor(mn, o));
          LAS float* red = (LAS float*)(F.lds + MISC_OFF);
          __syncthreads(); if (F.lane == 0) red[F.wave] = mn; __syncthreads();
          float all = red[0];
#pragma unroll
          for (int w = 1; w < NWAVES; ++w) all = fminf(all, red[w]);
          rec = __builtin_amdgcn_readfirstlane((int)(all >= 0.015625f)) != 0; __syncthreads(); }
        epi::EpiResid E{(const float*)args.in[0], (bf16_t*)(ws + WS_X1), (const bf16_t*)(ws + WS_XN), (const float*)(ws + WS_RMS), (const float*)args.in[2], rec};
        for (int rep = 0; rep < NREP(4); ++rep) { if (rep) GRID_BAR();
            if (P3B_FP8) pg8::gemm_phase<epi::EpiResid, pg8::DenseOrder, false, true, 0x7a7a7a7au>(F.lds, 512, S, E);
            else pg8::gemm_phase<epi::EpiResid, pg8::DenseOrder, false>(F.lds, 1024, S, E); }
        if (BOTH(4)) GRID_BAR();
    }
    if (IN(5)) { MKFRAME(); if (NREP(5) > 1) { p4_router(F, args, true); GRID_BAR(); } p4_router(F, args, false); if (BOTH(5)) GRID_BAR(); }
    if (IN(6)) {
        MKFRAME();
        const int MT = build_group_tables(F, args, t_cnt, t_pt, t_tile);
        LAS int* tokl = (LAS int*)(F.lds + MISC_OFF + MISC_TOKL);
        pg8::GroupOrder S{MT, 8, F.G, (int)blockIdx.x, t_tile, t_pt, t_cnt, (const char*)(ws + WS_XN), (const char*)(ws + WS_WGU), TS512, 2048, tokl, true};
        { const int* ROWTOK = (const int*)(ws + WS_ROWTOK);
          int tv[TOKL_UNITS];
#pragma unroll
          for (int ui = 0; ui < TOKL_UNITS; ++ui) { const long L = (long)ui * F.G + (int)blockIdx.x; tv[ui] = 0;
              if (L < (long)MT * 8 && F.tid < 256) { int pm, pn; pg8::tile_map((int)L, MT, 8, pm, pn); const int e = t_tile[pm], idx = (pm - t_pt[e]) * 256 + F.tid; if (idx < t_cnt[e]) tv[ui] = ROWTOK[(size_t)e * NTOK + idx]; } }
          if (F.tid < 256) {
#pragma unroll
              for (int ui = 0; ui < TOKL_UNITS; ++ui) tokl[ui * 256 + F.tid] = tv[ui]; }
          __syncthreads(); }
        epi::EpiSwiglu E{(const float*)args.in[18], ws + WS_ACT};
        for (int rep = 0; rep < NREP(6); ++rep) { if (rep) GRID_BAR(); pg8::gemm_phase<epi::EpiSwiglu, pg8::GroupOrder, true, true>(F.lds, 512, S, E); }
        if (BOTH(6)) GRID_BAR();
    }
    if (IN(7)) {
        MKFRAME();
        const int MT = (MK_N_LAUNCHES == 1 && PHASE_MASK == 0x1ff) ? t_pt[32] : build_group_tables(F, args, t_cnt, t_pt, t_tile);
        pg8::GroupOrder S{MT, 4, F.G, (int)blockIdx.x, t_tile, t_pt, t_cnt, (const char*)(ws + WS_ACT), (const char*)(ws + WS_WD), TS512, 1024, (const LAS int*)nullptr, false};
        epi::EpiDown E{(const float*)args.in[20], ws + WS_YB};
        for (int rep = 0; rep < NREP(7); ++rep) { if (rep) GRID_BAR(); pg8::gemm_phase<epi::EpiDown, pg8::GroupOrder, false, true>(F.lds, 512, S, E); }
        if (BOTH(7)) GRID_BAR();
    }
    if (IN(8)) { MKFRAME(); if (!(MK_N_LAUNCHES == 1 && PHASE_MASK == 0x1ff)) (void)build_group_tables(F, args, t_cnt, t_pt, t_tile); if (NREP(8) > 1) { p7_combine(F, args, t_pt, (float*)(ws + 896 * MiB)); GRID_BAR(); } p7_combine(F, args, t_pt, args.out); }
#undef IN
#undef BOTH
#undef GRID_BAR
#undef MKFRAME
}

extern "C" void kernel_launch(void* const* d_in, const int* in_sizes, int n_in, void* d_out, int out_size, void* d_ws, size_t ws_size, hipStream_t stream) {
    static int grid = 0;
    if (grid == 0) {
        if (n_in != 21 || in_sizes[0] != NTOK * D_MODEL || out_size != NTOK * D_MODEL || ws_size < WS_END) {
            fprintf(stderr, "kernel_launch: unexpected shapes (n_in %d, in0 %d, out %d, ws %zu); nothing launched\n", n_in, n_in > 0 ? in_sizes[0] : -1, out_size, ws_size); grid = -1; return; }
        int dev = 0, cus = 0, per_cu = 0;
        if (hipGetDevice(&dev) != hipSuccess || hipDeviceGetAttribute(&cus, hipDeviceAttributeMultiprocessorCount, dev) != hipSuccess) { fprintf(stderr, "kernel_launch: device query failed\n"); grid = -1; return; }
        if (hipFuncSetAttribute((const void*)hyb_fwd, hipFuncAttributeMaxDynamicSharedMemorySize, LDS_BYTES) != hipSuccess) { fprintf(stderr, "kernel_launch: hipFuncSetAttribute failed\n"); grid = -1; return; }
        if (hipOccupancyMaxActiveBlocksPerMultiprocessor(&per_cu, (const void*)hyb_fwd, NWAVES * 64, LDS_BYTES) != hipSuccess || per_cu < 1) { fprintf(stderr, "kernel_launch: occupancy query says %d\n", per_cu); per_cu = 1; }
        (void)hipGetLastError();
        grid = cus;
        if (grid > cus * per_cu) grid = cus * per_cu;
    }
    if (grid < 0) return;
    (void)hipMemsetAsync((char*)d_ws + WS_CTL, 0, CTL_ZERO_BYTES, stream);
    Args a{};
    for (int i = 0; i < 21; ++i) a.in[i] = d_in[i];
    a.out = (float*)d_out; a.ws = (unsigned char*)d_ws;
#if MK_N_LAUNCHES == 1
    a.ph_lo = 0; a.ph_hi = N_PHASES;
    void* kargs[] = {&a};
    hipError_t e = hipLaunchCooperativeKernel((const void*)hyb_fwd, dim3(grid), dim3(NWAVES * 64), kargs, LDS_BYTES, stream);
    if (e != hipSuccess) fprintf(stderr, "kernel_launch: cooperative launch failed: %s (grid %d)\n", hipGetErrorString(e), grid);
#else
    for (int p = 0; p < N_PHASES; ++p) { a.ph_lo = p; a.ph_hi = p + 1; hipLaunchKernelGGL(hyb_fwd, dim3(grid), dim3(NWAVES * 64), LDS_BYTES, stream, a); }
#endif
}
```
